# Optimizing an MI355X kernel written in HIP

```python
import jax, jax.numpy as jnp
from jax import lax
import numpy as np

D_MODEL = 1024
BATCH = 1
SEQ = 16384
DEPTH = 2

N_A = (DEPTH + 1) // 2
N_B = DEPTH // 2

D_RNN = D_MODEL
N_RNN_BLOCKS = 8
RNN_BLOCK = D_RNN // N_RNN_BLOCKS
CONV_WIDTH = 4
LRU_C = 8.0

N_HEADS = 16
N_KV_HEADS = 4
HEAD_DIM = 64
GROUP = N_HEADS // N_KV_HEADS
Q_DIM = N_HEADS * HEAD_DIM
KV_DIM = N_KV_HEADS * HEAD_DIM
WINDOW = 128
ATTN_BLOCK = 128
ROPE_THETA = 500000.0
ROT_DIM = HEAD_DIM // 4

D_FF = 3584
N_EXPERTS = 8
TOP_K = 2

EPS = 1e-6
NEG_INF = -1e30

kernel_name = "hybrid_rglru_swa_sink_moe_trunk"


def rmsnorm(t, g):
    tf = t.astype(jnp.float32)
    tf = tf * lax.rsqrt(jnp.mean(tf * tf, axis=-1, keepdims=True) + EPS)
    return (tf * g.astype(jnp.float32)).astype(t.dtype)


def rope_tables(positions):
    inv_freq = ROPE_THETA ** (-jnp.arange(0, ROT_DIM, 2, dtype=jnp.float32) / ROT_DIM)
    ang = positions.astype(jnp.float32)[..., None] * inv_freq
    return jnp.cos(ang)[:, :, None, :], jnp.sin(ang)[:, :, None, :]


def apply_partial_rope(t, cos, sin):
    rot, keep = t[..., :ROT_DIM].astype(jnp.float32), t[..., ROT_DIM:]
    t1, t2 = rot[..., :ROT_DIM // 2], rot[..., ROT_DIM // 2:]
    rot = jnp.concatenate([t1 * cos - t2 * sin, t2 * cos + t1 * sin], axis=-1).astype(t.dtype)
    return jnp.concatenate([rot, keep], axis=-1)


def rglru_mixer(h, w_in, conv_w, conv_b, w_a, b_a, w_x, b_x, lam, w_out):
    B, S, _ = h.shape
    proj = h @ w_in
    y_branch, x_branch = jnp.split(proj, 2, axis=-1)
    y_branch = jax.nn.gelu(y_branch, approximate=True)
    xp = jnp.pad(x_branch, ((0, 0), (CONV_WIDTH - 1, 0), (0, 0)))
    xc = conv_b + sum(xp[:, k:k + S] * conv_w[k] for k in range(CONV_WIDTH))
    xb = xc.reshape(B, S, N_RNN_BLOCKS, RNN_BLOCK)
    r = jax.nn.sigmoid(jnp.einsum('bsnc,ncd->bsnd', xb, w_a).reshape(B, S, D_RNN) + b_a)
    i = jax.nn.sigmoid(jnp.einsum('bsnc,ncd->bsnd', xb, w_x).reshape(B, S, D_RNN) + b_x)
    log_a = -LRU_C * r.astype(jnp.float32) * jax.nn.softplus(-lam.astype(jnp.float32))
    a = jnp.exp(log_a)
    gated_x = jnp.sqrt(-jnp.expm1(2.0 * log_a)) * (i * xc).astype(jnp.float32)

    def combine(left, right):
        a1, b1 = left
        a2, b2 = right
        return a1 * a2, a2 * b1 + b2

    _, hs = lax.associative_scan(combine, (a, gated_x), axis=1)
    return (hs.astype(h.dtype) * y_branch) @ w_out


def swa_sink_mixer(h, cos, sin, w_qkv, b_qkv, sinks, w_o, b_o):
    B, S, _ = h.shape
    nb = S // ATTN_BLOCK
    qkv = h @ w_qkv + b_qkv
    q, k, v = jnp.split(qkv, [Q_DIM, Q_DIM + KV_DIM], axis=-1)
    q = apply_partial_rope(q.reshape(B, S, N_HEADS, HEAD_DIM), cos, sin)
    k = apply_partial_rope(k.reshape(B, S, N_KV_HEADS, HEAD_DIM), cos, sin)
    v = v.reshape(B, S, N_KV_HEADS, HEAD_DIM)
    qb = q.reshape(B, nb, ATTN_BLOCK, N_KV_HEADS, GROUP, HEAD_DIM)
    kb = k.reshape(B, nb, ATTN_BLOCK, N_KV_HEADS, HEAD_DIM)
    vb = v.reshape(B, nb, ATTN_BLOCK, N_KV_HEADS, HEAD_DIM)

    def with_prev(t):
        prev = jnp.pad(t, ((0, 0), (1, 0), (0, 0), (0, 0), (0, 0)))[:, :-1]
        return jnp.concatenate([prev, t], axis=2)

    kc, vc = with_prev(kb), with_prev(vb)
    scores = jnp.einsum('bnqkgd,bnjkd->bnkgqj', qb, kc).astype(jnp.float32) * (HEAD_DIM ** -0.5)
    blk = jnp.arange(nb)[:, None, None]
    qpos = blk * ATTN_BLOCK + jnp.arange(ATTN_BLOCK)[None, :, None]
    kpos = (blk - 1) * ATTN_BLOCK + jnp.arange(2 * ATTN_BLOCK)[None, None, :]
    allowed = (kpos <= qpos) & (kpos > qpos - WINDOW) & (kpos >= 0)
    scores = jnp.where(allowed[None, :, None, None], scores, NEG_INF)
    sink = jnp.broadcast_to(sinks.astype(jnp.float32).reshape(1, 1, N_KV_HEADS, GROUP, 1, 1),
                            scores.shape[:-1] + (1,))
    probs = jax.nn.softmax(jnp.concatenate([scores, sink], axis=-1), axis=-1)[..., :-1]
    o = jnp.einsum('bnkgqj,bnjkd->bnqkgd', probs.astype(vc.dtype), vc).reshape(B, S, Q_DIM)
    return o @ w_o + b_o


def swiglu(h, w_gate, w_up, w_down):
    return (jax.nn.silu(h @ w_gate) * (h @ w_up)) @ w_down


def moe_swiglu(h, w_router, w_gate, w_up, w_down):
    logits = (h @ w_router).astype(jnp.float32)
    top_vals, top_idx = lax.top_k(logits, TOP_K)
    gates = jax.nn.softmax(top_vals, axis=-1)
    comb = jnp.sum(jax.nn.one_hot(top_idx, N_EXPERTS, dtype=jnp.float32) * gates[..., None], axis=-2)
    out = jnp.zeros_like(h)
    for e in range(N_EXPERTS):
        out = out + comb[..., e:e + 1].astype(h.dtype) * swiglu(h, w_gate[e], w_up[e], w_down[e])
    return out


def _normal(k, shape, scale):
    return jax.random.normal(k, shape, jnp.float32) * scale


def setup_inputs(seed: int = 0) -> dict:
    key = jax.random.key(seed)
    ks = jax.random.split(key, 32)
    u = jax.random.uniform(ks[9], (N_A, D_RNN), jnp.float32, 0.9, 0.999)
    s = u ** (1.0 / LRU_C)
    return {
        "x": _normal(ks[0], (BATCH, SEQ, D_MODEL), 1.0),
        "positions": jnp.broadcast_to(jnp.arange(SEQ, dtype=jnp.int32), (BATCH, SEQ)),
        "norm_mix": 1.0 + _normal(ks[1], (DEPTH, D_MODEL), 0.02),
        "norm_ffn": 1.0 + _normal(ks[2], (DEPTH, D_MODEL), 0.02),
        "norm_final": 1.0 + _normal(ks[3], (D_MODEL,), 0.02),
        "lru_w_in": _normal(ks[4], (N_A, D_MODEL, 2 * D_RNN), D_MODEL ** -0.5),
        "lru_conv_w": _normal(ks[5], (N_A, CONV_WIDTH, D_RNN), CONV_WIDTH ** -0.5),
        "lru_conv_b": _normal(ks[6], (N_A, D_RNN), 0.02),
        "lru_w_a": _normal(ks[7], (N_A, N_RNN_BLOCKS, RNN_BLOCK, RNN_BLOCK), RNN_BLOCK ** -0.5),
        "lru_b_a": _normal(ks[8], (N_A, D_RNN), 0.02),
        "lru_w_x": _normal(ks[10], (N_A, N_RNN_BLOCKS, RNN_BLOCK, RNN_BLOCK), RNN_BLOCK ** -0.5),
        "lru_b_x": _normal(ks[11], (N_A, D_RNN), 0.02),
        "lru_lambda": jnp.log(s) - jnp.log1p(-s),
        "lru_w_out": _normal(ks[12], (N_A, D_RNN, D_MODEL), D_RNN ** -0.5),
        "attn_w_qkv": _normal(ks[13], (N_B, D_MODEL, Q_DIM + 2 * KV_DIM), D_MODEL ** -0.5),
        "attn_b_qkv": _normal(ks[14], (N_B, Q_DIM + 2 * KV_DIM), 0.02),
        "attn_sinks": _normal(ks[15], (N_B, N_HEADS), 1.0),
        "attn_w_o": _normal(ks[16], (N_B, Q_DIM, D_MODEL), Q_DIM ** -0.5),
        "attn_b_o": _normal(ks[17], (N_B, D_MODEL), 0.02),
        "ffn_w_gate": _normal(ks[18], (N_A, D_MODEL, D_FF), D_MODEL ** -0.5),
        "ffn_w_up": _normal(ks[19], (N_A, D_MODEL, D_FF), D_MODEL ** -0.5),
        "ffn_w_down": _normal(ks[20], (N_A, D_FF, D_MODEL), D_FF ** -0.5),
        "moe_w_router": _normal(ks[21], (N_B, D_MODEL, N_EXPERTS), D_MODEL ** -0.5),
        "moe_w_gate": _normal(ks[22], (N_B, N_EXPERTS, D_MODEL, D_FF), D_MODEL ** -0.5),
        "moe_w_up": _normal(ks[23], (N_B, N_EXPERTS, D_MODEL, D_FF), D_MODEL ** -0.5),
        "moe_w_down": _normal(ks[24], (N_B, N_EXPERTS, D_FF, D_MODEL), D_FF ** -0.5),
    }


def reference(x, positions, norm_mix, norm_ffn, norm_final,
              lru_w_in, lru_conv_w, lru_conv_b, lru_w_a, lru_b_a, lru_w_x, lru_b_x,
              lru_lambda, lru_w_out,
              attn_w_qkv, attn_b_qkv, attn_sinks, attn_w_o, attn_b_o,
              ffn_w_gate, ffn_w_up, ffn_w_down,
              moe_w_router, moe_w_gate, moe_w_up, moe_w_down):
    cos, sin = rope_tables(positions)
    h = x
    for i in range(DEPTH):
        j = i // 2
        hn = rmsnorm(h, norm_mix[i])
        if i % 2 == 0:
            h = h + rglru_mixer(hn, lru_w_in[j], lru_conv_w[j], lru_conv_b[j], lru_w_a[j], lru_b_a[j],
                                lru_w_x[j], lru_b_x[j], lru_lambda[j], lru_w_out[j])
        else:
            h = h + swa_sink_mixer(hn, cos, sin, attn_w_qkv[j], attn_b_qkv[j], attn_sinks[j],
                                   attn_w_o[j], attn_b_o[j])
        hn = rmsnorm(h, norm_ffn[i])
        if i % 2 == 0:
            h = h + swiglu(hn, ffn_w_gate[j], ffn_w_up[j], ffn_w_down[j])
        else:
            h = h + moe_swiglu(hn, moe_w_router[j], moe_w_gate[j], moe_w_up[j], moe_w_down[j])
    return rmsnorm(h, norm_final)
```

```cpp
#include <hip/hip_runtime.h>
#include <stdint.h>
#include <stdio.h>

typedef unsigned short u16;
typedef short bf16x8 __attribute__((ext_vector_type(8)));
typedef float f32x4 __attribute__((ext_vector_type(4)));
typedef unsigned u32x4 __attribute__((ext_vector_type(4)));
typedef unsigned u32x2 __attribute__((ext_vector_type(2)));

constexpr int M = 16384, D = 1024, DFF = 3584, NE = 8, NBLK = 8, RB = 128;
constexpr int NH = 16, NKV = 4, HD = 64, KVD = 256, NQKV = 1536, WIN = 128;
constexpr int MAXSLOT = 34816;
constexpr float EPS = 1e-6f;
#ifndef MOE_FP8
#define MOE_FP8 1
#endif
constexpr float S8_A = 16.0f, S8_W = 256.0f, S8_ACT = 8.0f, S8_WD = 512.0f;
constexpr float LOG2E = 1.4426950408889634f;

constexpr size_t MiB = 1u << 20;
constexpr size_t WS_CTL = 0, CTL_BYTES = 1 * MiB;
constexpr size_t WS_ROPE = 1 * MiB;
constexpr size_t WS_SSP = 2 * MiB;
constexpr size_t WS_SPL = 3 * MiB;
constexpr size_t WS_WR = 3 * MiB + 64 * 1024;
constexpr size_t WS_CAR = 3 * MiB + 128 * 1024;
constexpr size_t WS_LIST = 4 * MiB;
constexpr size_t WS_GATEW = WS_LIST;
constexpr size_t WS_WGU2 = 6 * MiB;
constexpr size_t WS_HB8 = 70 * MiB;
constexpr size_t WS_WD2 = 118 * MiB;
constexpr size_t WS_HB = 174 * MiB;
constexpr size_t WS_X = 206 * MiB;
constexpr size_t WS_WIN = WS_X;
constexpr size_t WS_WAX = WS_X + 4 * MiB;
constexpr size_t WS_WOUT = WS_X + 5 * MiB;
constexpr size_t WS_WGU = WS_X + 7 * MiB;
constexpr size_t WS_WD = WS_X + 21 * MiB;
constexpr size_t WS_WQKV = WS_X + 28 * MiB;
constexpr size_t WS_WO = WS_X + 31 * MiB;
constexpr size_t WS_Y = WS_X + 33 * MiB;
constexpr size_t WS_XB = WS_Y + 32 * MiB;
constexpr size_t WS_G = WS_XB + 32 * MiB;
constexpr size_t WS_ACT = WS_G + 32 * MiB;
constexpr size_t WS_XC = WS_ACT;
constexpr size_t WS_BX = WS_ACT + 32 * MiB;
constexpr size_t WS_Q = WS_Y;
constexpr size_t WS_K = WS_Y + 32 * MiB;
constexpr size_t WS_V = WS_K + 8 * MiB;
constexpr size_t WS_ATT = WS_V + 8 * MiB;
constexpr size_t WS_ACT2 = WS_X;
constexpr size_t WS_MO = WS_WGU2;
constexpr size_t WS_END = 447 * MiB;
static_assert(WS_ACT + (size_t)M * DFF * 2 <= WS_END && WS_ACT2 + (size_t)MAXSLOT * DFF * 2 <= WS_END, "ws map");
constexpr int CW_CNT = 64;

__device__ __forceinline__ unsigned f2bf(float f) { unsigned u = __builtin_bit_cast(unsigned, f); return (u + 0x7fffu + ((u >> 16) & 1u)) >> 16; }
__device__ __forceinline__ float bf2f(unsigned b) { return __builtin_bit_cast(float, b << 16); }
__device__ __forceinline__ float u2f(unsigned b) { return __builtin_bit_cast(float, b); }
__device__ __forceinline__ unsigned pk2(float lo, float hi) { return f2bf(lo) | (f2bf(hi) << 16); }
__device__ __forceinline__ float wave_sum(float v) {
#pragma unroll
    for (int o = 1; o < 64; o <<= 1) v += __shfl_xor(v, o);
    return v;
}
__device__ __forceinline__ float sigmoidf_(float x) { return 1.0f / (1.0f + __expf(-x)); }
__device__ __forceinline__ float gelu_tanh(float x) { const float z = 0.7978845608028654f * (x + 0.044715f * x * x * x); return x / (1.0f + __expf(-2.0f * z)); }
__device__ __forceinline__ float silu_(float x) { return x / (1.0f + __expf(-x)); }
__device__ __forceinline__ float one_minus_exp(float x) {
    if (x > -0.3f) { float p = 1.0f / 720.0f; p = p * x + 1.0f / 120.0f; p = p * x + 1.0f / 24.0f; p = p * x + 1.0f / 6.0f; p = p * x + 0.5f; p = p * x + 1.0f; return -x * p; }
    return 1.0f - __expf(x);
}
__device__ __forceinline__ float rstd_of(const float* ssp, int row) { const f32x4 p = *(const f32x4*)(ssp + 4 * (size_t)row); return rsqrtf(((p[0] + p[1]) + (p[2] + p[3])) * (1.0f / D) + EPS); }

struct Args {
    const float* in[26]; const int* pos; float* out; unsigned char* ws; int ph_lo, ph_hi;
};

__device__ __forceinline__ void tables_body(const Args& a, int gt, int NT) {
    u16* rope = (u16*)(a.ws + WS_ROPE);
    for (int i = gt; i < M * 8; i += NT) { const int t = i >> 3, f = i & 7;
        const double inv = f == 0 ? 1.0 : f == 1 ? 0.19392274474868576 : f == 2 ? 0.03760603093086393 : f == 3 ? 0.007292664737217109 : f == 4 ? 0.001414213562373095 : f == 5 ? 0.0002742481756762073 : f == 6 ? 5.318295896944988e-05 : 1.031338537721246e-05;
        const double ang = (double)a.pos[t] * inv; const double kq = __builtin_rint(ang * 0.6366197723675814); const double r = ang - kq * 1.5707963267948966, r2 = r * r;
        double s = -1.0 / 39916800.0; s = s * r2 + 1.0 / 362880.0; s = s * r2 - 1.0 / 5040.0; s = s * r2 + 1.0 / 120.0; s = s * r2 - 1.0 / 6.0; s = s * r2 + 1.0; s *= r;
        double c = 1.0 / 479001600.0; c = c * r2 - 1.0 / 3628800.0; c = c * r2 + 1.0 / 40320.0; c = c * r2 - 1.0 / 720.0; c = c * r2 + 1.0 / 24.0; c = c * r2 - 0.5; c = c * r2 + 1.0;
        const int q = (int)((long long)kq & 3); const double cs = q == 0 ? c : q == 1 ? -s : q == 2 ? -c : s, sn = q == 0 ? s : q == 1 ? c : q == 2 ? -s : -c;
        rope[t * 16 + f] = (u16)f2bf((float)cs); rope[t * 16 + 8 + f] = (u16)f2bf((float)sn); }
    float* spl = (float*)(a.ws + WS_SPL);
    for (int i = gt; i < 1024; i += NT) { const float z = __expf(-a.in[12][i]);
        float p = 0.2f; p = p * z - 0.25f; p = p * z + 1.0f / 3.0f; p = p * z - 0.5f; p = p * z + 1.0f; spl[i] = z < 0.05f ? z * p : __logf(1.0f + z); }
    float* wr = (float*)(a.ws + WS_WR);
    for (int i = gt; i < 8 * 1024; i += NT) { const int e = i >> 10, k = i & 1023; wr[i] = a.in[3][1024 + k] * a.in[22][k * 8 + e]; }
}
__global__ void k_tables(Args a) { tables_body(a, blockIdx.x * blockDim.x + threadIdx.x, gridDim.x * blockDim.x); }

struct ConvJob { const float* W; const float* g; u16* WT; int K, N, mode, row_off; float s8; };
__device__ __forceinline__ bool conv_job(const Args& a, int j, ConvJob& c) {
    unsigned char* ws = a.ws;
    c.g = nullptr; c.mode = 0; c.row_off = 0; c.s8 = 0.f;
    if (j == 0) { c.W = a.in[5]; c.g = a.in[2]; c.WT = (u16*)(ws + WS_WIN); c.K = 1024; c.N = 2048; return true; }
    if (j == 1) { c.W = a.in[13]; c.WT = (u16*)(ws + WS_WOUT); c.K = 1024; c.N = 1024; return true; }
    if (j == 2) { c.W = a.in[19]; c.g = a.in[3]; c.WT = (u16*)(ws + WS_WGU); c.K = 1024; c.N = DFF; c.mode = 1; return true; }
    if (j == 3) { c.W = a.in[20]; c.g = a.in[3]; c.WT = (u16*)(ws + WS_WGU); c.K = 1024; c.N = DFF; c.mode = 2; return true; }
    if (j == 4) { c.W = a.in[21]; c.WT = (u16*)(ws + WS_WD); c.K = DFF; c.N = 1024; return true; }
    if (j == 5) { c.W = a.in[14]; c.g = a.in[2] + 1024; c.WT = (u16*)(ws + WS_WQKV); c.K = 1024; c.N = NQKV; return true; }
    if (j == 6) { c.W = a.in[17]; c.WT = (u16*)(ws + WS_WO); c.K = 1024; c.N = 1024; return true; }
    j -= 7;
    if (j < 16) { const int n = j >> 1, x = j & 1; c.W = a.in[x ? 10 : 8] + (size_t)n * 128 * 128; c.WT = (u16*)(ws + WS_WAX) + (size_t)n * 256 * 128; c.K = 128; c.N = 128; c.row_off = x * 128; return true; }
    j -= 16;
    if (j < 16) { const int e = j >> 1, x = j & 1; c.W = a.in[x ? 24 : 23] + (size_t)e * 1024 * DFF; c.g = a.in[3] + 1024; c.WT = (u16*)(ws + WS_WGU2 + (size_t)e * 7168 * 1024 * (MOE_FP8 ? 1 : 2)); c.K = 1024; c.N = DFF; c.mode = 1 + x; c.s8 = MOE_FP8 ? S8_W : 0.f; return true; }
    j -= 16;
    if (j < 8) { c.W = a.in[25] + (size_t)j * DFF * 1024; c.WT = (u16*)(ws + WS_WD2 + (size_t)j * 1024 * DFF * (MOE_FP8 ? 1 : 2)); c.K = DFF; c.N = 1024; c.s8 = MOE_FP8 ? S8_WD : 0.f; return true; }
    return false;
}
constexpr int NJOBS = 7 + 16 + 16 + 8;
__device__ __forceinline__ void conv_item(const ConvJob& c, float*, int item, int lane) {
    const int nblk = c.N / 128, kb = item / nblk, nb = item % nblk, r2 = lane >> 5, cc = lane & 31, k0 = 64 * kb + 32 * r2, n0 = 128 * nb + 4 * cc;
    f32x4 v[32];
    const float* src = c.W + (size_t)k0 * c.N + n0;
#pragma unroll
    for (int i = 0; i < 32; ++i) v[i] = *(const f32x4*)(src + (size_t)i * c.N);
    if (c.g) {
#pragma unroll
        for (int q = 0; q < 8; ++q) { const f32x4 g = *(const f32x4*)(c.g + k0 + 4 * q);
#pragma unroll
            for (int i = 0; i < 4; ++i) v[4 * q + i] = v[4 * q + i] * g[i]; } }
    if (c.s8 != 0.f) {
#pragma unroll
        for (int j = 0; j < 4; ++j) { const int nn = n0 + j; const int r = c.mode == 0 ? c.row_off + nn : 256 * (nn >> 7) + (nn & 127) + (c.mode == 2 ? 128 : 0);
            u32x4 o[2];
#pragma unroll
            for (int q = 0; q < 8; ++q) { int w = 0; w = __builtin_amdgcn_cvt_pk_fp8_f32(v[4 * q][j] * c.s8, v[4 * q + 1][j] * c.s8, w, false); w = __builtin_amdgcn_cvt_pk_fp8_f32(v[4 * q + 2][j] * c.s8, v[4 * q + 3][j] * c.s8, w, true); o[q >> 2][q & 3] = (unsigned)w; }
            u32x4* dst = (u32x4*)((unsigned char*)c.WT + (size_t)r * c.K + k0); dst[0] = o[0]; dst[1] = o[1]; }
        return; }
#pragma unroll
    for (int j = 0; j < 4; ++j) { const int nn = n0 + j; const int r = c.mode == 0 ? c.row_off + nn : 256 * (nn >> 7) + (nn & 127) + (c.mode == 2 ? 128 : 0);
        u32x4 o[4];
#pragma unroll
        for (int q = 0; q < 16; ++q) o[q >> 2][q & 3] = pk2(v[2 * q][j], v[2 * q + 1][j]);
        u32x4* dst = (u32x4*)(c.WT + (size_t)r * c.K + k0); dst[0] = o[0]; dst[1] = o[1]; dst[2] = o[2]; dst[3] = o[3]; }
}
__device__ __forceinline__ void convert_body(const Args& a, float* scr, int gw, int NGW, int lane) {
    int base = 0;
    for (int j = 0; j < NJOBS; ++j) { ConvJob c; if (!conv_job(a, j, c)) break; const int items = (c.K / 64) * (c.N / 128);
        int first = (gw - base) % NGW; if (first < 0) first += NGW;
        for (int it = first; it < items; it += NGW) conv_item(c, scr, it, lane);
        base = (base + items) % NGW; }
}
__global__ __launch_bounds__(256) void k_convert(Args a) {
    __shared__ float scr_all[4][64 * 33];
    const int lane = threadIdx.x & 63, w = threadIdx.x >> 6;
    convert_body(a, scr_all[w], blockIdx.x * 4 + w, gridDim.x * 4, lane);
}

__device__ __forceinline__ void rowprep_body(const float* x, u16* hb, float* ssp, int gw, int NGW, int lane) {
    for (int r = gw; r < M; r += NGW) {
        const f32x4* xr = (const f32x4*)(x + (size_t)r * D) + lane * 4; float s = 0.f; u32x4 o0, o1;
        f32x4 v0 = xr[0], v1 = xr[1], v2 = xr[2], v3 = xr[3];
        s = (v0[0] * v0[0] + v0[1] * v0[1]) + (v0[2] * v0[2] + v0[3] * v0[3]) + (v1[0] * v1[0] + v1[1] * v1[1]) + (v1[2] * v1[2] + v1[3] * v1[3])
          + (v2[0] * v2[0] + v2[1] * v2[1]) + (v2[2] * v2[2] + v2[3] * v2[3]) + (v3[0] * v3[0] + v3[1] * v3[1]) + (v3[2] * v3[2] + v3[3] * v3[3]);
        o0.x = pk2(v0[0], v0[1]); o0.y = pk2(v0[2], v0[3]); o0.z = pk2(v1[0], v1[1]); o0.w = pk2(v1[2], v1[3]);
        o1.x = pk2(v2[0], v2[1]); o1.y = pk2(v2[2], v2[3]); o1.z = pk2(v3[0], v3[1]); o1.w = pk2(v3[2], v3[3]);
        u32x4* orow = (u32x4*)(hb + (size_t)r * D) + lane * 2; orow[0] = o0; orow[1] = o1;
        s += __shfl_xor(s, 1); s += __shfl_xor(s, 2); s += __shfl_xor(s, 4); s += __shfl_xor(s, 8);
        if ((lane & 15) == 0) ssp[4 * (size_t)r + (lane >> 4)] = s;
    }
}
__global__ __launch_bounds__(256) void k_rowprep(const float* x, u16* hb, float* ssp) { rowprep_body(x, hb, ssp, blockIdx.x * 4 + (threadIdx.x >> 6), gridDim.x * 4, threadIdx.x & 63); }
__global__ __launch_bounds__(256) void k_ssp(const float* h, float* ssp) {
    const int lane = threadIdx.x & 63, gw = blockIdx.x * 4 + (threadIdx.x >> 6), NGW = gridDim.x * 4;
    for (int r = gw; r < M; r += NGW) {
        const f32x4* xr = (const f32x4*)(h + (size_t)r * D) + lane * 4; float s = 0.f;
#pragma unroll
        for (int j = 0; j < 4; ++j) { const f32x4 v = xr[j]; s += (v[0] * v[0] + v[1] * v[1]) + (v[2] * v[2] + v[3] * v[3]); }
        s += __shfl_xor(s, 1); s += __shfl_xor(s, 2); s += __shfl_xor(s, 4); s += __shfl_xor(s, 8);
        if ((lane & 15) == 0) ssp[4 * (size_t)r + (lane >> 4)] = s;
    }
}

__device__ __forceinline__ void slot_info(const unsigned* cnt, int slot, int& e, int& pos, int& n) {
    int base = 0; e = -1; pos = 0; n = 0;
#pragma unroll
    for (int i = 0; i < NE; ++i) { const int c = (int)cnt[i], rows = ((c + 255) >> 8) << 8; if (e < 0 && slot < base + rows) { e = i; pos = slot - base; n = c; } base += rows; }
}

template <class E> __global__ __launch_bounds__(256) void k_ngemm(E e, int K) {
    const int lane = threadIdx.x & 63, w = threadIdx.x >> 6, fr = lane & 15, fq = lane >> 4;
    const int rb = blockIdx.y * 64, r0 = rb + (w >> 1) * 32, c0 = blockIdx.x * 64 + (w & 1) * 32;
    if (!e.tile_ok(rb)) return;
    constexpr int NP = E::PAIR ? 2 : 1;
    const u16* ap[2]; const u16* bp[2][NP];
#pragma unroll
    for (int i = 0; i < 2; ++i) ap[i] = e.a_row(r0 + 16 * i + fr) + 8 * fq;
#pragma unroll
    for (int j = 0; j < 2; ++j)
#pragma unroll
        for (int p = 0; p < NP; ++p) bp[j][p] = e.b_row(c0 + 16 * j + fr, p, rb) + 8 * fq;
    f32x4 acc[2][2][NP];
#pragma unroll
    for (int i = 0; i < 2; ++i)
#pragma unroll
        for (int j = 0; j < 2; ++j)
#pragma unroll
            for (int p = 0; p < NP; ++p) acc[i][j][p] = (f32x4){0.f, 0.f, 0.f, 0.f};
    for (int k = 0; k < K; k += 32) {
        bf16x8 av[2], bv[2][NP];
#pragma unroll
        for (int i = 0; i < 2; ++i) av[i] = *(const bf16x8*)(ap[i] + k);
#pragma unroll
        for (int j = 0; j < 2; ++j)
#pragma unroll
            for (int p = 0; p < NP; ++p) bv[j][p] = *(const bf16x8*)(bp[j][p] + k);
#pragma unroll
        for (int i = 0; i < 2; ++i)
#pragma unroll
            for (int j = 0; j < 2; ++j)
#pragma unroll
                for (int p = 0; p < NP; ++p) acc[i][j][p] = __builtin_amdgcn_mfma_f32_16x16x32_bf16(av[i], bv[j][p], acc[i][j][p], 0, 0, 0);
    }
#pragma unroll
    for (int i = 0; i < 2; ++i)
#pragma unroll
        for (int j = 0; j < 2; ++j)
#pragma unroll
            for (int q = 0; q < 4; ++q) { const float v0 = acc[i][j][0][q], v1 = E::PAIR ? acc[i][j][NP - 1][q] : 0.f; const float pv = __shfl_xor(v0, 8);
                e.store(r0 + 16 * i + 4 * fq + q, c0 + 16 * j + fr, v0, v1, pv); }
}

struct NE_Proj {
    static constexpr bool PAIR = false;
    const u16* A; const u16* Bt; const float* ssp; u16* Y; u16* XB;
    __device__ bool tile_ok(int) const { return true; }
    __device__ const u16* a_row(int r) const { return A + (size_t)r * D; }
    __device__ const u16* b_row(int c, int, int) const { return Bt + (size_t)c * D; }
    __device__ void store(int r, int c, float v, float, float) const { v *= rstd_of(ssp, r); if (c < 1024) Y[(size_t)r * D + c] = (u16)f2bf(gelu_tanh(v)); else XB[(size_t)r * D + c - 1024] = (u16)f2bf(v); }
};
struct NE_Gates {
    static constexpr bool PAIR = true;
    const u16* XC; const u16* WAX; const float* b_a; const float* b_x; const float* spl; float* LA; float* BX;
    __device__ bool tile_ok(int) const { return true; }
    __device__ const u16* a_row(int r) const { return XC + (size_t)r * D + 128 * blockIdx.z; }
    __device__ const u16* b_row(int c, int p, int) const { return WAX + ((size_t)blockIdx.z * 256 + c + 128 * p) * 128; }
    __device__ void store(int r, int c, float vr, float vi, float) const { const int ch = 128 * blockIdx.z + c;
        const float rg = sigmoidf_(vr + b_a[ch]), ig = sigmoidf_(vi + b_x[ch]), la = -8.0f * rg * spl[ch], xc = bf2f(XC[(size_t)r * D + ch]);
        LA[(size_t)r * D + ch] = la; BX[(size_t)r * D + ch] = sqrtf(one_minus_exp(2.0f * la)) * (ig * xc); }
};
struct NE_Res {
    static constexpr bool PAIR = false;
    const u16* A; const u16* Bt; int K; const float* Hin; float* Hout; u16* HB; const float* bias;
    __device__ bool tile_ok(int) const { return true; }
    __device__ const u16* a_row(int r) const { return A + (size_t)r * K; }
    __device__ const u16* b_row(int c, int, int) const { return Bt + (size_t)c * K; }
    __device__ void store(int r, int c, float v, float, float) const { const float h = (Hin ? Hin[(size_t)r * D + c] : bf2f(HB[(size_t)r * D + c])) + v + (bias ? bias[c] : 0.f); Hout[(size_t)r * D + c] = h; HB[(size_t)r * D + c] = (u16)f2bf(h); }
};
struct NE_GateUp {
    static constexpr bool PAIR = true;
    const u16* A; const u16* Bt; const float* ssp; u16* ACT;
    __device__ bool tile_ok(int) const { return true; }
    __device__ const u16* a_row(int r) const { return A + (size_t)r * D; }
    __device__ const u16* b_row(int c, int p, int) const { return Bt + (size_t)(256 * (c >> 7) + (c & 127) + 128 * p) * D; }
    __device__ void store(int r, int c, float g, float u, float) const { const float rs = rstd_of(ssp, r); ACT[(size_t)r * DFF + c] = (u16)f2bf(silu_(rs * g) * (rs * u)); }
};
struct NE_QKV {
    static constexpr bool PAIR = false;
    const u16* A; const u16* Bt; const float* ssp; const float* bias; const u16* rope; u16* Q; u16* Kb; u16* Vb;
    __device__ bool tile_ok(int) const { return true; }
    __device__ const u16* a_row(int r) const { return A + (size_t)r * D; }
    __device__ const u16* b_row(int c, int, int) const { return Bt + (size_t)c * D; }
    __device__ void store(int r, int c, float v, float, float pv) const {
        const float rs = rstd_of(ssp, r); v = rs * v + bias[c]; pv = rs * pv + bias[c ^ 8];
        const int d = c & 63;
        if (c < 1280 && d < 16) { const float cs = bf2f(rope[(size_t)r * 16 + (d & 7)]), sn = bf2f(rope[(size_t)r * 16 + 8 + (d & 7)]); v = d < 8 ? v * cs - pv * sn : v * cs + pv * sn; }
        if (c < 1024) Q[(size_t)r * D + c] = (u16)f2bf(v * (0.125f * LOG2E));
        else if (c < 1280) Kb[(size_t)r * KVD + c - 1024] = (u16)f2bf(v);
        else Vb[(size_t)r * KVD + c - 1280] = (u16)f2bf(v);
    }
};
struct NE_MoeUp {
    static constexpr bool PAIR = true;
    const u16* HB; const u16* WGU2; const float* ssp; const unsigned* cnt; const int* list; const float* gatew; u16* ACT2;
    __device__ bool tile_ok(int rb) const { int e, pos, n; slot_info(cnt, rb, e, pos, n); return e >= 0; }
    __device__ const u16* a_row(int r) const { int e, pos, n; slot_info(cnt, r, e, pos, n); const int tok = (e >= 0 && pos < n) ? (list[((size_t)e * M + pos) * 4] >> 1) : 0; return HB + (size_t)tok * D; }
    __device__ const u16* b_row(int c, int p, int rb) const { int e, pos, n; slot_info(cnt, rb, e, pos, n); return WGU2 + ((size_t)e * 7168 + 256 * (c >> 7) + (c & 127) + 128 * p) * D; }
    __device__ void store(int r, int c, float g, float u, float) const { int e, pos, n; slot_info(cnt, r, e, pos, n); float o = 0.f;
        if (e >= 0 && pos < n) { const int tok = list[((size_t)e * M + pos) * 4] >> 1; const float rs = rstd_of(ssp, tok); o = silu_(rs * g) * (rs * u) * gatew[((size_t)e * M + pos) * 4 + 1]; }
        ACT2[(size_t)r * DFF + c] = (u16)f2bf(o); }
};
struct NE_MoeDown {
    static constexpr bool PAIR = false;
    const u16* ACT2; const u16* WD2; const unsigned* cnt; const int* list; u16* MO;
    __device__ bool tile_ok(int rb) const { int e, pos, n; slot_info(cnt, rb, e, pos, n); return e >= 0; }
    __device__ const u16* a_row(int r) const { return ACT2 + (size_t)r * DFF; }
    __device__ const u16* b_row(int c, int, int rb) const { int e, pos, n; slot_info(cnt, rb, e, pos, n); return WD2 + ((size_t)e * 1024 + c) * DFF; }
    __device__ void store(int r, int c, float v, float, float) const { int e, pos, n; slot_info(cnt, r, e, pos, n);
        if (e >= 0 && pos < n) { const int tk = list[((size_t)e * M + pos) * 4]; MO[((size_t)(tk & 1) * M + (tk >> 1)) * D + c] = (u16)f2bf(v); } }
};

__global__ void k_conv1d(const u16* XB, const float* cw, const float* cb, u16* XC) {
    const size_t i = (size_t)blockIdx.x * blockDim.x + threadIdx.x; if (i >= (size_t)M * D) return;
    const int t = (int)(i >> 10), c = (int)(i & 1023); float s = cb[c];
#pragma unroll
    for (int k = 0; k < 4; ++k) { const int tt = t - 3 + k; if (tt >= 0) s += bf2f(XB[(size_t)tt * D + c]) * cw[k * D + c]; }
    XC[i] = (u16)f2bf(s);
}
__global__ __launch_bounds__(64) void k_scan_seq(const float* LA, const float* BX, const u16* Y, u16* G) {
    const int c = blockIdx.x * 64 + threadIdx.x; float h = 0.f;
    for (int t0 = 0; t0 < M; t0 += 8) {
        float la[8], bx[8], y[8];
#pragma unroll
        for (int j = 0; j < 8; ++j) { la[j] = LA[(size_t)(t0 + j) * D + c]; bx[j] = BX[(size_t)(t0 + j) * D + c]; y[j] = bf2f(Y[(size_t)(t0 + j) * D + c]); }
#pragma unroll
        for (int j = 0; j < 8; ++j) { h = __expf(la[j]) * h + bx[j]; G[(size_t)(t0 + j) * D + c] = (u16)f2bf(h * y[j]); }
    }
}

__global__ __launch_bounds__(64) void k_attn_ref(const u16* Q, const u16* Kb, const u16* Vb, const float* sinks, u16* ATT) {
    const int i = blockIdx.x * 64 + threadIdx.x; const int h = i / M, t = i % M, kvh = h >> 2;
    float q[64], o[64];
#pragma unroll
    for (int d = 0; d < 64; d += 2) { const unsigned w = *(const unsigned*)(Q + (size_t)t * D + 64 * h + d); q[d] = bf2f(w & 0xffffu); q[d + 1] = bf2f(w >> 16); o[d] = 0.f; o[d + 1] = 0.f; }
    float m = sinks[h] * LOG2E, l = 1.0f;
    const int j0 = t - (WIN - 1) > 0 ? t - (WIN - 1) : 0;
    for (int j = j0; j <= t; ++j) {
        const u16* kr = Kb + (size_t)j * KVD + 64 * kvh; const u16* vr = Vb + (size_t)j * KVD + 64 * kvh; float s = 0.f;
#pragma unroll
        for (int d = 0; d < 64; d += 2) { const unsigned w = *(const unsigned*)(kr + d); s += q[d] * bf2f(w & 0xffffu) + q[d + 1] * bf2f(w >> 16); }
        const float mn = fmaxf(m, s), al = exp2f(m - mn), p = exp2f(s - mn); l = l * al + p; m = mn;
#pragma unroll
        for (int d = 0; d < 64; d += 2) { const unsigned w = *(const unsigned*)(vr + d); o[d] = o[d] * al + p * bf2f(w & 0xffffu); o[d + 1] = o[d + 1] * al + p * bf2f(w >> 16); }
    }
    const float il = 1.0f / l;
#pragma unroll
    for (int d = 0; d < 64; d += 2) *(unsigned*)(ATT + (size_t)t * D + 64 * h + d) = pk2(o[d] * il, o[d + 1] * il);
}

__device__ __forceinline__ void router_group(const u16* HB, const float* WR, const float* ssp, unsigned* cnt, int* list, float* gatew, int grp, float* lds  ) {
    const int lane = threadIdx.x & 63, w = threadIdx.x >> 6;
    for (int tt = 0; tt < 8; ++tt) {
        const int tl = 8 * w + tt, t = 64 * grp + tl;
        const u32x4* hr = (const u32x4*)(HB + (size_t)t * D + 16 * lane); const u32x4 h0 = hr[0], h1 = hr[1];
        float x[16];
        x[0] = bf2f(h0.x & 0xffffu); x[1] = bf2f(h0.x >> 16); x[2] = bf2f(h0.y & 0xffffu); x[3] = bf2f(h0.y >> 16); x[4] = bf2f(h0.z & 0xffffu); x[5] = bf2f(h0.z >> 16); x[6] = bf2f(h0.w & 0xffffu); x[7] = bf2f(h0.w >> 16);
        x[8] = bf2f(h1.x & 0xffffu); x[9] = bf2f(h1.x >> 16); x[10] = bf2f(h1.y & 0xffffu); x[11] = bf2f(h1.y >> 16); x[12] = bf2f(h1.z & 0xffffu); x[13] = bf2f(h1.z >> 16); x[14] = bf2f(h1.w & 0xffffu); x[15] = bf2f(h1.w >> 16);
        float lg[8];
#pragma unroll
        for (int e = 0; e < 8; ++e) { const float* wr = WR + e * 1024 + 16 * lane; float s = 0.f;
#pragma unroll
            for (int k = 0; k < 16; ++k) s += x[k] * wr[k];
            lg[e] = wave_sum(s); }
        if (lane == 0) {
            const float rs = rstd_of(ssp, t);
            int e1 = 0; float v1 = lg[0];
#pragma unroll
            for (int e = 1; e < 8; ++e) if (lg[e] > v1) { v1 = lg[e]; e1 = e; }
            int e2 = -1; float v2 = -3.0e38f;
#pragma unroll
            for (int e = 0; e < 8; ++e) if (e != e1 && lg[e] > v2) { v2 = lg[e]; e2 = e; }
            const float g1 = 1.0f / (1.0f + __expf((v2 - v1) * rs));
            lds[tl * 4 + 0] = __builtin_bit_cast(float, e1); lds[tl * 4 + 1] = __builtin_bit_cast(float, e2); lds[tl * 4 + 2] = g1; lds[tl * 4 + 3] = 1.0f - g1;
        }
    }
    __syncthreads();
    if (w == 0) {
        const int e1 = __builtin_bit_cast(int, lds[lane * 4 + 0]), e2 = __builtin_bit_cast(int, lds[lane * 4 + 1]); const float g1 = lds[lane * 4 + 2], g2 = lds[lane * 4 + 3];
        const int t = 64 * grp + lane; const unsigned long long lt = (1ull << lane) - 1ull; const float rsl = rstd_of(ssp, t);
        for (int e = 0; e < 8; ++e) {
            const unsigned long long m1 = __ballot(e1 == e), m2 = __ballot(e2 == e); const int n1 = __popcll(m1), n2 = __popcll(m2);
            unsigned base = 0; if (lane == 0 && n1 + n2 > 0) base = atomicAdd(cnt + e, (unsigned)(n1 + n2));
            base = __shfl(base, 0);
            if (e1 == e) { const unsigned p = base + __popcll(m1 & lt); u32x4 r; r.x = (unsigned)(2 * t); r.y = __builtin_bit_cast(unsigned, g1); r.z = __builtin_bit_cast(unsigned, rsl); r.w = 0u; *(u32x4*)(list + ((size_t)e * M + p) * 4) = r; }
            if (e2 == e) { const unsigned p = base + n1 + __popcll(m2 & lt); u32x4 r; r.x = (unsigned)(2 * t + 1); r.y = __builtin_bit_cast(unsigned, g2); r.z = __builtin_bit_cast(unsigned, rsl); r.w = 0u; *(u32x4*)(list + ((size_t)e * M + p) * 4) = r; }
        }
    }
    __syncthreads();
}
__global__ __launch_bounds__(512) void k_router(Args a) {
    __shared__ float lds[64 * 4];
    unsigned* cnt = (unsigned*)(a.ws + WS_CTL) + CW_CNT;
    for (int g = blockIdx.x; g < M / 64; g += gridDim.x)
        router_group((const u16*)(a.ws + WS_HB), (const float*)(a.ws + WS_WR), (const float*)(a.ws + WS_SSP + 3 * 256 * 1024), cnt, (int*)(a.ws + WS_LIST), (float*)(a.ws + WS_GATEW), g, lds);
}

__device__ __forceinline__ void final_body(float* H, const u16* HBr, const u16* MO, const float* g, int gw, int NGW, int lane) {
    for (int r = gw; r < M; r += NGW) {
        f32x4 v[4]; float s = 0.f;
#pragma unroll
        for (int j = 0; j < 4; ++j) { const int c = 256 * j + 4 * lane; { const u32x2 hb = *(const u32x2*)(HBr + (size_t)r * D + c); v[j] = (f32x4){bf2f(hb.x & 0xffffu), bf2f(hb.x >> 16), bf2f(hb.y & 0xffffu), bf2f(hb.y >> 16)}; }
            const u32x2 a0 = *(const u32x2*)(MO + (size_t)r * D + c), a1 = *(const u32x2*)(MO + ((size_t)M + r) * D + c);
            v[j][0] += bf2f(a0.x & 0xffffu) + bf2f(a1.x & 0xffffu); v[j][1] += bf2f(a0.x >> 16) + bf2f(a1.x >> 16); v[j][2] += bf2f(a0.y & 0xffffu) + bf2f(a1.y & 0xffffu); v[j][3] += bf2f(a0.y >> 16) + bf2f(a1.y >> 16);
            s += (v[j][0] * v[j][0] + v[j][1] * v[j][1]) + (v[j][2] * v[j][2] + v[j][3] * v[j][3]); }
        const float rs = rsqrtf(wave_sum(s) * (1.0f / D) + EPS);
#pragma unroll
        for (int j = 0; j < 4; ++j) { const int c = 256 * j + 4 * lane; const f32x4 gg = *(const f32x4*)(g + c); *(f32x4*)(H + (size_t)r * D + c) = v[j] * rs * gg; }
    }
}
__global__ __launch_bounds__(256) void k_final(float* H, const u16* HBr, const u16* MO, const float* g) { final_body(H, HBr, MO, g, blockIdx.x * 4 + (threadIdx.x >> 6), gridDim.x * 4, threadIdx.x & 63); }

#define LAS __attribute__((address_space(3)))
typedef float f32x16 __attribute__((ext_vector_type(16)));
typedef short s16x4 __attribute__((ext_vector_type(4)));
typedef float f32x2v_t __attribute__((ext_vector_type(2)));
__device__ __forceinline__ unsigned cvt_pk_bf16(float lo, float hi) { unsigned r; asm volatile("v_cvt_pk_bf16_f32 %0, %1, %2" : "=v"(r) : "v"(lo), "v"(hi)); return r; }
__device__ __forceinline__ float fexp2(float x) { return __builtin_amdgcn_exp2f(x); }
__device__ __forceinline__ float frcp(float x) { return __builtin_amdgcn_rcpf(x); }
__device__ __forceinline__ float fsigmoid(float x) { return frcp(1.0f + fexp2(-LOG2E * x)); }
__device__ __forceinline__ float fsilu(float x) { return x * frcp(1.0f + fexp2(-LOG2E * x)); }
__device__ __forceinline__ float fgelu_tanh(float x) { const float z = 0.7978845608028654f * (x + 0.044715f * x * x * x); return x * frcp(1.0f + fexp2(-2.0f * LOG2E * z)); }

__device__ __forceinline__ u32x2 pk8_fp8(const float (&o)[8], float sc) {
    float t[8];
#pragma unroll
    for (int i = 0; i < 8; ++i) t[i] = __builtin_fminf(__builtin_fmaxf(o[i] * sc, -448.0f), 448.0f);
    int w0 = 0, w1 = 0; w0 = __builtin_amdgcn_cvt_pk_fp8_f32(t[0], t[1], w0, false); w0 = __builtin_amdgcn_cvt_pk_fp8_f32(t[2], t[3], w0, true);
    w1 = __builtin_amdgcn_cvt_pk_fp8_f32(t[4], t[5], w1, false); w1 = __builtin_amdgcn_cvt_pk_fp8_f32(t[6], t[7], w1, true);
    u32x2 r; r.x = (unsigned)w0; r.y = (unsigned)w1; return r;
}
constexpr int RING_BYTES = 131072;
constexpr int LX_P = RING_BYTES;
constexpr int LX_TBL = RING_BYTES + 4096;
constexpr int LX_ROUT = RING_BYTES + 8192;
constexpr int LX_MISC = RING_BYTES + 12288;
constexpr int LDS_BYTES = 147456;

namespace pg8 {
constexpr int BM = 256, BK = 64, HALF = 128, HTB = HALF * BK * 2, STAGE_BYTES = 8 * HTB, NXCD = 8, WGM = 8;
__device__ __forceinline__ int lds_byte(int r, int c) { const int st = (r >> 4) * 2 + (c >> 5), rr = r & 15, cc = c & 31, ob = rr * 64 + cc * 2; return st * 1024 + (ob ^ (((ob >> 9) & 1) << 5)); }
__device__ __forceinline__ void stage_rc(int b, int& R, int& C) { const int st = b / 1024, sb = b % 1024, swz = sb ^ (((sb >> 9) & 1) << 5); R = (st >> 1) * 16 + swz / 64; C = (st & 1) * 32 + (swz % 64) / 2; }
__device__ __forceinline__ int perm32(int rho) { const int n = rho >> 4, i = rho & 15; return 8 * (i >> 2) + 4 * n + (i & 3); }

struct Unit { int pm, pn, e; };
struct TileOrder {
    int nM, nN, nwg, G, c;
    __device__ __forceinline__ void init(int nM_, int nN_, int G_, int c_) { nM = nM_; nN = nN_; nwg = nM * nN; G = G_; c = c_; }
    __device__ __forceinline__ bool next_tile(int i, int& pm, int& pn) const {
        const long L = (long)i * G + c; if (L >= nwg) return false;
        int wgid = (int)L; { const int q = nwg / NXCD, r = nwg % NXCD, xcd = wgid % NXCD, off = wgid / NXCD; wgid = (xcd < r ? xcd * (q + 1) : r * (q + 1) + (xcd - r) * q) + off; }
        const int nig = WGM * nN, gid = wgid / nig, fm = gid * WGM, gsz = (nM - fm) < WGM ? (nM - fm) : WGM;
        pm = fm + ((wgid % nig) % gsz); pn = (wgid % nig) / gsz; return true;
    }
};
struct DenseSched {
    TileOrder o; const char* A; const char* Bt; int K;
    __device__ __forceinline__ bool next(int i, Unit& u) const { u.e = 0; return o.next_tile(i, u.pm, u.pn); }
    __device__ __forceinline__ const char* a_base(const Unit& u) const { return A + (size_t)u.pm * 256 * K * 2; }
    __device__ __forceinline__ const char* b_base(const Unit& u) const { return Bt + (size_t)u.pn * 256 * K * 2; }
    __device__ __forceinline__ unsigned a_off(const Unit&, int) const { return 0u; }
};
struct MoeSched {
    TileOrder o; const char* A; const char* Bt; int K; size_t bstride; const int* list; const LAS int* tbl;
    __device__ __forceinline__ bool next(int i, Unit& u) const {
        if (!o.next_tile(i, u.pm, u.pn)) return false;
        int e = 0;
#pragma unroll
        for (int j = 1; j < 8; ++j) e += (u.pm >= tbl[8 + j]) ? 1 : 0;
        u.e = __builtin_amdgcn_readfirstlane(e); return true;
    }
    __device__ __forceinline__ const char* a_base(const Unit& u) const { return list ? A : A + (size_t)u.pm * 256 * K * 2; }
    __device__ __forceinline__ const char* b_base(const Unit& u) const { return Bt + (size_t)u.e * bstride + (size_t)u.pn * 256 * K * 2; }
    __device__ __forceinline__ unsigned a_off(const Unit& u, int rl) const {
        const int pos = (u.pm - tbl[8 + u.e]) * 256 + rl; const int tok = list[((size_t)u.e * M + (pos < tbl[u.e] ? pos : 0)) * 4] >> 1; return (unsigned)tok * (unsigned)(K * 2);
    }
};
struct EpiCtx { int wr, wc, fr, fq, tid; LAS unsigned char* lds; };
typedef int i32x4 __attribute__((ext_vector_type(4)));
typedef int i32x8 __attribute__((ext_vector_type(8)));
__device__ __forceinline__ i32x8 cat8(bf16x8 lo, bf16x8 hi) { return __builtin_shufflevector(__builtin_bit_cast(i32x4, lo), __builtin_bit_cast(i32x4, hi), 0, 1, 2, 3, 4, 5, 6, 7); }
#define ACC_T const f32x4 (&acc)[2][2][4][2]

struct EpiProj {
    const float* ssp; u16* Y; u16* XB;
    __device__ __forceinline__ void operator()(ACC_T, const Unit& u, const EpiCtx& c) const {
        const int row0 = u.pm * 256 + c.wr * 64 + c.fr; const bool isY = u.pn < 4; u16* base = isY ? Y : XB; const int col0 = (u.pn & 3) * 256 + c.wc * 32 + 8 * c.fq;
        float rsv[8];
#pragma unroll
        for (int i = 0; i < 8; ++i) rsv[i] = rstd_of(ssp, row0 + (i >> 2) * 128 + (i & 3) * 16);
#pragma unroll
        for (int ai = 0; ai < 2; ++ai)
#pragma unroll
            for (int m = 0; m < 4; ++m) { const int row = row0 + ai * 128 + m * 16; const float rs = rsv[ai * 4 + m]; u16* rowp = base + (size_t)row * D + col0;
#pragma unroll
                for (int bj = 0; bj < 2; ++bj) { f32x4 v0 = acc[ai][bj][m][0] * rs, v1 = acc[ai][bj][m][1] * rs;
                    if (isY) {
#pragma unroll
                        for (int j = 0; j < 4; ++j) { v0[j] = fgelu_tanh(v0[j]); v1[j] = fgelu_tanh(v1[j]); } }
                    u32x4 w; w.x = cvt_pk_bf16(v0[0], v0[1]); w.y = cvt_pk_bf16(v0[2], v0[3]); w.z = cvt_pk_bf16(v1[0], v1[1]); w.w = cvt_pk_bf16(v1[2], v1[3]);
                    *(u32x4*)(rowp + bj * 128) = w; } }
    }
};
struct EpiGateUp {
    const float* ssp; u16* ACT;
    __device__ __forceinline__ void operator()(ACC_T, const Unit& u, const EpiCtx& c) const {
        const int row0 = u.pm * 256 + c.wr * 64 + c.fr, col0 = u.pn * 128 + c.wc * 32 + 8 * c.fq;
        float rsv[8];
#pragma unroll
        for (int i = 0; i < 8; ++i) rsv[i] = rstd_of(ssp, row0 + (i >> 2) * 128 + (i & 3) * 16);
#pragma unroll
        for (int ai = 0; ai < 2; ++ai)
#pragma unroll
            for (int m = 0; m < 4; ++m) { const int row = row0 + ai * 128 + m * 16; const float rs = rsv[ai * 4 + m]; float o[8];
#pragma unroll
                for (int n = 0; n < 2; ++n)
#pragma unroll
                    for (int j = 0; j < 4; ++j) o[4 * n + j] = fsilu(acc[ai][0][m][n][j] * rs) * (acc[ai][1][m][n][j] * rs);
                u32x4 w; w.x = cvt_pk_bf16(o[0], o[1]); w.y = cvt_pk_bf16(o[2], o[3]); w.z = cvt_pk_bf16(o[4], o[5]); w.w = cvt_pk_bf16(o[6], o[7]);
                *(u32x4*)(ACT + (size_t)row * DFF + col0) = w; }
    }
};
struct EpiRes {
    const float* Xin; u16* HB; const float* bias; float* ssp; unsigned char* HB8;
    __device__ __forceinline__ void operator()(ACC_T, const Unit& u, const EpiCtx& c) const {
        const int col0 = u.pn * 256 + c.wc * 32 + 8 * c.fq;
        f32x4 bv[2][2];
#pragma unroll
        for (int bj = 0; bj < 2; ++bj)
#pragma unroll
            for (int n = 0; n < 2; ++n) { bv[bj][n] = (f32x4){0.f, 0.f, 0.f, 0.f}; if (bias) bv[bj][n] = *(const f32x4*)(bias + col0 + bj * 128 + 4 * n); }
        LAS float* P = (LAS float*)(c.lds + LX_P);
#pragma unroll
        for (int g = 0; g < 4; ++g) {
            f32x4 hin[2][2][2];
#pragma unroll
            for (int q = 0; q < 2; ++q) { const int ai = g >> 1, m = (g & 1) * 2 + q; const size_t off = (size_t)(u.pm * 256 + ai * 128 + c.wr * 64 + m * 16 + c.fr) * D + col0;
#pragma unroll
                for (int bj = 0; bj < 2; ++bj) {
                    if (Xin) { hin[q][bj][0] = *(const f32x4*)(Xin + off + bj * 128); hin[q][bj][1] = *(const f32x4*)(Xin + off + bj * 128 + 4); }
                    else { const u32x4 hb = *(const u32x4*)(HB + off + bj * 128);
                        hin[q][bj][0] = (f32x4){bf2f(hb.x & 0xffffu), bf2f(hb.x >> 16), bf2f(hb.y & 0xffffu), bf2f(hb.y >> 16)}; hin[q][bj][1] = (f32x4){bf2f(hb.z & 0xffffu), bf2f(hb.z >> 16), bf2f(hb.w & 0xffffu), bf2f(hb.w >> 16)}; } } }
#pragma unroll
            for (int q = 0; q < 2; ++q) { const int ai = g >> 1, m = (g & 1) * 2 + q; const int rl = ai * 128 + c.wr * 64 + m * 16 + c.fr; const size_t off = (size_t)(u.pm * 256 + rl) * D + col0; float s = 0.f;
#pragma unroll
                for (int bj = 0; bj < 2; ++bj) {
                    const f32x4 h0 = hin[q][bj][0] + acc[ai][bj][m][0] + bv[bj][0], h1 = hin[q][bj][1] + acc[ai][bj][m][1] + bv[bj][1];
                    u32x4 w; w.x = cvt_pk_bf16(h0[0], h0[1]); w.y = cvt_pk_bf16(h0[2], h0[3]); w.z = cvt_pk_bf16(h1[0], h1[1]); w.w = cvt_pk_bf16(h1[2], h1[3]);
                    *(u32x4*)(HB + off + bj * 128) = w;
                    if (HB8) { const float o8[8] = {h0[0], h0[1], h0[2], h0[3], h1[0], h1[1], h1[2], h1[3]}; *(u32x2*)(HB8 + off + bj * 128) = pk8_fp8(o8, S8_A); }
                    s += ((h0[0] * h0[0] + h0[1] * h0[1]) + (h0[2] * h0[2] + h0[3] * h0[3])) + ((h1[0] * h1[0] + h1[1] * h1[1]) + (h1[2] * h1[2] + h1[3] * h1[3])); }
                s += __shfl_xor(s, 16); s += __shfl_xor(s, 32);
                if (c.fq == 0) P[rl * 4 + c.wc] = s; }
            asm volatile("" ::: "memory"); }
        asm volatile("s_waitcnt lgkmcnt(0)" ::: "memory"); __builtin_amdgcn_s_barrier(); asm volatile("" ::: "memory");
        if (c.tid < 256) { const f32x4 p = *(const LAS f32x4*)(P + 4 * c.tid); ssp[(size_t)(u.pm * 256 + c.tid) * 4 + u.pn] = (p[0] + p[1]) + (p[2] + p[3]); }
    }
};
struct EpiQKV {
    const float* ssp; const float* bias; const u16* rope; u16* Q; u16* Kb; u16* Vb;
    __device__ __forceinline__ void operator()(ACC_T, const Unit& u, const EpiCtx& c) const {
        const int row0 = u.pm * 256 + c.wr * 64 + c.fr, bcol0 = u.pn * 256 + c.wc * 32 + 8 * c.fq;
        u16* base; int pitch, col0; float sc = 1.0f;
        if (u.pn < 4) { base = Q; pitch = D; col0 = bcol0; sc = 0.125f * LOG2E; } else if (u.pn == 4) { base = Kb; pitch = KVD; col0 = bcol0 - 1024; } else { base = Vb; pitch = KVD; col0 = bcol0 - 1280; }
        const bool rot = (u.pn < 5) && ((c.wc & 1) == 0);
        f32x4 bv[2][2];
#pragma unroll
        for (int bj = 0; bj < 2; ++bj)
#pragma unroll
            for (int n = 0; n < 2; ++n) bv[bj][n] = *(const f32x4*)(bias + bcol0 + bj * 128 + 4 * n);
        float rsv[8];
#pragma unroll
        for (int i = 0; i < 8; ++i) rsv[i] = rstd_of(ssp, row0 + (i >> 2) * 128 + (i & 3) * 16);
#pragma unroll
        for (int g = 0; g < 4; ++g) {
            u32x4 rpv[2][2];
            if (rot) {
#pragma unroll
                for (int q2 = 0; q2 < 2; ++q2) { const u32x4* rp = (const u32x4*)(rope + (size_t)(row0 + (g >> 1) * 128 + ((g & 1) * 2 + q2) * 16) * 16); rpv[q2][0] = rp[0]; rpv[q2][1] = rp[1]; } }
#pragma unroll
            for (int q2 = 0; q2 < 2; ++q2) { const int ai = g >> 1, m = (g & 1) * 2 + q2; const int row = row0 + ai * 128 + m * 16; const float rs = rsv[ai * 4 + m];
                f32x4 cs0, cs1, sn0, sn1;
                if (rot) { const u32x4 cw = rpv[q2][0], sw = rpv[q2][1];
                    cs0 = (f32x4){bf2f(cw.x & 0xffffu), bf2f(cw.x >> 16), bf2f(cw.y & 0xffffu), bf2f(cw.y >> 16)}; cs1 = (f32x4){bf2f(cw.z & 0xffffu), bf2f(cw.z >> 16), bf2f(cw.w & 0xffffu), bf2f(cw.w >> 16)};
                    sn0 = (f32x4){bf2f(sw.x & 0xffffu), bf2f(sw.x >> 16), bf2f(sw.y & 0xffffu), bf2f(sw.y >> 16)}; sn1 = (f32x4){bf2f(sw.z & 0xffffu), bf2f(sw.z >> 16), bf2f(sw.w & 0xffffu), bf2f(sw.w >> 16)};
                    if (c.fq == 0) { sn0 = -sn0; sn1 = -sn1; } }
#pragma unroll
                for (int bj = 0; bj < 2; ++bj) { f32x4 v0 = acc[ai][bj][m][0] * rs + bv[bj][0], v1 = acc[ai][bj][m][1] * rs + bv[bj][1];
                    if (rot) { f32x4 p0, p1;
#pragma unroll
                        for (int j = 0; j < 4; ++j) { p0[j] = __shfl_xor(v0[j], 16); p1[j] = __shfl_xor(v1[j], 16); }
                        if (c.fq < 2) { v0 = v0 * cs0 + p0 * sn0; v1 = v1 * cs1 + p1 * sn1; } }
                    v0 = v0 * sc; v1 = v1 * sc;
                    u32x4 w; w.x = cvt_pk_bf16(v0[0], v0[1]); w.y = cvt_pk_bf16(v0[2], v0[3]); w.z = cvt_pk_bf16(v1[0], v1[1]); w.w = cvt_pk_bf16(v1[2], v1[3]);
                    *(u32x4*)(base + (size_t)row * pitch + col0 + bj * 128) = w; } } }
    }
};
struct EpiMoeUp {
    const float* ssp; const int* list; const float* gatew; const LAS int* tbl; u16* ACT2;
    __device__ __forceinline__ void operator()(ACC_T, const Unit& u, const EpiCtx& c) const {
        const int col0 = u.pn * 128 + c.wc * 32 + 8 * c.fq, n_e = tbl[u.e], pos0 = (u.pm - tbl[8 + u.e]) * 256;
        u32x4 rec[8];
#pragma unroll
        for (int i = 0; i < 8; ++i) { const int pos = pos0 + (i >> 2) * 128 + c.wr * 64 + (i & 3) * 16 + c.fr; rec[i] = *(const u32x4*)(list + ((size_t)u.e * M + (pos < n_e ? pos : 0)) * 4); }
#pragma unroll
        for (int ai = 0; ai < 2; ++ai)
#pragma unroll
            for (int m = 0; m < 4; ++m) { const int rl = ai * 128 + c.wr * 64 + m * 16 + c.fr;
                const bool valid = pos0 + rl < n_e; const unsigned gwu = rec[ai * 4 + m].y, rsu = rec[ai * 4 + m].z;
                const float gw = valid ? u2f(gwu) : 0.f; const float rs = u2f(rsu) * (MOE_FP8 ? 1.0f / (S8_A * S8_W) : 1.0f); float o[8];
#pragma unroll
                for (int n = 0; n < 2; ++n)
#pragma unroll
                    for (int j = 0; j < 4; ++j) o[4 * n + j] = fsilu(acc[ai][0][m][n][j] * rs) * (acc[ai][1][m][n][j] * rs) * gw;
                if (MOE_FP8) *(u32x2*)((unsigned char*)ACT2 + (size_t)(u.pm * 256 + rl) * DFF + col0) = pk8_fp8(o, S8_ACT);
                else { u32x4 w; w.x = cvt_pk_bf16(o[0], o[1]); w.y = cvt_pk_bf16(o[2], o[3]); w.z = cvt_pk_bf16(o[4], o[5]); w.w = cvt_pk_bf16(o[6], o[7]);
                    *(u32x4*)(ACT2 + (size_t)(u.pm * 256 + rl) * DFF + col0) = w; } }
    }
};
struct EpiMoeDown {
    const int* list; const LAS int* tbl; u16* MO;
    __device__ __forceinline__ void operator()(ACC_T, const Unit& u, const EpiCtx& c) const {
        const int col0 = u.pn * 256 + c.wc * 32 + 8 * c.fq, n_e = tbl[u.e], pos0 = (u.pm - tbl[8 + u.e]) * 256;
        int tkv[8];
#pragma unroll
        for (int i = 0; i < 8; ++i) { const int pos = pos0 + (i >> 2) * 128 + c.wr * 64 + (i & 3) * 16 + c.fr; const int v = list[((size_t)u.e * M + (pos < n_e ? pos : 0)) * 4]; tkv[i] = pos < n_e ? v : -1; }
#pragma unroll
        for (int ai = 0; ai < 2; ++ai)
#pragma unroll
            for (int m = 0; m < 4; ++m) {
                if (tkv[ai * 4 + m] >= 0) { const int tk = tkv[ai * 4 + m]; u16* dst = MO + ((size_t)(tk & 1) * M + (tk >> 1)) * D + col0;
#pragma unroll
                    for (int bj = 0; bj < 2; ++bj) { const float us = MOE_FP8 ? 1.0f / (S8_ACT * S8_WD) : 1.0f; const f32x4 v0 = acc[ai][bj][m][0] * us, v1 = acc[ai][bj][m][1] * us;
                        u32x4 w; w.x = cvt_pk_bf16(v0[0], v0[1]); w.y = cvt_pk_bf16(v0[2], v0[3]); w.z = cvt_pk_bf16(v1[0], v1[1]); w.w = cvt_pk_bf16(v1[2], v1[3]);
                        *(u32x4*)(dst + bj * 128) = w; } } }
    }
};

template <class Epi, class Sched, bool GATHER, bool FP8 = false>
__device__ __forceinline__ void gemm_phase(LAS unsigned char* lds, const int K, const Sched& S, const Epi& E) {
    const int tid = threadIdx.x, wid = __builtin_amdgcn_readfirstlane(tid >> 6), lane = tid & 63, wr = wid >> 2, wc = wid & 3, fr = lane & 15, fq = lane >> 4;
    const int nt = K / BK;
    EpiCtx ctx; ctx.wr = wr; ctx.wc = wc; ctx.fr = fr; ctx.fq = fq; ctx.tid = tid; ctx.lds = lds;
    unsigned voffA[2], voffB[2]; int RA[2]; unsigned CA[2];
#pragma unroll
    for (int i = 0; i < 2; ++i) { int R, C; stage_rc(tid * 16 + i * 8192, R, C); const int Rb = (R & ~31) + perm32(R & 31);
        voffA[i] = (unsigned)(R * K + C) * 2u; voffB[i] = (unsigned)(Rb * K + C) * 2u; RA[i] = R; CA[i] = (unsigned)C * 2u; }
    const size_t kstep = (size_t)(BK * 2);
    const size_t hstep = (size_t)HALF * K * 2;
    const unsigned ldsw = (unsigned)wid * 1024u;
    const int aoff = lds_byte(wr * 64 + fr, fq * 8), boff = lds_byte(wc * 32 + fr, fq * 8);
#define PG8_SA(b, h) (((b) * 2 + (h)) * HTB)
#define PG8_SB(b, h) ((4 + (b) * 2 + (h)) * HTB)
#define PG8_GLDS(src, dstoff) __builtin_amdgcn_global_load_lds((const unsigned*)(src), (LAS unsigned*)(lds + (dstoff)), 16, 0, 0)
#define PG8_STAGE_B(bufoff, gbase) do { _Pragma("unroll") for (int _i = 0; _i < 2; ++_i) PG8_GLDS((const char*)(gbase) + voffB[_i], (bufoff) + ldsw + _i * 8192); } while (0)
#define PG8_STAGE_A(bufoff, gk, h, VA) do { _Pragma("unroll") for (int _i = 0; _i < 2; ++_i) { \
        if constexpr (GATHER) PG8_GLDS((const char*)(gk) + VA[h][_i], (bufoff) + ldsw + _i * 8192); else PG8_GLDS((const char*)(gk) + (size_t)(h) * hstep + voffA[_i], (bufoff) + ldsw + _i * 8192); } } while (0)
#define PG8_LDA(dst, b, h) do { _Pragma("unroll") for (int m = 0; m < 4; ++m) _Pragma("unroll") for (int k = 0; k < 2; ++k) dst[m][k] = *(const LAS bf16x8*)(lds + PG8_SA(b, h) + aoff + m * 2048 + k * 1024); } while (0)
#define PG8_LDB(dst, b, h) do { _Pragma("unroll") for (int n = 0; n < 2; ++n) _Pragma("unroll") for (int k = 0; k < 2; ++k) dst[n][k] = *(const LAS bf16x8*)(lds + PG8_SB(b, h) + boff + n * 2048 + k * 1024); } while (0)
#define PG8_MMA(ai, bj, At, Bt) do { __builtin_amdgcn_s_setprio(1); _Pragma("unroll") for (int m = 0; m < 4; ++m) _Pragma("unroll") for (int n = 0; n < 2; ++n) { \
        if constexpr (FP8) asm volatile("v_mfma_scale_f32_16x16x128_f8f6f4 %0, %1, %2, %0, %3, %3 op_sel_hi:[0,0,0]" : "+v"(acc[ai][bj][m][n]) : "v"(cat8(Bt[n][0], Bt[n][1])), "v"(cat8(At[m][0], At[m][1])), "v"(one_scale)); \
        else { _Pragma("unroll") for (int k = 0; k < 2; ++k) acc[ai][bj][m][n] = __builtin_amdgcn_mfma_f32_16x16x32_bf16(Bt[n][k], At[m][k], acc[ai][bj][m][n], 0, 0, 0); } } \
        __builtin_amdgcn_s_setprio(0); } while (0)
#define PG8_WAIT_V(n) asm volatile("s_waitcnt vmcnt(" #n ")" ::: "memory")
#define PG8_WAIT_L(n) asm volatile("s_waitcnt lgkmcnt(" #n ")" ::: "memory")
#define PG8_BAR __builtin_amdgcn_s_barrier()
#define PG8_SCHED __builtin_amdgcn_sched_barrier(0)
    const int one_scale = 0x7f7f7f7f;
    Unit cur, nxt; int ui = 0;
    if (!S.next(0, cur)) return;
    f32x4 acc[2][2][4][2];
#pragma unroll
    for (int a = 0; a < 2; ++a)
#pragma unroll
        for (int b = 0; b < 2; ++b)
#pragma unroll
            for (int m = 0; m < 4; ++m)
#pragma unroll
                for (int n = 0; n < 2; ++n) acc[a][b][m][n] = (f32x4){0.f, 0.f, 0.f, 0.f};
    bf16x8 At[4][2], B0[2][2], B1[2][2];
    const char* cA = S.a_base(cur); const char* cB = S.b_base(cur);
    unsigned vaC[2][2], vaN[2][2];
#pragma unroll
    for (int h = 0; h < 2; ++h)
#pragma unroll
        for (int i = 0; i < 2; ++i) { vaC[h][i] = GATHER ? S.a_off(cur, h * HALF + RA[i]) + CA[i] : 0u; vaN[h][i] = vaC[h][i]; }
    PG8_STAGE_B(PG8_SB(0, 0), cB); PG8_STAGE_B(PG8_SB(0, 1), cB + hstep); PG8_STAGE_A(PG8_SA(0, 0), cA, 0, vaC); PG8_STAGE_A(PG8_SA(0, 1), cA, 1, vaC);
    if (wr == 1) PG8_BAR;
    PG8_WAIT_V(2); PG8_BAR;
    PG8_STAGE_B(PG8_SB(1, 0), cB + kstep); PG8_STAGE_A(PG8_SA(1, 0), cA + kstep, 0, vaC); PG8_STAGE_B(PG8_SB(1, 1), cB + hstep + kstep);
    PG8_WAIT_V(6); PG8_BAR;
    for (;;) {
        const bool has_next = S.next(ui + 1, nxt);
        const char* nA = has_next ? S.a_base(nxt) : cA; const char* nB = has_next ? S.b_base(nxt) : cB;
        if constexpr (GATHER) { if (has_next) {
#pragma unroll
            for (int h = 0; h < 2; ++h)
#pragma unroll
                for (int i = 0; i < 2; ++i) vaN[h][i] = S.a_off(nxt, h * HALF + RA[i]) + CA[i]; } }
#pragma unroll 1
        for (int t = 0; t < nt; t += 2) {
            const bool last = (t == nt - 2);
            const char* a1 = cA + (size_t)(t + 1) * kstep;
            const char* a2 = last ? nA : cA + (size_t)(t + 2) * kstep; const char* b2 = last ? nB : cB + (size_t)(t + 2) * kstep;
            const char* a3 = a2 + kstep; const char* b3 = b2 + kstep;
            unsigned v2[2][2];
#pragma unroll
            for (int h = 0; h < 2; ++h)
#pragma unroll
                for (int i = 0; i < 2; ++i) v2[h][i] = (GATHER && last) ? vaN[h][i] : vaC[h][i];
            PG8_LDB(B0, 0, 0); PG8_LDB(B1, 0, 1); PG8_SCHED; PG8_LDA(At, 0, 0); PG8_STAGE_A(PG8_SA(1, 1), a1, 1, vaC);
            PG8_WAIT_V(8); PG8_WAIT_L(0); PG8_BAR; PG8_MMA(0, 0, At, B0); PG8_MMA(0, 1, At, B1); PG8_BAR; PG8_SCHED;
            PG8_LDA(At, 0, 1); PG8_STAGE_B(PG8_SB(0, 0), b2); PG8_STAGE_B(PG8_SB(0, 1), b2 + hstep); PG8_STAGE_A(PG8_SA(0, 0), a2, 0, v2);
            PG8_WAIT_V(8); PG8_WAIT_L(0); PG8_BAR; PG8_MMA(1, 0, At, B0); PG8_MMA(1, 1, At, B1); PG8_BAR; PG8_SCHED;
            PG8_LDB(B0, 1, 0); PG8_LDB(B1, 1, 1); PG8_SCHED; PG8_LDA(At, 1, 0); PG8_STAGE_A(PG8_SA(0, 1), a2, 1, v2);
            PG8_WAIT_V(8); PG8_WAIT_L(0); PG8_BAR; PG8_MMA(0, 0, At, B0); PG8_MMA(0, 1, At, B1); PG8_BAR; PG8_SCHED;
            PG8_LDA(At, 1, 1); PG8_STAGE_B(PG8_SB(1, 0), b3); PG8_STAGE_B(PG8_SB(1, 1), b3 + hstep); PG8_STAGE_A(PG8_SA(1, 0), a3, 0, v2);
            PG8_WAIT_V(8); PG8_WAIT_L(0); PG8_BAR; PG8_MMA(1, 0, At, B0); PG8_MMA(1, 1, At, B1); PG8_BAR; PG8_SCHED;
        }
        if (wr == 0) PG8_BAR;
        E(acc, cur, ctx);
        if (!has_next) break;
#pragma unroll
        for (int a = 0; a < 2; ++a)
#pragma unroll
            for (int b = 0; b < 2; ++b)
#pragma unroll
                for (int m = 0; m < 4; ++m)
#pragma unroll
                    for (int n = 0; n < 2; ++n) acc[a][b][m][n] = (f32x4){0.f, 0.f, 0.f, 0.f};
        cur = nxt; cA = nA; cB = nB; ++ui;
#pragma unroll
        for (int h = 0; h < 2; ++h)
#pragma unroll
            for (int i = 0; i < 2; ++i) vaC[h][i] = vaN[h][i];
        if (wr == 1) PG8_BAR;
    }
    PG8_WAIT_V(0);
    PG8_BAR;
#undef PG8_SA
#undef PG8_SB
#undef PG8_GLDS
#undef PG8_STAGE_A
#undef PG8_STAGE_B
#undef PG8_LDA
#undef PG8_LDB
#undef PG8_MMA
#undef PG8_WAIT_V
#undef PG8_WAIT_L
#undef PG8_BAR
#undef PG8_SCHED
}
}

#define XB_TMO      128
#define XB_XCNT(j)  (256  + 64 * (j))
#define XB_XSUB(j)  (1280 + 64 * (j))
#define XB_XGEN(j)  (2304 + 64 * (j))
#define XB_TOP      3328
#define XB_TOPGEN   3392
#define XCD_BAR_WORDS 3456
#define XB_SPIN_CAP (1u << 18)
__device__ __forceinline__ unsigned xb_ld(unsigned* p)              { return __hip_atomic_load(p, __ATOMIC_RELAXED, __HIP_MEMORY_SCOPE_AGENT); }
__device__ __forceinline__ unsigned xb_add(unsigned* p, unsigned v) { return __hip_atomic_fetch_add(p, v, __ATOMIC_RELAXED, __HIP_MEMORY_SCOPE_AGENT); }
__device__ __forceinline__ unsigned xb_xcc_id() { return (unsigned)__builtin_amdgcn_s_getreg((3 << 11) | 20) & 0xFu; }
#define XB_SPIN(cond, bar) do { unsigned _sp = 0; while (cond) { __builtin_amdgcn_s_sleep(1); \
    if ((++_sp & 255u) == 0u) { if (xb_ld(&(bar)[XB_TMO])) break; if (_sp > XB_SPIN_CAP) { atomicAdd(&(bar)[XB_TMO], 1u); break; } } } } while (0)
struct XcdBarrier { unsigned* bar; unsigned x; volatile LAS unsigned* st; };
__device__ __forceinline__ XcdBarrier xcd_barrier_post(unsigned* bar, volatile LAS unsigned* st) {
    XcdBarrier b; b.bar = bar; b.x = xb_xcc_id(); b.st = st;
    if (threadIdx.x == 0) (void)xb_add(&bar[XB_XCNT(b.x)], 1u);
    return b;
}
__device__ __forceinline__ void xcd_barrier_complete(unsigned* bar, unsigned x, unsigned& nloc, unsigned& nx) {
    const unsigned G = gridDim.x * gridDim.y * gridDim.z;
    unsigned sum, cnt, mine, sp = 0u;
    for (;;) {
        sum = 0u; cnt = 0u; mine = 0u;
#pragma unroll
        for (unsigned j = 0; j < 16; ++j) { const unsigned c = xb_ld(&bar[XB_XCNT(j)]); sum += c; cnt += (c > 0u) ? 1u : 0u; mine = (j == x) ? c : mine; }
        if (sum == G) break;
        __builtin_amdgcn_s_sleep(1);
        if ((++sp & 255u) == 0u) { if (xb_ld(&bar[XB_TMO])) break; if (sp > XB_SPIN_CAP) { atomicAdd(&bar[XB_TMO], 1u); break; } }
    }
    nloc = mine > 0u ? mine : 1u; nx = cnt > 0u ? cnt : 1u;
}
__device__ __forceinline__ void xcd_barrier(const XcdBarrier& b) {
    asm volatile("s_waitcnt vmcnt(0)" ::: "memory");
    __syncthreads();
    if (threadIdx.x == 0) {
        unsigned* bar = b.bar;
        __builtin_amdgcn_s_waitcnt(0);
        unsigned nloc = b.st[0], nx = b.st[1];
        if (nloc == 0u) { xcd_barrier_complete(bar, b.x, nloc, nx); b.st[0] = nloc; b.st[1] = nx; }
        const unsigned old = xb_add(&bar[XB_XSUB(b.x)], 1u);
        const unsigned gen = old / nloc;
        if (old + 1u == (gen + 1u) * nloc) {
            __builtin_amdgcn_fence(__ATOMIC_RELEASE, "agent");
            asm volatile("s_waitcnt vmcnt(0)" ::: "memory");
            const unsigned og = xb_add(&bar[XB_TOP], 1u);
            const unsigned tg = og / nx;
            if (og + 1u == (tg + 1u) * nx) xb_add(&bar[XB_TOPGEN], 1u);
            else XB_SPIN(xb_ld(&bar[XB_TOPGEN]) == tg, bar);
            __builtin_amdgcn_fence(__ATOMIC_ACQUIRE, "agent");
            xb_add(&bar[XB_XGEN(b.x)], 1u);
            asm volatile("s_waitcnt vmcnt(0)" ::: "memory");
        } else {
            XB_SPIN(xb_ld(&bar[XB_XGEN(b.x)]) == gen, bar);
            __builtin_amdgcn_fence(__ATOMIC_ACQUIRE, "agent");
            asm volatile("s_waitcnt vmcnt(0)" ::: "memory");
        }
    }
    __syncthreads();
}
constexpr int CW_BAR = 4096;

constexpr int XS_STRIDE = 272;
constexpr int LR_XS = 0, LR_XC = 35840, LR_HS = LR_XC + 34816, LR_CP = LR_HS + 34816, LR_HIN = LR_CP + 2560;
static_assert(LR_HIN + 512 <= RING_BYTES, "lru lds");
template <bool FINAL>
__device__ __forceinline__ void lru_phase(const Args& a, LAS unsigned char* lds, int G, int vcu) {
    const int tid = threadIdx.x, lane = tid & 63, w = __builtin_amdgcn_readfirstlane(tid >> 6), fr = lane & 15, fq = lane >> 4;
    const u16* XB = (const u16*)(a.ws + WS_XB); const u16* Y = (const u16*)(a.ws + WS_Y); u16* Gout = (u16*)(a.ws + WS_G);
    const u16* WAX = (const u16*)(a.ws + WS_WAX); float* CAR = (float*)(a.ws + WS_CAR); const float* spl = (const float*)(a.ws + WS_SPL);
    const float* cw = a.in[6]; const float* cb = a.in[7]; const float* b_a = a.in[9]; const float* b_x = a.in[11];
    LAS float* CP = (LAS float*)(lds + LR_CP); LAS float* HIN = (LAS float*)(lds + LR_HIN);
    for (int unit = vcu; unit < 256; unit += G) {
        const int n = unit & 7, chunk = unit >> 3, t0 = chunk * 512, ch0 = 128 * n;
        bf16x8 bfr[4], bfi[4];
        { const u16* wb = WAX + ((size_t)n * 256 + 16 * w + fr) * 128 + 8 * fq;
#pragma unroll
          for (int s = 0; s < 4; ++s) { bfr[s] = *(const bf16x8*)(wb + 32 * s); bfi[s] = *(const bf16x8*)(wb + 128 * 128 + 32 * s); } }
        const int ch = ch0 + 16 * w + fr; const float ba = b_a[ch], bx = b_x[ch], sp = spl[ch];
        for (int i = tid; i < 5 * 128; i += 512) { const int k = i >> 7, c = i & 127; CP[i] = k < 4 ? cw[k * D + ch0 + c] : cb[ch0 + c]; }
        float H = 0.f, Ptot = 1.f;
        if (FINAL) {
            const int hh = lane >> 5, jj = lane & 31;
#pragma unroll
            for (int it = 0; it < 8; ++it) { const int cl = 16 * w + 2 * it + hh; float A = 1.f, h = 0.f;
                if (jj < chunk) { const f32x2v_t v = *(const f32x2v_t*)(CAR + (((size_t)n * 32 + jj) * 128 + cl) * 2); A = v.x; h = v.y; }
#pragma unroll
                for (int d = 1; d < 32; d <<= 1) { const float Ap = __shfl_up(A, d, 32), hp = __shfl_up(h, d, 32); if (jj >= d) { h = A * hp + h; A = A * Ap; } }
                if (jj == 31) HIN[cl] = h; }
        }
        __syncthreads();
        if (FINAL) H = HIN[16 * w + fr];
        for (int s = 0; s < 4; ++s) {
            const int ts = t0 + 128 * s;
            for (int p = tid; p < 131 * 16; p += 512) { const int row = p >> 4, pc = p & 15, t = ts - 3 + row; u32x4 v = (u32x4){0u, 0u, 0u, 0u};
                if (t >= 0) v = *(const u32x4*)(XB + (size_t)t * D + ch0 + 8 * pc);
                *(LAS u32x4*)(lds + LR_XS + row * XS_STRIDE + pc * 16) = v; }
            __syncthreads();
            { const int cg = tid & 15, tg = tid >> 4; float o[4][8], wk[4][8];
#pragma unroll
              for (int k = 0; k < 4; ++k) { const f32x4 w0 = *(const LAS f32x4*)(CP + k * 128 + 8 * cg), w1 = *(const LAS f32x4*)(CP + k * 128 + 8 * cg + 4);
#pragma unroll
                  for (int i = 0; i < 4; ++i) { wk[k][i] = w0[i]; wk[k][4 + i] = w1[i]; } }
              { const f32x4 b0 = *(const LAS f32x4*)(CP + 512 + 8 * cg), b1 = *(const LAS f32x4*)(CP + 512 + 8 * cg + 4);
#pragma unroll
                for (int jt = 0; jt < 4; ++jt)
#pragma unroll
                    for (int i = 0; i < 4; ++i) { o[jt][i] = b0[i]; o[jt][4 + i] = b1[i]; } }
#pragma unroll
              for (int rr = 0; rr < 7; ++rr) { const u32x4 xv = *(const LAS u32x4*)(lds + LR_XS + (4 * tg + rr) * XS_STRIDE + cg * 16); float xf[8];
                  xf[0] = bf2f(xv.x & 0xffffu); xf[1] = bf2f(xv.x >> 16); xf[2] = bf2f(xv.y & 0xffffu); xf[3] = bf2f(xv.y >> 16); xf[4] = bf2f(xv.z & 0xffffu); xf[5] = bf2f(xv.z >> 16); xf[6] = bf2f(xv.w & 0xffffu); xf[7] = bf2f(xv.w >> 16);
#pragma unroll
                  for (int jt = 0; jt < 4; ++jt) { const int k = rr - jt; if (k >= 0 && k <= 3) {
#pragma unroll
                      for (int i = 0; i < 8; ++i) o[jt][i] += xf[i] * wk[k][i]; } } }
#pragma unroll
              for (int jt = 0; jt < 4; ++jt) { u32x4 wv; wv.x = cvt_pk_bf16(o[jt][0], o[jt][1]); wv.y = cvt_pk_bf16(o[jt][2], o[jt][3]); wv.z = cvt_pk_bf16(o[jt][4], o[jt][5]); wv.w = cvt_pk_bf16(o[jt][6], o[jt][7]);
                  *(LAS u32x4*)(lds + LR_XC + (4 * tg + jt) * XS_STRIDE + cg * 16) = wv; } }
            __syncthreads();
            f32x4 ar[8], ag[8];
#pragma unroll
            for (int m = 0; m < 8; ++m) { ar[m] = (f32x4){0.f, 0.f, 0.f, 0.f}; ag[m] = (f32x4){0.f, 0.f, 0.f, 0.f}; }
#pragma unroll
            for (int m = 0; m < 8; ++m)
#pragma unroll
                for (int s2 = 0; s2 < 4; ++s2) { const bf16x8 af = *(const LAS bf16x8*)(lds + LR_XC + (16 * m + fr) * XS_STRIDE + (32 * s2 + 8 * fq) * 2);
                    ar[m] = __builtin_amdgcn_mfma_f32_16x16x32_bf16(af, bfr[s2], ar[m], 0, 0, 0); ag[m] = __builtin_amdgcn_mfma_f32_16x16x32_bf16(af, bfi[s2], ag[m], 0, 0, 0); }
#pragma unroll
            for (int m = 0; m < 8; ++m) {
                float av[4], hv[4]; float Aseg = 1.f, Bseg = 0.f;
#pragma unroll
                for (int j = 0; j < 4; ++j) { const int tl = 16 * m + 4 * fq + j;
                    const float rg = fsigmoid(ar[m][j] + ba), ig = fsigmoid(ag[m][j] + bx), la = -8.0f * rg * sp, a_ = fexp2(LOG2E * la);
                    const float xc = bf2f(*(const LAS u16*)(lds + LR_XC + tl * XS_STRIDE + (16 * w + fr) * 2));
                    const float b_ = __builtin_sqrtf(one_minus_exp(2.0f * la)) * (ig * xc);
                    Bseg = a_ * Bseg + b_; Aseg *= a_; av[j] = Aseg; hv[j] = Bseg; }
                float Aq[4], Bq[4];
#pragma unroll
                for (int q = 0; q < 4; ++q) { Aq[q] = __shfl(Aseg, fr + 16 * q); Bq[q] = __shfl(Bseg, fr + 16 * q); }
                float hin[4]; float h = H;
#pragma unroll
                for (int q = 0; q < 4; ++q) { hin[q] = h; h = Aq[q] * h + Bq[q]; }
                H = h; Ptot *= (Aq[0] * Aq[1]) * (Aq[2] * Aq[3]);
                if (FINAL) { const float my = fq == 0 ? hin[0] : fq == 1 ? hin[1] : fq == 2 ? hin[2] : hin[3];
#pragma unroll
                    for (int j = 0; j < 4; ++j) { const int tl = 16 * m + 4 * fq + j; *(LAS u16*)(lds + LR_HS + tl * XS_STRIDE + (16 * w + fr) * 2) = (u16)f2bf(av[j] * my + hv[j]); } }
            }
            if (FINAL) {
                __syncthreads();
#pragma unroll
                for (int i = 0; i < 4; ++i) { const int p = tid + 512 * i, row = p >> 4, pc = p & 15; const size_t go = (size_t)(ts + row) * D + ch0 + 8 * pc;
                    const u32x4 hv = *(const LAS u32x4*)(lds + LR_HS + row * XS_STRIDE + pc * 16); const u32x4 yv = *(const u32x4*)(Y + go); u32x4 ov;
                    ov.x = cvt_pk_bf16(bf2f(hv.x & 0xffffu) * bf2f(yv.x & 0xffffu), bf2f(hv.x >> 16) * bf2f(yv.x >> 16)); ov.y = cvt_pk_bf16(bf2f(hv.y & 0xffffu) * bf2f(yv.y & 0xffffu), bf2f(hv.y >> 16) * bf2f(yv.y >> 16));
                    ov.z = cvt_pk_bf16(bf2f(hv.z & 0xffffu) * bf2f(yv.z & 0xffffu), bf2f(hv.z >> 16) * bf2f(yv.z >> 16)); ov.w = cvt_pk_bf16(bf2f(hv.w & 0xffffu) * bf2f(yv.w & 0xffffu), bf2f(hv.w >> 16) * bf2f(yv.w >> 16));
                    *(u32x4*)(Gout + go) = ov; }
            }
        }
        if (!FINAL) { if (fq == 0) { f32x2v_t v; v.x = Ptot; v.y = H; *(f32x2v_t*)(CAR + (((size_t)n * 32 + chunk) * 128 + 16 * w + fr) * 2) = v; } }
        __syncthreads();
    }
}

constexpr int AT_KS = 144, AT_K = 0, AT_V = 256 * AT_KS;
__device__ __forceinline__ int crow(int r, int hi) { return (r & 3) + 8 * (r >> 2) + 4 * hi; }
__device__ __forceinline__ void attn_phase(const Args& a, LAS unsigned char* lds, int G, int vcu) {
    const int tid = threadIdx.x, lane = tid & 63, w = __builtin_amdgcn_readfirstlane(tid >> 6), r32 = lane & 31, hi = lane >> 5;
    const u16* Q = (const u16*)(a.ws + WS_Q); const u16* Kb = (const u16*)(a.ws + WS_K); const u16* Vb = (const u16*)(a.ws + WS_V); u16* ATT = (u16*)(a.ws + WS_ATT);
    const float* sinks = a.in[16];
    for (int unit = vcu; unit < 512; unit += G) {
        const int kvh = unit & 3, b = unit >> 2;
        for (int p = tid; p < 256 * 8; p += 512) { const int idx = p >> 3, pc = p & 7, t = 128 * (b - 1) + idx;
            if (t >= 0) { const u32x4 kv = *(const u32x4*)(Kb + (size_t)t * KVD + 64 * kvh + 8 * pc), vv = *(const u32x4*)(Vb + (size_t)t * KVD + 64 * kvh + 8 * pc);
                *(LAS u32x4*)(lds + AT_K + idx * AT_KS + pc * 16) = kv; *(LAS u32x4*)(lds + AT_V + idx * AT_KS + pc * 16) = vv; } }
        __syncthreads();
        const int head = 4 * kvh + (w >> 1), qh = w & 1; const float sink2 = sinks[head] * LOG2E;
        for (int qt = 0; qt < 2; ++qt) {
            const int q0 = 64 * qh + 32 * qt, t = 128 * b + q0 + r32;
            bf16x8 qf[4];
#pragma unroll
            for (int s = 0; s < 4; ++s) qf[s] = *(const bf16x8*)(Q + (size_t)t * D + 64 * head + 16 * s + 8 * hi);
            f32x16 o0, o1;
#pragma unroll
            for (int r = 0; r < 16; ++r) { o0[r] = 0.f; o1[r] = 0.f; }
            float mx = sink2, l = 1.0f; const int kt0 = q0 >> 5;
            for (int kk = 0; kk < 5; ++kk) { const int kt = kt0 + kk; if (b == 0 && kt < 4) continue;
                f32x16 sc;
#pragma unroll
                for (int r = 0; r < 16; ++r) sc[r] = 0.f;
#pragma unroll
                for (int s = 0; s < 4; ++s) { const bf16x8 kf = *(const LAS bf16x8*)(lds + AT_K + (32 * kt + r32) * AT_KS + (16 * s + 8 * hi) * 2); sc = __builtin_amdgcn_mfma_f32_32x32x16_bf16(kf, qf[s], sc, 0, 0, 0); }
                const int base = 32 * kt + 4 * hi - (128 + q0 + r32); float mt = -1.0e30f;
#pragma unroll
                for (int r = 0; r < 16; ++r) { const int rel = base + (r & 3) + 8 * (r >> 2); if (!(rel <= 0 && rel > -WIN)) sc[r] = -1.0e30f; mt = fmaxf(mt, sc[r]); }
                mt = fmaxf(mt, __shfl_xor(mt, 32));
                const float mn = fmaxf(mx, mt), al = fexp2(mx - mn); float ps = 0.f;
#pragma unroll
                for (int r = 0; r < 16; ++r) { const float p = fexp2(sc[r] - mn); sc[r] = p; ps += p; }
                ps += __shfl_xor(ps, 32); l = l * al + ps; mx = mn;
#pragma unroll
                for (int r = 0; r < 16; ++r) { o0[r] *= al; o1[r] *= al; }
                u32x4 pa, pb; pa.x = cvt_pk_bf16(sc[0], sc[1]); pa.y = cvt_pk_bf16(sc[2], sc[3]); pa.z = cvt_pk_bf16(sc[4], sc[5]); pa.w = cvt_pk_bf16(sc[6], sc[7]);
                pb.x = cvt_pk_bf16(sc[8], sc[9]); pb.y = cvt_pk_bf16(sc[10], sc[11]); pb.z = cvt_pk_bf16(sc[12], sc[13]); pb.w = cvt_pk_bf16(sc[14], sc[15]);
                const bf16x8 pf0 = __builtin_bit_cast(bf16x8, pa), pf1 = __builtin_bit_cast(bf16x8, pb);
#pragma unroll
                for (int s2 = 0; s2 < 2; ++s2)
#pragma unroll
                    for (int dt = 0; dt < 2; ++dt) {
                        const int va = AT_V + (32 * kt + 16 * s2 + 4 * hi + ((lane & 15) >> 2)) * AT_KS + (32 * dt + 16 * ((lane >> 4) & 1) + 4 * (lane & 3)) * 2;
                        const s16x4 lo = __builtin_bit_cast(s16x4, __builtin_amdgcn_ds_read_tr16_b64_v4i16((LAS s16x4*)(lds + va)));
                        const s16x4 hi4 = __builtin_bit_cast(s16x4, __builtin_amdgcn_ds_read_tr16_b64_v4i16((LAS s16x4*)(lds + va + 8 * AT_KS)));
                        const bf16x8 vf = (bf16x8){lo[0], lo[1], lo[2], lo[3], hi4[0], hi4[1], hi4[2], hi4[3]};
                        if (dt == 0) o0 = __builtin_amdgcn_mfma_f32_32x32x16_bf16(vf, s2 ? pf1 : pf0, o0, 0, 0, 0); else o1 = __builtin_amdgcn_mfma_f32_32x32x16_bf16(vf, s2 ? pf1 : pf0, o1, 0, 0, 0); }
            }
            const float il = 1.0f / l;
#pragma unroll
            for (int g4 = 0; g4 < 4; ++g4) { u32x2 w0, w1;
                w0.x = cvt_pk_bf16(o0[4 * g4] * il, o0[4 * g4 + 1] * il); w0.y = cvt_pk_bf16(o0[4 * g4 + 2] * il, o0[4 * g4 + 3] * il);
                w1.x = cvt_pk_bf16(o1[4 * g4] * il, o1[4 * g4 + 1] * il); w1.y = cvt_pk_bf16(o1[4 * g4 + 2] * il, o1[4 * g4 + 3] * il);
                *(u32x2*)(ATT + (size_t)t * D + 64 * head + 8 * g4 + 4 * hi) = w0; *(u32x2*)(ATT + (size_t)t * D + 64 * head + 32 + 8 * g4 + 4 * hi) = w1; }
        }
        __syncthreads();
    }
}

constexpr int NPHASE = 14;
__global__ void __launch_bounds__(512, 2) mega(Args a) {
    extern __shared__ __attribute__((aligned(16))) unsigned char lds_raw[];
    LAS unsigned char* lds = (LAS unsigned char*)lds_raw;
    const int tid = threadIdx.x, lane = tid & 63, wave = __builtin_amdgcn_readfirstlane(tid >> 6);
    const int G = gridDim.x; const int bx = blockIdx.x; const int vcu = (G % 8 == 0) ? (bx % 8) * (G / 8) + bx / 8 : bx;
    unsigned char* ws = a.ws; unsigned* ctl = (unsigned*)(ws + WS_CTL);
    volatile LAS unsigned* MISC = (volatile LAS unsigned*)(lds + LX_MISC);
    for (int u = tid; u < 112; u += 512) ((LAS unsigned*)(lds + LX_MISC))[u] = 0u;
    __syncthreads();
    const int lo = a.ph_lo, hi = a.ph_hi;
    XcdBarrier bar; bar.bar = ctl + CW_BAR; bar.x = 0; bar.st = nullptr;
    if (hi - lo > 1) bar = xcd_barrier_post(ctl + CW_BAR, MISC + 8);
#define IN(k) (lo <= (k) && (k) < hi)
#ifndef REP_MASK
#define REP_MASK 0
#endif
#define REPS(k) for (int rep_ = 0; rep_ < 1 + ((REP_MASK >> (k)) & 1); ++rep_)
#define SEAM(k) do { if (IN(k) && IN((k) + 1)) xcd_barrier(bar); } while (0)
    float* H = a.out; u16* HB = (u16*)(ws + WS_HB);
    float* SSP0 = (float*)(ws + WS_SSP); float* SSP1 = SSP0 + 65536; float* SSP2 = SSP1 + 65536; float* SSP3 = SSP2 + 65536;
    unsigned* cnt = ctl + CW_CNT; int* list = (int*)(ws + WS_LIST); float* gatew = (float*)(ws + WS_GATEW);
    const int gw = vcu * 8 + wave, NGW = G * 8;

    if (IN(0)) REPS(0) {
        tables_body(a, vcu * 512 + tid, G * 512);
        convert_body(a, (float*)(lds_raw + wave * 16384), gw, NGW, lane);
        rowprep_body(a.in[0], HB, SSP0, gw, NGW, lane);
    }
    SEAM(0);
    if (IN(1)) REPS(1) { pg8::DenseSched S; S.o.init(M / 256, 2048 / 256, G, bx); S.A = (const char*)HB; S.Bt = (const char*)(ws + WS_WIN); S.K = 1024;
        pg8::EpiProj E{SSP0, (u16*)(ws + WS_Y), (u16*)(ws + WS_XB)}; pg8::gemm_phase<pg8::EpiProj, pg8::DenseSched, false>(lds, 1024, S, E); }
    SEAM(1);
    if (IN(2)) REPS(2) lru_phase<false>(a, lds, G, vcu);
    SEAM(2);
    if (IN(3)) REPS(3) lru_phase<true>(a, lds, G, vcu);
    SEAM(3);
    if (IN(4)) REPS(4) { pg8::DenseSched S; S.o.init(M / 256, 4, G, bx); S.A = (const char*)(ws + WS_G); S.Bt = (const char*)(ws + WS_WOUT); S.K = 1024;
        pg8::EpiRes E{a.in[0], HB, nullptr, SSP1, nullptr}; pg8::gemm_phase<pg8::EpiRes, pg8::DenseSched, false>(lds, 1024, S, E); }
    SEAM(4);
    if (IN(5)) REPS(5) { pg8::DenseSched S; S.o.init(M / 256, 7168 / 256, G, bx); S.A = (const char*)HB; S.Bt = (const char*)(ws + WS_WGU); S.K = 1024;
        pg8::EpiGateUp E{SSP1, (u16*)(ws + WS_ACT)}; pg8::gemm_phase<pg8::EpiGateUp, pg8::DenseSched, false>(lds, 1024, S, E); }
    SEAM(5);
    if (IN(6)) { pg8::DenseSched S; S.o.init(M / 256, 4, G, bx); S.A = (const char*)(ws + WS_ACT); S.Bt = (const char*)(ws + WS_WD); S.K = DFF;
        pg8::EpiRes E{nullptr, HB, nullptr, SSP2, nullptr}; pg8::gemm_phase<pg8::EpiRes, pg8::DenseSched, false>(lds, DFF, S, E); }
    SEAM(6);
    if (IN(7)) REPS(7) { pg8::DenseSched S; S.o.init(M / 256, NQKV / 256, G, bx); S.A = (const char*)HB; S.Bt = (const char*)(ws + WS_WQKV); S.K = 1024;
        pg8::EpiQKV E{SSP2, a.in[15], (const u16*)(ws + WS_ROPE), (u16*)(ws + WS_Q), (u16*)(ws + WS_K), (u16*)(ws + WS_V)}; pg8::gemm_phase<pg8::EpiQKV, pg8::DenseSched, false>(lds, 1024, S, E); }
    SEAM(7);
    if (IN(8)) REPS(8) attn_phase(a, lds, G, vcu);
    SEAM(8);
    if (IN(9)) { pg8::DenseSched S; S.o.init(M / 256, 4, G, bx); S.A = (const char*)(ws + WS_ATT); S.Bt = (const char*)(ws + WS_WO); S.K = 1024;
        pg8::EpiRes E{nullptr, HB, a.in[18], SSP3, MOE_FP8 ? (unsigned char*)(ws + WS_HB8) : nullptr}; pg8::gemm_phase<pg8::EpiRes, pg8::DenseSched, false>(lds, 1024, S, E); }
    SEAM(9);
    if (IN(10)) { for (int g = vcu; g < M / 64; g += G) router_group(HB, (const float*)(ws + WS_WR), SSP3, cnt, list, gatew, g, (float*)(lds_raw + LX_ROUT)); }
    SEAM(10);
    LAS int* tbl = (LAS int*)(lds + LX_TBL);
    if (IN(11) || IN(12)) { if (tid == 0) { int acc = 0; for (int e = 0; e < 8; ++e) { const int c = (int)__hip_atomic_load(cnt + e, __ATOMIC_RELAXED, __HIP_MEMORY_SCOPE_AGENT); tbl[e] = c; tbl[8 + e] = acc; acc += (c + 255) >> 8; } tbl[16] = acc; } __syncthreads(); }
    if (IN(11)) REPS(11) { pg8::MoeSched S; S.o.init(__builtin_amdgcn_readfirstlane(tbl[16]), 7168 / 256, G, bx); S.A = MOE_FP8 ? (const char*)(ws + WS_HB8) : (const char*)HB; S.Bt = (const char*)(ws + WS_WGU2); S.K = MOE_FP8 ? 512 : 1024; S.bstride = (size_t)7168 * 1024 * (MOE_FP8 ? 1 : 2); S.list = list; S.tbl = tbl;
        pg8::EpiMoeUp E{SSP3, list, gatew, tbl, (u16*)(ws + WS_ACT2)}; pg8::gemm_phase<pg8::EpiMoeUp, pg8::MoeSched, true, MOE_FP8 != 0>(lds, MOE_FP8 ? 512 : 1024, S, E); }
    SEAM(11);
    if (IN(12)) REPS(12) { pg8::MoeSched S; S.o.init(__builtin_amdgcn_readfirstlane(tbl[16]), 4, G, bx); S.A = (const char*)(ws + WS_ACT2); S.Bt = (const char*)(ws + WS_WD2); S.K = MOE_FP8 ? DFF / 2 : DFF; S.bstride = (size_t)1024 * DFF * (MOE_FP8 ? 1 : 2); S.list = nullptr; S.tbl = tbl;
        pg8::EpiMoeDown E{list, tbl, (u16*)(ws + WS_MO)}; pg8::gemm_phase<pg8::EpiMoeDown, pg8::MoeSched, false, MOE_FP8 != 0>(lds, MOE_FP8 ? DFF / 2 : DFF, S, E); }
    SEAM(12);
    if (IN(13)) final_body(H, HB, (const u16*)(ws + WS_MO), a.in[4], gw, NGW, lane);
#undef IN
#undef SEAM
}
#ifndef MK_MODE
#define MK_MODE 1
#endif
#ifndef FASTMASK
#define FASTMASK 0x3fff
#endif
extern "C" void kernel_launch(void* const* d_in, const int* in_sizes, int n_in, void* d_out, int out_size, void* d_ws, size_t ws_size, hipStream_t stream) {
    if (n_in != 26 || out_size != M * D || ws_size < WS_END) { fprintf(stderr, "kernel_launch: unexpected shapes (n_in %d out %d ws %zu, need %zu)\n", n_in, out_size, ws_size, (size_t)WS_END); return; }
    static int grid = 0;
    if (grid == 0) {
        int dev = 0, cus = 0, per_cu = 0;
        if (hipGetDevice(&dev) != hipSuccess || hipDeviceGetAttribute(&cus, hipDeviceAttributeMultiprocessorCount, dev) != hipSuccess) { grid = -1; return; }
        if (hipFuncSetAttribute((const void*)mega, hipFuncAttributeMaxDynamicSharedMemorySize, LDS_BYTES) != hipSuccess) { fprintf(stderr, "kernel_launch: hipFuncSetAttribute failed\n"); grid = -1; return; }
        if (hipOccupancyMaxActiveBlocksPerMultiprocessor(&per_cu, (const void*)mega, 512, LDS_BYTES) != hipSuccess || per_cu < 1) { fprintf(stderr, "kernel_launch: occupancy query says %d\n", per_cu); per_cu = 1; }
        (void)hipGetLastError();
        grid = cus;
    }
    if (grid < 0) return;
    unsigned char* ws = (unsigned char*)d_ws;
    (void)hipMemsetAsync(ws + WS_CTL, 0, CTL_BYTES, stream);
    Args a{};
    for (int i = 0; i < 26; ++i) a.in[i] = (const float*)d_in[i];
    a.pos = (const int*)d_in[1]; a.out = (float*)d_out; a.ws = ws; a.ph_lo = 0; a.ph_hi = NPHASE;
#if MK_MODE == 1
    hipLaunchKernelGGL(mega, dim3(grid), dim3(512), LDS_BYTES, stream, a);
#else
    float* H = (float*)d_out; u16* HB = (u16*)(ws + WS_HB);
    float* SSP0 = (float*)(ws + WS_SSP), *SSP1 = SSP0 + 65536, *SSP2 = SSP1 + 65536, *SSP3 = SSP2 + 65536;
    const unsigned* cnt = (const unsigned*)(ws + WS_CTL) + CW_CNT; const int* list = (const int*)(ws + WS_LIST); const float* gatew = (const float*)(ws + WS_GATEW);
    for (int p = 0; p < NPHASE; ++p) {
        if ((FASTMASK >> p) & 1) { a.ph_lo = p; a.ph_hi = p + 1; hipLaunchKernelGGL(mega, dim3(grid), dim3(512), LDS_BYTES, stream, a); continue; }
        switch (p) {
        case 0: k_tables<<<256, 256, 0, stream>>>(a); k_convert<<<2048, 256, 0, stream>>>(a); k_rowprep<<<1024, 256, 0, stream>>>(a.in[0], HB, SSP0); break;
        case 1: { NE_Proj e{HB, (const u16*)(ws + WS_WIN), SSP0, (u16*)(ws + WS_Y), (u16*)(ws + WS_XB)}; k_ngemm<<<dim3(2048 / 64, M / 64), 256, 0, stream>>>(e, 1024); } break;
        case 2: k_conv1d<<<(M * D) / 256, 256, 0, stream>>>((const u16*)(ws + WS_XB), a.in[6], a.in[7], (u16*)(ws + WS_XC));
                { NE_Gates e{(const u16*)(ws + WS_XC), (const u16*)(ws + WS_WAX), a.in[9], a.in[11], (const float*)(ws + WS_SPL), (float*)d_out, (float*)(ws + WS_BX)}; k_ngemm<<<dim3(128 / 64, M / 64, 8), 256, 0, stream>>>(e, 128); } break;
        case 3: k_scan_seq<<<16, 64, 0, stream>>>((const float*)d_out, (const float*)(ws + WS_BX), (const u16*)(ws + WS_Y), (u16*)(ws + WS_G)); break;
        case 4: { NE_Res e{(const u16*)(ws + WS_G), (const u16*)(ws + WS_WOUT), 1024, a.in[0], H, HB, nullptr}; k_ngemm<<<dim3(1024 / 64, M / 64), 256, 0, stream>>>(e, 1024); } k_ssp<<<1024, 256, 0, stream>>>(H, SSP1); break;
        case 5: { NE_GateUp e{HB, (const u16*)(ws + WS_WGU), SSP1, (u16*)(ws + WS_ACT)}; k_ngemm<<<dim3(DFF / 64, M / 64), 256, 0, stream>>>(e, 1024); } break;
        case 6: { NE_Res e{(const u16*)(ws + WS_ACT), (const u16*)(ws + WS_WD), DFF, nullptr, H, HB, nullptr}; k_ngemm<<<dim3(1024 / 64, M / 64), 256, 0, stream>>>(e, DFF); } k_ssp<<<1024, 256, 0, stream>>>(H, SSP2); break;
        case 7: { NE_QKV e{HB, (const u16*)(ws + WS_WQKV), SSP2, a.in[15], (const u16*)(ws + WS_ROPE), (u16*)(ws + WS_Q), (u16*)(ws + WS_K), (u16*)(ws + WS_V)}; k_ngemm<<<dim3(NQKV / 64, M / 64), 256, 0, stream>>>(e, 1024); } break;
        case 8: k_attn_ref<<<(M * NH) / 64, 64, 0, stream>>>((const u16*)(ws + WS_Q), (const u16*)(ws + WS_K), (const u16*)(ws + WS_V), a.in[16], (u16*)(ws + WS_ATT)); break;
        case 9: { NE_Res e{(const u16*)(ws + WS_ATT), (const u16*)(ws + WS_WO), 1024, nullptr, H, HB, a.in[18]}; k_ngemm<<<dim3(1024 / 64, M / 64), 256, 0, stream>>>(e, 1024); } k_ssp<<<1024, 256, 0, stream>>>(H, SSP3); break;
        case 10: k_router<<<256, 512, 0, stream>>>(a); break;
        case 11: { NE_MoeUp e{HB, (const u16*)(ws + WS_WGU2), SSP3, cnt, list, gatew, (u16*)(ws + WS_ACT2)}; k_ngemm<<<dim3(DFF / 64, MAXSLOT / 64), 256, 0, stream>>>(e, 1024); } break;
        case 12: { NE_MoeDown e{(const u16*)(ws + WS_ACT2), (const u16*)(ws + WS_WD2), cnt, list, (u16*)(ws + WS_MO)}; k_ngemm<<<dim3(1024 / 64, MAXSLOT / 64), 256, 0, stream>>>(e, DFF); } break;
        case 13: k_final<<<1024, 256, 0, stream>>>(H, HB, (const u16*)(ws + WS_MO), a.in[4]); break;
        }
    }
#endif
}
```

```cpp
#include <hip/hip_runtime.h>
#include <stdint.h>
#include <stdio.h>

typedef unsigned short u16;
typedef short bf16x8 __attribute__((ext_vector_type(8)));
typedef float f32x4 __attribute__((ext_vector_type(4)));
typedef unsigned u32x4 __attribute__((ext_vector_type(4)));
typedef unsigned u32x2 __attribute__((ext_vector_type(2)));

constexpr int M = 16384, D = 1024, DFF = 3584, NE = 8, NBLK = 8, RB = 128;
constexpr int NH = 16, NKV = 4, HD = 64, KVD = 256, NQKV = 1536, WIN = 128;
constexpr int MAXSLOT = 34816;
constexpr float EPS = 1e-6f;
#ifndef MOE_FP8
#define MOE_FP8 1
#endif
constexpr float S8_A = 16.0f, S8_W = 256.0f, S8_ACT = 8.0f, S8_WD = 512.0f;
constexpr float LOG2E = 1.4426950408889634f;

constexpr size_t MiB = 1u << 20;
constexpr size_t WS_CTL = 0, CTL_BYTES = 1 * MiB;
constexpr size_t WS_ROPE = 1 * MiB;
constexpr size_t WS_SSP = 2 * MiB;
constexpr size_t WS_SPL = 3 * MiB;
constexpr size_t WS_WR = 3 * MiB + 64 * 1024;
constexpr size_t WS_CAR = 3 * MiB + 128 * 1024;
constexpr size_t WS_LIST = 4 * MiB;
constexpr size_t WS_GATEW = WS_LIST;
constexpr size_t WS_WGU2 = 6 * MiB;
constexpr size_t WS_HB8 = 70 * MiB;
constexpr size_t WS_WD2 = 118 * MiB;
constexpr size_t WS_HB = 174 * MiB;
constexpr size_t WS_X = 206 * MiB;
constexpr size_t WS_WIN = WS_X;
constexpr size_t WS_WAX = WS_X + 4 * MiB;
constexpr size_t WS_WOUT = WS_X + 5 * MiB;
constexpr size_t WS_WGU = WS_X + 7 * MiB;
constexpr size_t WS_WD = WS_X + 21 * MiB;
constexpr size_t WS_WQKV = WS_X + 28 * MiB;
constexpr size_t WS_WO = WS_X + 31 * MiB;
constexpr size_t WS_Y = WS_X + 33 * MiB;
constexpr size_t WS_XB = WS_Y + 32 * MiB;
constexpr size_t WS_G = WS_XB + 32 * MiB;
constexpr size_t WS_ACT = WS_G + 32 * MiB;
constexpr size_t WS_XC = WS_ACT;
constexpr size_t WS_BX = WS_ACT + 32 * MiB;
constexpr size_t WS_Q = WS_Y;
constexpr size_t WS_K = WS_Y + 32 * MiB;
constexpr size_t WS_V = WS_K + 8 * MiB;
constexpr size_t WS_ATT = WS_V + 8 * MiB;
constexpr size_t WS_ACT2 = WS_X;
constexpr size_t WS_MO = WS_WGU2;
constexpr size_t WS_END = 447 * MiB;
static_assert(WS_ACT + (size_t)M * DFF * 2 <= WS_END && WS_ACT2 + (size_t)MAXSLOT * DFF * 2 <= WS_END, "ws map");
constexpr int CW_CNT = 64;

__device__ __forceinline__ unsigned f2bf(float f) { unsigned u = __builtin_bit_cast(unsigned, f); return (u + 0x7fffu + ((u >> 16) & 1u)) >> 16; }
__device__ __forceinline__ float bf2f(unsigned b) { return __builtin_bit_cast(float, b << 16); }
__device__ __forceinline__ float u2f(unsigned b) { return __builtin_bit_cast(float, b); }
__device__ __forceinline__ unsigned pk2(float lo, float hi) { return f2bf(lo) | (f2bf(hi) << 16); }
__device__ __forceinline__ float wave_sum(float v) {
#pragma unroll
    for (int o = 1; o < 64; o <<= 1) v += __shfl_xor(v, o);
    return v;
}
__device__ __forceinline__ float sigmoidf_(float x) { return 1.0f / (1.0f + __expf(-x)); }
__device__ __forceinline__ float gelu_tanh(float x) { const float z = 0.7978845608028654f * (x + 0.044715f * x * x * x); return x / (1.0f + __expf(-2.0f * z)); }
__device__ __forceinline__ float silu_(float x) { return x / (1.0f + __expf(-x)); }
__device__ __forceinline__ float one_minus_exp(float x) {
    if (x > -0.3f) { float p = 1.0f / 720.0f; p = p * x + 1.0f / 120.0f; p = p * x + 1.0f / 24.0f; p = p * x + 1.0f / 6.0f; p = p * x + 0.5f; p = p * x + 1.0f; return -x * p; }
    return 1.0f - __expf(x);
}
__device__ __forceinline__ float rstd_of(const float* ssp, int row) { const f32x4 p = *(const f32x4*)(ssp + 4 * (size_t)row); return rsqrtf(((p[0] + p[1]) + (p[2] + p[3])) * (1.0f / D) + EPS); }

struct Args {
    const float* in[26]; const int* pos; float* out; unsigned char* ws; int ph_lo, ph_hi;
};

__device__ __forceinline__ void tables_body(const Args& a, int gt, int NT) {
    u16* rope = (u16*)(a.ws + WS_ROPE);
    for (int i = gt; i < M * 8; i += NT) { const int t = i >> 3, f = i & 7;
        const double inv = f == 0 ? 1.0 : f == 1 ? 0.19392274474868576 : f == 2 ? 0.03760603093086393 : f == 3 ? 0.007292664737217109 : f == 4 ? 0.001414213562373095 : f == 5 ? 0.0002742481756762073 : f == 6 ? 5.318295896944988e-05 : 1.031338537721246e-05;
        const double ang = (double)a.pos[t] * inv; const double kq = __builtin_rint(ang * 0.6366197723675814); const double r = ang - kq * 1.5707963267948966, r2 = r * r;
        double s = -1.0 / 39916800.0; s = s * r2 + 1.0 / 362880.0; s = s * r2 - 1.0 / 5040.0; s = s * r2 + 1.0 / 120.0; s = s * r2 - 1.0 / 6.0; s = s * r2 + 1.0; s *= r;
        double c = 1.0 / 479001600.0; c = c * r2 - 1.0 / 3628800.0; c = c * r2 + 1.0 / 40320.0; c = c * r2 - 1.0 / 720.0; c = c * r2 + 1.0 / 24.0; c = c * r2 - 0.5; c = c * r2 + 1.0;
        const int q = (int)((long long)kq & 3); const double cs = q == 0 ? c : q == 1 ? -s : q == 2 ? -c : s, sn = q == 0 ? s : q == 1 ? c : q == 2 ? -s : -c;
        rope[t * 16 + f] = (u16)f2bf((float)cs); rope[t * 16 + 8 + f] = (u16)f2bf((float)sn); }
    float* spl = (float*)(a.ws + WS_SPL);
    for (int i = gt; i < 1024; i += NT) { const float z = __expf(-a.in[12][i]);
        float p = 0.2f; p = p * z - 0.25f; p = p * z + 1.0f / 3.0f; p = p * z - 0.5f; p = p * z + 1.0f; spl[i] = z < 0.05f ? z * p : __logf(1.0f + z); }
    float* wr = (float*)(a.ws + WS_WR);
    for (int i = gt; i < 8 * 1024; i += NT) { const int e = i >> 10, k = i & 1023; wr[i] = a.in[3][1024 + k] * a.in[22][k * 8 + e]; }
}
__global__ void k_tables(Args a) { tables_body(a, blockIdx.x * blockDim.x + threadIdx.x, gridDim.x * blockDim.x); }

struct ConvJob { const float* W; const float* g; u16* WT; int K, N, mode, row_off; float s8; };
__device__ __forceinline__ bool conv_job(const Args& a, int j, ConvJob& c) {
    unsigned char* ws = a.ws;
    c.g = nullptr; c.mode = 0; c.row_off = 0; c.s8 = 0.f;
    if (j == 0) { c.W = a.in[5]; c.g = a.in[2]; c.WT = (u16*)(ws + WS_WIN); c.K = 1024; c.N = 2048; return true; }
    if (j == 1) { c.W = a.in[13]; c.WT = (u16*)(ws + WS_WOUT); c.K = 1024; c.N = 1024; return true; }
    if (j == 2) { c.W = a.in[19]; c.g = a.in[3]; c.WT = (u16*)(ws + WS_WGU); c.K = 1024; c.N = DFF; c.mode = 1; return true; }
    if (j == 3) { c.W = a.in[20]; c.g = a.in[3]; c.WT = (u16*)(ws + WS_WGU); c.K = 1024; c.N = DFF; c.mode = 2; return true; }
    if (j == 4) { c.W = a.in[21]; c.WT = (u16*)(ws + WS_WD); c.K = DFF; c.N = 1024; return true; }
    if (j == 5) { c.W = a.in[14]; c.g = a.in[2] + 1024; c.WT = (u16*)(ws + WS_WQKV); c.K = 1024; c.N = NQKV; return true; }
    if (j == 6) { c.W = a.in[17]; c.WT = (u16*)(ws + WS_WO); c.K = 1024; c.N = 1024; return true; }
    j -= 7;
    if (j < 16) { const int n = j >> 1, x = j & 1; c.W = a.in[x ? 10 : 8] + (size_t)n * 128 * 128; c.WT = (u16*)(ws + WS_WAX) + (size_t)n * 256 * 128; c.K = 128; c.N = 128; c.row_off = x * 128; return true; }
    j -= 16;
    if (j < 16) { const int e = j >> 1, x = j & 1; c.W = a.in[x ? 24 : 23] + (size_t)e * 1024 * DFF; c.g = a.in[3] + 1024; c.WT = (u16*)(ws + WS_WGU2 + (size_t)e * 7168 * 1024 * (MOE_FP8 ? 1 : 2)); c.K = 1024; c.N = DFF; c.mode = 1 + x; c.s8 = MOE_FP8 ? S8_W : 0.f; return true; }
    j -= 16;
    if (j < 8) { c.W = a.in[25] + (size_t)j * DFF * 1024; c.WT = (u16*)(ws + WS_WD2 + (size_t)j * 1024 * DFF * (MOE_FP8 ? 1 : 2)); c.K = DFF; c.N = 1024; c.s8 = MOE_FP8 ? S8_WD : 0.f; return true; }
    return false;
}
constexpr int NJOBS = 7 + 16 + 16 + 8;
__device__ __forceinline__ void conv_item(const ConvJob& c, float*, int item, int lane) {
    const int nblk = c.N / 64, kb = item / nblk, nb = item % nblk, r4 = lane >> 4, cc = lane & 15, k0 = 64 * kb + 16 * r4, n0 = 64 * nb + 4 * cc;
    f32x4 v[16];
    const float* src = c.W + (size_t)k0 * c.N + n0;
#pragma unroll
    for (int i = 0; i < 16; ++i) v[i] = *(const f32x4*)(src + (size_t)i * c.N);
    if (c.g) { const f32x4 g0 = *(const f32x4*)(c.g + k0), g1 = *(const f32x4*)(c.g + k0 + 4), g2 = *(const f32x4*)(c.g + k0 + 8), g3 = *(const f32x4*)(c.g + k0 + 12);
#pragma unroll
        for (int i = 0; i < 4; ++i) { v[i] = v[i] * g0[i]; v[4 + i] = v[4 + i] * g1[i]; v[8 + i] = v[8 + i] * g2[i]; v[12 + i] = v[12 + i] * g3[i]; } }
    if (c.s8 != 0.f) {
#pragma unroll
        for (int j = 0; j < 4; ++j) { const int nn = n0 + j; const int r = c.mode == 0 ? c.row_off + nn : 256 * (nn >> 7) + (nn & 127) + (c.mode == 2 ? 128 : 0);
            u32x4 o;
#pragma unroll
            for (int q = 0; q < 4; ++q) { int w = 0; w = __builtin_amdgcn_cvt_pk_fp8_f32(v[4 * q][j] * c.s8, v[4 * q + 1][j] * c.s8, w, false); w = __builtin_amdgcn_cvt_pk_fp8_f32(v[4 * q + 2][j] * c.s8, v[4 * q + 3][j] * c.s8, w, true); o[q] = (unsigned)w; }
            *(u32x4*)((unsigned char*)c.WT + (size_t)r * c.K + k0) = o; }
        return; }
#pragma unroll
    for (int j = 0; j < 4; ++j) { const int nn = n0 + j; const int r = c.mode == 0 ? c.row_off + nn : 256 * (nn >> 7) + (nn & 127) + (c.mode == 2 ? 128 : 0);
        u32x4 o0, o1; o0.x = pk2(v[0][j], v[1][j]); o0.y = pk2(v[2][j], v[3][j]); o0.z = pk2(v[4][j], v[5][j]); o0.w = pk2(v[6][j], v[7][j]);
        o1.x = pk2(v[8][j], v[9][j]); o1.y = pk2(v[10][j], v[11][j]); o1.z = pk2(v[12][j], v[13][j]); o1.w = pk2(v[14][j], v[15][j]);
        u32x4* dst = (u32x4*)(c.WT + (size_t)r * c.K + k0); dst[0] = o0; dst[1] = o1; }
}
__device__ __forceinline__ void convert_body(const Args& a, float* scr, int gw, int NGW, int lane) {
    int base = 0;
    for (int j = 0; j < NJOBS; ++j) { ConvJob c; if (!conv_job(a, j, c)) break; const int items = (c.K / 64) * (c.N / 64);
        int first = (gw - base) % NGW; if (first < 0) first += NGW;
        for (int it = first; it < items; it += NGW) conv_item(c, scr, it, lane);
        base = (base + items) % NGW; }
}
__global__ __launch_bounds__(256) void k_convert(Args a) {
    __shared__ float scr_all[4][64 * 33];
    const int lane = threadIdx.x & 63, w = threadIdx.x >> 6;
    convert_body(a, scr_all[w], blockIdx.x * 4 + w, gridDim.x * 4, lane);
}

__device__ __forceinline__ void rowprep_body(const float* x, u16* hb, float* ssp, int gw, int NGW, int lane) {
    for (int r = gw; r < M; r += NGW) {
        const f32x4* xr = (const f32x4*)(x + (size_t)r * D) + lane * 4; float s = 0.f; u32x4 o0, o1;
        f32x4 v0 = xr[0], v1 = xr[1], v2 = xr[2], v3 = xr[3];
        s = (v0[0] * v0[0] + v0[1] * v0[1]) + (v0[2] * v0[2] + v0[3] * v0[3]) + (v1[0] * v1[0] + v1[1] * v1[1]) + (v1[2] * v1[2] + v1[3] * v1[3])
          + (v2[0] * v2[0] + v2[1] * v2[1]) + (v2[2] * v2[2] + v2[3] * v2[3]) + (v3[0] * v3[0] + v3[1] * v3[1]) + (v3[2] * v3[2] + v3[3] * v3[3]);
        o0.x = pk2(v0[0], v0[1]); o0.y = pk2(v0[2], v0[3]); o0.z = pk2(v1[0], v1[1]); o0.w = pk2(v1[2], v1[3]);
        o1.x = pk2(v2[0], v2[1]); o1.y = pk2(v2[2], v2[3]); o1.z = pk2(v3[0], v3[1]); o1.w = pk2(v3[2], v3[3]);
        u32x4* orow = (u32x4*)(hb + (size_t)r * D) + lane * 2; orow[0] = o0; orow[1] = o1;
        s += __shfl_xor(s, 1); s += __shfl_xor(s, 2); s += __shfl_xor(s, 4); s += __shfl_xor(s, 8);
        if ((lane & 15) == 0) ssp[4 * (size_t)r + (lane >> 4)] = s;
    }
}
__global__ __launch_bounds__(256) void k_rowprep(const float* x, u16* hb, float* ssp) { rowprep_body(x, hb, ssp, blockIdx.x * 4 + (threadIdx.x >> 6), gridDim.x * 4, threadIdx.x & 63); }
__global__ __launch_bounds__(256) void k_ssp(const float* h, float* ssp) {
    const int lane = threadIdx.x & 63, gw = blockIdx.x * 4 + (threadIdx.x >> 6), NGW = gridDim.x * 4;
    for (int r = gw; r < M; r += NGW) {
        const f32x4* xr = (const f32x4*)(h + (size_t)r * D) + lane * 4; float s = 0.f;
#pragma unroll
        for (int j = 0; j < 4; ++j) { const f32x4 v = xr[j]; s += (v[0] * v[0] + v[1] * v[1]) + (v[2] * v[2] + v[3] * v[3]); }
        s += __shfl_xor(s, 1); s += __shfl_xor(s, 2); s += __shfl_xor(s, 4); s += __shfl_xor(s, 8);
        if ((lane & 15) == 0) ssp[4 * (size_t)r + (lane >> 4)] = s;
    }
}

__device__ __forceinline__ void slot_info(const unsigned* cnt, int slot, int& e, int& pos, int& n) {
    int base = 0; e = -1; pos = 0; n = 0;
#pragma unroll
    for (int i = 0; i < NE; ++i) { const int c = (int)cnt[i], rows = ((c + 255) >> 8) << 8; if (e < 0 && slot < base + rows) { e = i; pos = slot - base; n = c; } base += rows; }
}

template <class E> __global__ __launch_bounds__(256) void k_ngemm(E e, int K) {
    const int lane = threadIdx.x & 63, w = threadIdx.x >> 6, fr = lane & 15, fq = lane >> 4;
    const int rb = blockIdx.y * 64, r0 = rb + (w >> 1) * 32, c0 = blockIdx.x * 64 + (w & 1) * 32;
    if (!e.tile_ok(rb)) return;
    constexpr int NP = E::PAIR ? 2 : 1;
    const u16* ap[2]; const u16* bp[2][NP];
#pragma unroll
    for (int i = 0; i < 2; ++i) ap[i] = e.a_row(r0 + 16 * i + fr) + 8 * fq;
#pragma unroll
    for (int j = 0; j < 2; ++j)
#pragma unroll
        for (int p = 0; p < NP; ++p) bp[j][p] = e.b_row(c0 + 16 * j + fr, p, rb) + 8 * fq;
    f32x4 acc[2][2][NP];
#pragma unroll
    for (int i = 0; i < 2; ++i)
#pragma unroll
        for (int j = 0; j < 2; ++j)
#pragma unroll
            for (int p = 0; p < NP; ++p) acc[i][j][p] = (f32x4){0.f, 0.f, 0.f, 0.f};
    for (int k = 0; k < K; k += 32) {
        bf16x8 av[2], bv[2][NP];
#pragma unroll
        for (int i = 0; i < 2; ++i) av[i] = *(const bf16x8*)(ap[i] + k);
#pragma unroll
        for (int j = 0; j < 2; ++j)
#pragma unroll
            for (int p = 0; p < NP; ++p) bv[j][p] = *(const bf16x8*)(bp[j][p] + k);
#pragma unroll
        for (int i = 0; i < 2; ++i)
#pragma unroll
            for (int j = 0; j < 2; ++j)
#pragma unroll
                for (int p = 0; p < NP; ++p) acc[i][j][p] = __builtin_amdgcn_mfma_f32_16x16x32_bf16(av[i], bv[j][p], acc[i][j][p], 0, 0, 0);
    }
#pragma unroll
    for (int i = 0; i < 2; ++i)
#pragma unroll
        for (int j = 0; j < 2; ++j)
#pragma unroll
            for (int q = 0; q < 4; ++q) { const float v0 = acc[i][j][0][q], v1 = E::PAIR ? acc[i][j][NP - 1][q] : 0.f; const float pv = __shfl_xor(v0, 8);
                e.store(r0 + 16 * i + 4 * fq + q, c0 + 16 * j + fr, v0, v1, pv); }
}

struct NE_Proj {
    static constexpr bool PAIR = false;
    const u16* A; const u16* Bt; const float* ssp; u16* Y; u16* XB;
    __device__ bool tile_ok(int) const { return true; }
    __device__ const u16* a_row(int r) const { return A + (size_t)r * D; }
    __device__ const u16* b_row(int c, int, int) const { return Bt + (size_t)c * D; }
    __device__ void store(int r, int c, float v, float, float) const { v *= rstd_of(ssp, r); if (c < 1024) Y[(size_t)r * D + c] = (u16)f2bf(gelu_tanh(v)); else XB[(size_t)r * D + c - 1024] = (u16)f2bf(v); }
};
struct NE_Gates {
    static constexpr bool PAIR = true;
    const u16* XC; const u16* WAX; const float* b_a; const float* b_x; const float* spl; float* LA; float* BX;
    __device__ bool tile_ok(int) const { return true; }
    __device__ const u16* a_row(int r) const { return XC + (size_t)r * D + 128 * blockIdx.z; }
    __device__ const u16* b_row(int c, int p, int) const { return WAX + ((size_t)blockIdx.z * 256 + c + 128 * p) * 128; }
    __device__ void store(int r, int c, float vr, float vi, float) const { const int ch = 128 * blockIdx.z + c;
        const float rg = sigmoidf_(vr + b_a[ch]), ig = sigmoidf_(vi + b_x[ch]), la = -8.0f * rg * spl[ch], xc = bf2f(XC[(size_t)r * D + ch]);
        LA[(size_t)r * D + ch] = la; BX[(size_t)r * D + ch] = sqrtf(one_minus_exp(2.0f * la)) * (ig * xc); }
};
struct NE_Res {
    static constexpr bool PAIR = false;
    const u16* A; const u16* Bt; int K; const float* Hin; float* Hout; u16* HB; const float* bias;
    __device__ bool tile_ok(int) const { return true; }
    __device__ const u16* a_row(int r) const { return A + (size_t)r * K; }
    __device__ const u16* b_row(int c, int, int) const { return Bt + (size_t)c * K; }
    __device__ void store(int r, int c, float v, float, float) const { const float h = (Hin ? Hin[(size_t)r * D + c] : bf2f(HB[(size_t)r * D + c])) + v + (bias ? bias[c] : 0.f); Hout[(size_t)r * D + c] = h; HB[(size_t)r * D + c] = (u16)f2bf(h); }
};
struct NE_GateUp {
    static constexpr bool PAIR = true;
    const u16* A; const u16* Bt; const float* ssp; u16* ACT;
    __device__ bool tile_ok(int) const { return true; }
    __device__ const u16* a_row(int r) const { return A + (size_t)r * D; }
    __device__ const u16* b_row(int c, int p, int) const { return Bt + (size_t)(256 * (c >> 7) + (c & 127) + 128 * p) * D; }
    __device__ void store(int r, int c, float g, float u, float) const { const float rs = rstd_of(ssp, r); ACT[(size_t)r * DFF + c] = (u16)f2bf(silu_(rs * g) * (rs * u)); }
};
struct NE_QKV {
    static constexpr bool PAIR = false;
    const u16* A; const u16* Bt; const float* ssp; const float* bias; const u16* rope; u16* Q; u16* Kb; u16* Vb;
    __device__ bool tile_ok(int) const { return true; }
    __device__ const u16* a_row(int r) const { return A + (size_t)r * D; }
    __device__ const u16* b_row(int c, int, int) const { return Bt + (size_t)c * D; }
    __device__ void store(int r, int c, float v, float, float pv) const {
        const float rs = rstd_of(ssp, r); v = rs * v + bias[c]; pv = rs * pv + bias[c ^ 8];
        const int d = c & 63;
        if (c < 1280 && d < 16) { const float cs = bf2f(rope[(size_t)r * 16 + (d & 7)]), sn = bf2f(rope[(size_t)r * 16 + 8 + (d & 7)]); v = d < 8 ? v * cs - pv * sn : v * cs + pv * sn; }
        if (c < 1024) Q[(size_t)r * D + c] = (u16)f2bf(v * (0.125f * LOG2E));
        else if (c < 1280) Kb[(size_t)r * KVD + c - 1024] = (u16)f2bf(v);
        else Vb[(size_t)r * KVD + c - 1280] = (u16)f2bf(v);
    }
};
struct NE_MoeUp {
    static constexpr bool PAIR = true;
    const u16* HB; const u16* WGU2; const float* ssp; const unsigned* cnt; const int* list; const float* gatew; u16* ACT2;
    __device__ bool tile_ok(int rb) const { int e, pos, n; slot_info(cnt, rb, e, pos, n); return e >= 0; }
    __device__ const u16* a_row(int r) const { int e, pos, n; slot_info(cnt, r, e, pos, n); const int tok = (e >= 0 && pos < n) ? (list[((size_t)e * M + pos) * 4] >> 1) : 0; return HB + (size_t)tok * D; }
    __device__ const u16* b_row(int c, int p, int rb) const { int e, pos, n; slot_info(cnt, rb, e, pos, n); return WGU2 + ((size_t)e * 7168 + 256 * (c >> 7) + (c & 127) + 128 * p) * D; }
    __device__ void store(int r, int c, float g, float u, float) const { int e, pos, n; slot_info(cnt, r, e, pos, n); float o = 0.f;
        if (e >= 0 && pos < n) { const int tok = list[((size_t)e * M + pos) * 4] >> 1; const float rs = rstd_of(ssp, tok); o = silu_(rs * g) * (rs * u) * gatew[((size_t)e * M + pos) * 4 + 1]; }
        ACT2[(size_t)r * DFF + c] = (u16)f2bf(o); }
};
struct NE_MoeDown {
    static constexpr bool PAIR = false;
    const u16* ACT2; const u16* WD2; const unsigned* cnt; const int* list; u16* MO;
    __device__ bool tile_ok(int rb) const { int e, pos, n; slot_info(cnt, rb, e, pos, n); return e >= 0; }
    __device__ const u16* a_row(int r) const { return ACT2 + (size_t)r * DFF; }
    __device__ const u16* b_row(int c, int, int rb) const { int e, pos, n; slot_info(cnt, rb, e, pos, n); return WD2 + ((size_t)e * 1024 + c) * DFF; }
    __device__ void store(int r, int c, float v, float, float) const { int e, pos, n; slot_info(cnt, r, e, pos, n);
        if (e >= 0 && pos < n) { const int tk = list[((size_t)e * M + pos) * 4]; MO[((size_t)(tk & 1) * M + (tk >> 1)) * D + c] = (u16)f2bf(v); } }
};

__global__ void k_conv1d(const u16* XB, const float* cw, const float* cb, u16* XC) {
    const size_t i = (size_t)blockIdx.x * blockDim.x + threadIdx.x; if (i >= (size_t)M * D) return;
    const int t = (int)(i >> 10), c = (int)(i & 1023); float s = cb[c];
#pragma unroll
    for (int k = 0; k < 4; ++k) { const int tt = t - 3 + k; if (tt >= 0) s += bf2f(XB[(size_t)tt * D + c]) * cw[k * D + c]; }
    XC[i] = (u16)f2bf(s);
}
__global__ __launch_bounds__(64) void k_scan_seq(const float* LA, const float* BX, const u16* Y, u16* G) {
    const int c = blockIdx.x * 64 + threadIdx.x; float h = 0.f;
    for (int t0 = 0; t0 < M; t0 += 8) {
        float la[8], bx[8], y[8];
#pragma unroll
        for (int j = 0; j < 8; ++j) { la[j] = LA[(size_t)(t0 + j) * D + c]; bx[j] = BX[(size_t)(t0 + j) * D + c]; y[j] = bf2f(Y[(size_t)(t0 + j) * D + c]); }
#pragma unroll
        for (int j = 0; j < 8; ++j) { h = __expf(la[j]) * h + bx[j]; G[(size_t)(t0 + j) * D + c] = (u16)f2bf(h * y[j]); }
    }
}

__global__ __launch_bounds__(64) void k_attn_ref(const u16* Q, const u16* Kb, const u16* Vb, const float* sinks, u16* ATT) {
    const int i = blockIdx.x * 64 + threadIdx.x; const int h = i / M, t = i % M, kvh = h >> 2;
    float q[64], o[64];
#pragma unroll
    for (int d = 0; d < 64; d += 2) { const unsigned w = *(const unsigned*)(Q + (size_t)t * D + 64 * h + d); q[d] = bf2f(w & 0xffffu); q[d + 1] = bf2f(w >> 16); o[d] = 0.f; o[d + 1] = 0.f; }
    float m = sinks[h] * LOG2E, l = 1.0f;
    const int j0 = t - (WIN - 1) > 0 ? t - (WIN - 1) : 0;
    for (int j = j0; j <= t; ++j) {
        const u16* kr = Kb + (size_t)j * KVD + 64 * kvh; const u16* vr = Vb + (size_t)j * KVD + 64 * kvh; float s = 0.f;
#pragma unroll
        for (int d = 0; d < 64; d += 2) { const unsigned w = *(const unsigned*)(kr + d); s += q[d] * bf2f(w & 0xffffu) + q[d + 1] * bf2f(w >> 16); }
        const float mn = fmaxf(m, s), al = exp2f(m - mn), p = exp2f(s - mn); l = l * al + p; m = mn;
#pragma unroll
        for (int d = 0; d < 64; d += 2) { const unsigned w = *(const unsigned*)(vr + d); o[d] = o[d] * al + p * bf2f(w & 0xffffu); o[d + 1] = o[d + 1] * al + p * bf2f(w >> 16); }
    }
    const float il = 1.0f / l;
#pragma unroll
    for (int d = 0; d < 64; d += 2) *(unsigned*)(ATT + (size_t)t * D + 64 * h + d) = pk2(o[d] * il, o[d + 1] * il);
}

__device__ __forceinline__ void router_group(const u16* HB, const float* WR, const float* ssp, unsigned* cnt, int* list, float* gatew, int grp, float* lds  ) {
    const int lane = threadIdx.x & 63, w = threadIdx.x >> 6;
    for (int tt = 0; tt < 8; ++tt) {
        const int tl = 8 * w + tt, t = 64 * grp + tl;
        const u32x4* hr = (const u32x4*)(HB + (size_t)t * D + 16 * lane); const u32x4 h0 = hr[0], h1 = hr[1];
        float x[16];
        x[0] = bf2f(h0.x & 0xffffu); x[1] = bf2f(h0.x >> 16); x[2] = bf2f(h0.y & 0xffffu); x[3] = bf2f(h0.y >> 16); x[4] = bf2f(h0.z & 0xffffu); x[5] = bf2f(h0.z >> 16); x[6] = bf2f(h0.w & 0xffffu); x[7] = bf2f(h0.w >> 16);
        x[8] = bf2f(h1.x & 0xffffu); x[9] = bf2f(h1.x >> 16); x[10] = bf2f(h1.y & 0xffffu); x[11] = bf2f(h1.y >> 16); x[12] = bf2f(h1.z & 0xffffu); x[13] = bf2f(h1.z >> 16); x[14] = bf2f(h1.w & 0xffffu); x[15] = bf2f(h1.w >> 16);
        float lg[8];
#pragma unroll
        for (int e = 0; e < 8; ++e) { const float* wr = WR + e * 1024 + 16 * lane; float s = 0.f;
#pragma unroll
            for (int k = 0; k < 16; ++k) s += x[k] * wr[k];
            lg[e] = wave_sum(s); }
        if (lane == 0) {
            const float rs = rstd_of(ssp, t);
            int e1 = 0; float v1 = lg[0];
#pragma unroll
            for (int e = 1; e < 8; ++e) if (lg[e] > v1) { v1 = lg[e]; e1 = e; }
            int e2 = -1; float v2 = -3.0e38f;
#pragma unroll
            for (int e = 0; e < 8; ++e) if (e != e1 && lg[e] > v2) { v2 = lg[e]; e2 = e; }
            const float g1 = 1.0f / (1.0f + __expf((v2 - v1) * rs));
            lds[tl * 4 + 0] = __builtin_bit_cast(float, e1); lds[tl * 4 + 1] = __builtin_bit_cast(float, e2); lds[tl * 4 + 2] = g1; lds[tl * 4 + 3] = 1.0f - g1;
        }
    }
    __syncthreads();
    if (w == 0) {
        const int e1 = __builtin_bit_cast(int, lds[lane * 4 + 0]), e2 = __builtin_bit_cast(int, lds[lane * 4 + 1]); const float g1 = lds[lane * 4 + 2], g2 = lds[lane * 4 + 3];
        const int t = 64 * grp + lane; const unsigned long long lt = (1ull << lane) - 1ull; const float rsl = rstd_of(ssp, t);
        for (int e = 0; e < 8; ++e) {
            const unsigned long long m1 = __ballot(e1 == e), m2 = __ballot(e2 == e); const int n1 = __popcll(m1), n2 = __popcll(m2);
            unsigned base = 0; if (lane == 0 && n1 + n2 > 0) base = atomicAdd(cnt + e, (unsigned)(n1 + n2));
            base = __shfl(base, 0);
            if (e1 == e) { const unsigned p = base + __popcll(m1 & lt); u32x4 r; r.x = (unsigned)(2 * t); r.y = __builtin_bit_cast(unsigned, g1); r.z = __builtin_bit_cast(unsigned, rsl); r.w = 0u; *(u32x4*)(list + ((size_t)e * M + p) * 4) = r; }
            if (e2 == e) { const unsigned p = base + n1 + __popcll(m2 & lt); u32x4 r; r.x = (unsigned)(2 * t + 1); r.y = __builtin_bit_cast(unsigned, g2); r.z = __builtin_bit_cast(unsigned, rsl); r.w = 0u; *(u32x4*)(list + ((size_t)e * M + p) * 4) = r; }
        }
    }
    __syncthreads();
}
__global__ __launch_bounds__(512) void k_router(Args a) {
    __shared__ float lds[64 * 4];
    unsigned* cnt = (unsigned*)(a.ws + WS_CTL) + CW_CNT;
    for (int g = blockIdx.x; g < M / 64; g += gridDim.x)
        router_group((const u16*)(a.ws + WS_HB), (const float*)(a.ws + WS_WR), (const float*)(a.ws + WS_SSP + 3 * 256 * 1024), cnt, (int*)(a.ws + WS_LIST), (float*)(a.ws + WS_GATEW), g, lds);
}

__device__ __forceinline__ void final_body(float* H, const u16* HBr, const u16* MO, const float* g, int gw, int NGW, int lane) {
    for (int r = gw; r < M; r += NGW) {
        f32x4 v[4]; float s = 0.f;
#pragma unroll
        for (int j = 0; j < 4; ++j) { const int c = 256 * j + 4 * lane; { const u32x2 hb = *(const u32x2*)(HBr + (size_t)r * D + c); v[j] = (f32x4){bf2f(hb.x & 0xffffu), bf2f(hb.x >> 16), bf2f(hb.y & 0xffffu), bf2f(hb.y >> 16)}; }
            const u32x2 a0 = *(const u32x2*)(MO + (size_t)r * D + c), a1 = *(const u32x2*)(MO + ((size_t)M + r) * D + c);
            v[j][0] += bf2f(a0.x & 0xffffu) + bf2f(a1.x & 0xffffu); v[j][1] += bf2f(a0.x >> 16) + bf2f(a1.x >> 16); v[j][2] += bf2f(a0.y & 0xffffu) + bf2f(a1.y & 0xffffu); v[j][3] += bf2f(a0.y >> 16) + bf2f(a1.y >> 16);
            s += (v[j][0] * v[j][0] + v[j][1] * v[j][1]) + (v[j][2] * v[j][2] + v[j][3] * v[j][3]); }
        const float rs = rsqrtf(wave_sum(s) * (1.0f / D) + EPS);
#pragma unroll
        for (int j = 0; j < 4; ++j) { const int c = 256 * j + 4 * lane; const f32x4 gg = *(const f32x4*)(g + c); *(f32x4*)(H + (size_t)r * D + c) = v[j] * rs * gg; }
    }
}
__global__ __launch_bounds__(256) void k_final(float* H, const u16* HBr, const u16* MO, const float* g) { final_body(H, HBr, MO, g, blockIdx.x * 4 + (threadIdx.x >> 6), gridDim.x * 4, threadIdx.x & 63); }

#define LAS __attribute__((address_space(3)))
typedef float f32x16 __attribute__((ext_vector_type(16)));
typedef short s16x4 __attribute__((ext_vector_type(4)));
typedef float f32x2v_t __attribute__((ext_vector_type(2)));
__device__ __forceinline__ unsigned cvt_pk_bf16(float lo, float hi) { unsigned r; asm volatile("v_cvt_pk_bf16_f32 %0, %1, %2" : "=v"(r) : "v"(lo), "v"(hi)); return r; }
__device__ __forceinline__ float fexp2(float x) { return __builtin_amdgcn_exp2f(x); }
__device__ __forceinline__ float frcp(float x) { return __builtin_amdgcn_rcpf(x); }
__device__ __forceinline__ float fsigmoid(float x) { return frcp(1.0f + fexp2(-LOG2E * x)); }
__device__ __forceinline__ float fsilu(float x) { return x * frcp(1.0f + fexp2(-LOG2E * x)); }
__device__ __forceinline__ float fgelu_tanh(float x) { const float z = 0.7978845608028654f * (x + 0.044715f * x * x * x); return x * frcp(1.0f + fexp2(-2.0f * LOG2E * z)); }

__device__ __forceinline__ u32x2 pk8_fp8(const float (&o)[8], float sc) {
    float t[8];
#pragma unroll
    for (int i = 0; i < 8; ++i) t[i] = __builtin_fminf(__builtin_fmaxf(o[i] * sc, -448.0f), 448.0f);
    int w0 = 0, w1 = 0; w0 = __builtin_amdgcn_cvt_pk_fp8_f32(t[0], t[1], w0, false); w0 = __builtin_amdgcn_cvt_pk_fp8_f32(t[2], t[3], w0, true);
    w1 = __builtin_amdgcn_cvt_pk_fp8_f32(t[4], t[5], w1, false); w1 = __builtin_amdgcn_cvt_pk_fp8_f32(t[6], t[7], w1, true);
    u32x2 r; r.x = (unsigned)w0; r.y = (unsigned)w1; return r;
}
constexpr int RING_BYTES = 131072;
constexpr int LX_P = RING_BYTES;
constexpr int LX_TBL = RING_BYTES + 4096;
constexpr int LX_ROUT = RING_BYTES + 8192;
constexpr int LX_MISC = RING_BYTES + 12288;
constexpr int LDS_BYTES = 147456;

namespace pg8 {
constexpr int BM = 256, BK = 64, HALF = 128, HTB = HALF * BK * 2, STAGE_BYTES = 8 * HTB, NXCD = 8, WGM = 8;
__device__ __forceinline__ int lds_byte(int r, int c) { const int st = (r >> 4) * 2 + (c >> 5), rr = r & 15, cc = c & 31, ob = rr * 64 + cc * 2; return st * 1024 + (ob ^ (((ob >> 9) & 1) << 5)); }
__device__ __forceinline__ void stage_rc(int b, int& R, int& C) { const int st = b / 1024, sb = b % 1024, swz = sb ^ (((sb >> 9) & 1) << 5); R = (st >> 1) * 16 + swz / 64; C = (st & 1) * 32 + (swz % 64) / 2; }
__device__ __forceinline__ int perm32(int rho) { const int n = rho >> 4, i = rho & 15; return 8 * (i >> 2) + 4 * n + (i & 3); }

struct Unit { int pm, pn, e; };
struct TileOrder {
    int nM, nN, nwg, G, c;
    __device__ __forceinline__ void init(int nM_, int nN_, int G_, int c_) { nM = nM_; nN = nN_; nwg = nM * nN; G = G_; c = c_; }
    __device__ __forceinline__ bool next_tile(int i, int& pm, int& pn) const {
        const long L = (long)i * G + c; if (L >= nwg) return false;
        int wgid = (int)L; { const int q = nwg / NXCD, r = nwg % NXCD, xcd = wgid % NXCD, off = wgid / NXCD; wgid = (xcd < r ? xcd * (q + 1) : r * (q + 1) + (xcd - r) * q) + off; }
        const int nig = WGM * nN, gid = wgid / nig, fm = gid * WGM, gsz = (nM - fm) < WGM ? (nM - fm) : WGM;
        pm = fm + ((wgid % nig) % gsz); pn = (wgid % nig) / gsz; return true;
    }
};
struct DenseSched {
    TileOrder o; const char* A; const char* Bt; int K;
    __device__ __forceinline__ bool next(int i, Unit& u) const { u.e = 0; return o.next_tile(i, u.pm, u.pn); }
    __device__ __forceinline__ const char* a_base(const Unit& u) const { return A + (size_t)u.pm * 256 * K * 2; }
    __device__ __forceinline__ const char* b_base(const Unit& u) const { return Bt + (size_t)u.pn * 256 * K * 2; }
    __device__ __forceinline__ unsigned a_off(const Unit&, int) const { return 0u; }
};
struct MoeSched {
    TileOrder o; const char* A; const char* Bt; int K; size_t bstride; const int* list; const LAS int* tbl;
    __device__ __forceinline__ bool next(int i, Unit& u) const {
        if (!o.next_tile(i, u.pm, u.pn)) return false;
        int e = 0;
#pragma unroll
        for (int j = 1; j < 8; ++j) e += (u.pm >= tbl[8 + j]) ? 1 : 0;
        u.e = __builtin_amdgcn_readfirstlane(e); return true;
    }
    __device__ __forceinline__ const char* a_base(const Unit& u) const { return list ? A : A + (size_t)u.pm * 256 * K * 2; }
    __device__ __forceinline__ const char* b_base(const Unit& u) const { return Bt + (size_t)u.e * bstride + (size_t)u.pn * 256 * K * 2; }
    __device__ __forceinline__ unsigned a_off(const Unit& u, int rl) const {
        const int pos = (u.pm - tbl[8 + u.e]) * 256 + rl; const int tok = list[((size_t)u.e * M + (pos < tbl[u.e] ? pos : 0)) * 4] >> 1; return (unsigned)tok * (unsigned)(K * 2);
    }
};
struct EpiCtx { int wr, wc, fr, fq, tid; LAS unsigned char* lds; };
typedef int i32x4 __attribute__((ext_vector_type(4)));
typedef int i32x8 __attribute__((ext_vector_type(8)));
__device__ __forceinline__ i32x8 cat8(bf16x8 lo, bf16x8 hi) { return __builtin_shufflevector(__builtin_bit_cast(i32x4, lo), __builtin_bit_cast(i32x4, hi), 0, 1, 2, 3, 4, 5, 6, 7); }
#define ACC_T const f32x4 (&acc)[2][2][4][2]

struct EpiProj {
    const float* ssp; u16* Y; u16* XB;
    __device__ __forceinline__ void operator()(ACC_T, const Unit& u, const EpiCtx& c) const {
        const int row0 = u.pm * 256 + c.wr * 64 + c.fr; const bool isY = u.pn < 4; u16* base = isY ? Y : XB; const int col0 = (u.pn & 3) * 256 + c.wc * 32 + 8 * c.fq;
        float rsv[8];
#pragma unroll
        for (int i = 0; i < 8; ++i) rsv[i] = rstd_of(ssp, row0 + (i >> 2) * 128 + (i & 3) * 16);
#pragma unroll
        for (int ai = 0; ai < 2; ++ai)
#pragma unroll
            for (int m = 0; m < 4; ++m) { const int row = row0 + ai * 128 + m * 16; const float rs = rsv[ai * 4 + m]; u16* rowp = base + (size_t)row * D + col0;
#pragma unroll
                for (int bj = 0; bj < 2; ++bj) { f32x4 v0 = acc[ai][bj][m][0] * rs, v1 = acc[ai][bj][m][1] * rs;
                    if (isY) {
#pragma unroll
                        for (int j = 0; j < 4; ++j) { v0[j] = fgelu_tanh(v0[j]); v1[j] = fgelu_tanh(v1[j]); } }
                    u32x4 w; w.x = cvt_pk_bf16(v0[0], v0[1]); w.y = cvt_pk_bf16(v0[2], v0[3]); w.z = cvt_pk_bf16(v1[0], v1[1]); w.w = cvt_pk_bf16(v1[2], v1[3]);
                    *(u32x4*)(rowp + bj * 128) = w; } }
    }
};
struct EpiGateUp {
    const float* ssp; u16* ACT;
    __device__ __forceinline__ void operator()(ACC_T, const Unit& u, const EpiCtx& c) const {
        const int row0 = u.pm * 256 + c.wr * 64 + c.fr, col0 = u.pn * 128 + c.wc * 32 + 8 * c.fq;
        float rsv[8];
#pragma unroll
        for (int i = 0; i < 8; ++i) rsv[i] = rstd_of(ssp, row0 + (i >> 2) * 128 + (i & 3) * 16);
#pragma unroll
        for (int ai = 0; ai < 2; ++ai)
#pragma unroll
            for (int m = 0; m < 4; ++m) { const int row = row0 + ai * 128 + m * 16; const float rs = rsv[ai * 4 + m]; float o[8];
#pragma unroll
                for (int n = 0; n < 2; ++n)
#pragma unroll
                    for (int j = 0; j < 4; ++j) o[4 * n + j] = fsilu(acc[ai][0][m][n][j] * rs) * (acc[ai][1][m][n][j] * rs);
                u32x4 w; w.x = cvt_pk_bf16(o[0], o[1]); w.y = cvt_pk_bf16(o[2], o[3]); w.z = cvt_pk_bf16(o[4], o[5]); w.w = cvt_pk_bf16(o[6], o[7]);
                *(u32x4*)(ACT + (size_t)row * DFF + col0) = w; }
    }
};
struct EpiRes {
    const float* Xin; u16* HB; const float* bias; float* ssp; unsigned char* HB8;
    __device__ __forceinline__ void operator()(ACC_T, const Unit& u, const EpiCtx& c) const {
        const int col0 = u.pn * 256 + c.wc * 32 + 8 * c.fq;
        f32x4 bv[2][2];
#pragma unroll
        for (int bj = 0; bj < 2; ++bj)
#pragma unroll
            for (int n = 0; n < 2; ++n) { bv[bj][n] = (f32x4){0.f, 0.f, 0.f, 0.f}; if (bias) bv[bj][n] = *(const f32x4*)(bias + col0 + bj * 128 + 4 * n); }
        LAS float* P = (LAS float*)(c.lds + LX_P);
#pragma unroll
        for (int g = 0; g < 4; ++g) {
            f32x4 hin[2][2][2];
#pragma unroll
            for (int q = 0; q < 2; ++q) { const int ai = g >> 1, m = (g & 1) * 2 + q; const size_t off = (size_t)(u.pm * 256 + ai * 128 + c.wr * 64 + m * 16 + c.fr) * D + col0;
#pragma unroll
                for (int bj = 0; bj < 2; ++bj) {
                    if (Xin) { hin[q][bj][0] = *(const f32x4*)(Xin + off + bj * 128); hin[q][bj][1] = *(const f32x4*)(Xin + off + bj * 128 + 4); }
                    else { const u32x4 hb = *(const u32x4*)(HB + off + bj * 128);
                        hin[q][bj][0] = (f32x4){bf2f(hb.x & 0xffffu), bf2f(hb.x >> 16), bf2f(hb.y & 0xffffu), bf2f(hb.y >> 16)}; hin[q][bj][1] = (f32x4){bf2f(hb.z & 0xffffu), bf2f(hb.z >> 16), bf2f(hb.w & 0xffffu), bf2f(hb.w >> 16)}; } } }
#pragma unroll
            for (int q = 0; q < 2; ++q) { const int ai = g >> 1, m = (g & 1) * 2 + q; const int rl = ai * 128 + c.wr * 64 + m * 16 + c.fr; const size_t off = (size_t)(u.pm * 256 + rl) * D + col0; float s = 0.f;
#pragma unroll
                for (int bj = 0; bj < 2; ++bj) {
                    const f32x4 h0 = hin[q][bj][0] + acc[ai][bj][m][0] + bv[bj][0], h1 = hin[q][bj][1] + acc[ai][bj][m][1] + bv[bj][1];
                    u32x4 w; w.x = cvt_pk_bf16(h0[0], h0[1]); w.y = cvt_pk_bf16(h0[2], h0[3]); w.z = cvt_pk_bf16(h1[0], h1[1]); w.w = cvt_pk_bf16(h1[2], h1[3]);
                    *(u32x4*)(HB + off + bj * 128) = w;
                    if (HB8) { const float o8[8] = {h0[0], h0[1], h0[2], h0[3], h1[0], h1[1], h1[2], h1[3]}; *(u32x2*)(HB8 + off + bj * 128) = pk8_fp8(o8, S8_A); }
                    s += ((h0[0] * h0[0] + h0[1] * h0[1]) + (h0[2] * h0[2] + h0[3] * h0[3])) + ((h1[0] * h1[0] + h1[1] * h1[1]) + (h1[2] * h1[2] + h1[3] * h1[3])); }
                s += __shfl_xor(s, 16); s += __shfl_xor(s, 32);
                if (c.fq == 0) P[rl * 4 + c.wc] = s; }
            asm volatile("" ::: "memory"); }
        asm volatile("s_waitcnt lgkmcnt(0)" ::: "memory"); __builtin_amdgcn_s_barrier(); asm volatile("" ::: "memory");
        if (c.tid < 256) { const f32x4 p = *(const LAS f32x4*)(P + 4 * c.tid); ssp[(size_t)(u.pm * 256 + c.tid) * 4 + u.pn] = (p[0] + p[1]) + (p[2] + p[3]); }
    }
};
struct EpiQKV {
    const float* ssp; const float* bias; const u16* rope; u16* Q; u16* Kb; u16* Vb;
    __device__ __forceinline__ void operator()(ACC_T, const Unit& u, const EpiCtx& c) const {
        const int row0 = u.pm * 256 + c.wr * 64 + c.fr, bcol0 = u.pn * 256 + c.wc * 32 + 8 * c.fq;
        u16* base; int pitch, col0; float sc = 1.0f;
        if (u.pn < 4) { base = Q; pitch = D; col0 = bcol0; sc = 0.125f * LOG2E; } else if (u.pn == 4) { base = Kb; pitch = KVD; col0 = bcol0 - 1024; } else { base = Vb; pitch = KVD; col0 = bcol0 - 1280; }
        const bool rot = (u.pn < 5) && ((c.wc & 1) == 0);
        f32x4 bv[2][2];
#pragma unroll
        for (int bj = 0; bj < 2; ++bj)
#pragma unroll
            for (int n = 0; n < 2; ++n) bv[bj][n] = *(const f32x4*)(bias + bcol0 + bj * 128 + 4 * n);
        float rsv[8];
#pragma unroll
        for (int i = 0; i < 8; ++i) rsv[i] = rstd_of(ssp, row0 + (i >> 2) * 128 + (i & 3) * 16);
#pragma unroll
        for (int g = 0; g < 4; ++g) {
            u32x4 rpv[2][2];
            if (rot) {
#pragma unroll
                for (int q2 = 0; q2 < 2; ++q2) { const u32x4* rp = (const u32x4*)(rope + (size_t)(row0 + (g >> 1) * 128 + ((g & 1) * 2 + q2) * 16) * 16); rpv[q2][0] = rp[0]; rpv[q2][1] = rp[1]; } }
#pragma unroll
            for (int q2 = 0; q2 < 2; ++q2) { const int ai = g >> 1, m = (g & 1) * 2 + q2; const int row = row0 + ai * 128 + m * 16; const float rs = rsv[ai * 4 + m];
                f32x4 cs0, cs1, sn0, sn1;
                if (rot) { const u32x4 cw = rpv[q2][0], sw = rpv[q2][1];
                    cs0 = (f32x4){bf2f(cw.x & 0xffffu), bf2f(cw.x >> 16), bf2f(cw.y & 0xffffu), bf2f(cw.y >> 16)}; cs1 = (f32x4){bf2f(cw.z & 0xffffu), bf2f(cw.z >> 16), bf2f(cw.w & 0xffffu), bf2f(cw.w >> 16)};
                    sn0 = (f32x4){bf2f(sw.x & 0xffffu), bf2f(sw.x >> 16), bf2f(sw.y & 0xffffu), bf2f(sw.y >> 16)}; sn1 = (f32x4){bf2f(sw.z & 0xffffu), bf2f(sw.z >> 16), bf2f(sw.w & 0xffffu), bf2f(sw.w >> 16)};
                    if (c.fq == 0) { sn0 = -sn0; sn1 = -sn1; } }
#pragma unroll
                for (int bj = 0; bj < 2; ++bj) { f32x4 v0 = acc[ai][bj][m][0] * rs + bv[bj][0], v1 = acc[ai][bj][m][1] * rs + bv[bj][1];
                    if (rot) { f32x4 p0, p1;
#pragma unroll
                        for (int j = 0; j < 4; ++j) { p0[j] = __shfl_xor(v0[j], 16); p1[j] = __shfl_xor(v1[j], 16); }
                        if (c.fq < 2) { v0 = v0 * cs0 + p0 * sn0; v1 = v1 * cs1 + p1 * sn1; } }
                    v0 = v0 * sc; v1 = v1 * sc;
                    u32x4 w; w.x = cvt_pk_bf16(v0[0], v0[1]); w.y = cvt_pk_bf16(v0[2], v0[3]); w.z = cvt_pk_bf16(v1[0], v1[1]); w.w = cvt_pk_bf16(v1[2], v1[3]);
                    *(u32x4*)(base + (size_t)row * pitch + col0 + bj * 128) = w; } } }
    }
};
struct EpiMoeUp {
    const float* ssp; const int* list; const float* gatew; const LAS int* tbl; u16* ACT2;
    __device__ __forceinline__ void operator()(ACC_T, const Unit& u, const EpiCtx& c) const {
        const int col0 = u.pn * 128 + c.wc * 32 + 8 * c.fq, n_e = tbl[u.e], pos0 = (u.pm - tbl[8 + u.e]) * 256;
        u32x4 rec[8];
#pragma unroll
        for (int i = 0; i < 8; ++i) { const int pos = pos0 + (i >> 2) * 128 + c.wr * 64 + (i & 3) * 16 + c.fr; rec[i] = *(const u32x4*)(list + ((size_t)u.e * M + (pos < n_e ? pos : 0)) * 4); }
#pragma unroll
        for (int ai = 0; ai < 2; ++ai)
#pragma unroll
            for (int m = 0; m < 4; ++m) { const int rl = ai * 128 + c.wr * 64 + m * 16 + c.fr;
                const bool valid = pos0 + rl < n_e; const unsigned gwu = rec[ai * 4 + m].y, rsu = rec[ai * 4 + m].z;
                const float gw = valid ? u2f(gwu) : 0.f; const float rs = u2f(rsu) * (MOE_FP8 ? 1.0f / (S8_A * S8_W) : 1.0f); float o[8];
#pragma unroll
                for (int n = 0; n < 2; ++n)
#pragma unroll
                    for (int j = 0; j < 4; ++j) o[4 * n + j] = fsilu(acc[ai][0][m][n][j] * rs) * (acc[ai][1][m][n][j] * rs) * gw;
                if (MOE_FP8) *(u32x2*)((unsigned char*)ACT2 + (size_t)(u.pm * 256 + rl) * DFF + col0) = pk8_fp8(o, S8_ACT);
                else { u32x4 w; w.x = cvt_pk_bf16(o[0], o[1]); w.y = cvt_pk_bf16(o[2], o[3]); w.z = cvt_pk_bf16(o[4], o[5]); w.w = cvt_pk_bf16(o[6], o[7]);
                    *(u32x4*)(ACT2 + (size_t)(u.pm * 256 + rl) * DFF + col0) = w; } }
    }
};
struct EpiMoeDown {
    const int* list; const LAS int* tbl; u16* MO;
    __device__ __forceinline__ void operator()(ACC_T, const Unit& u, const EpiCtx& c) const {
        const int col0 = u.pn * 256 + c.wc * 32 + 8 * c.fq, n_e = tbl[u.e], pos0 = (u.pm - tbl[8 + u.e]) * 256;
        int tkv[8];
#pragma unroll
        for (int i = 0; i < 8; ++i) { const int pos = pos0 + (i >> 2) * 128 + c.wr * 64 + (i & 3) * 16 + c.fr; const int v = list[((size_t)u.e * M + (pos < n_e ? pos : 0)) * 4]; tkv[i] = pos < n_e ? v : -1; }
#pragma unroll
        for (int ai = 0; ai < 2; ++ai)
#pragma unroll
            for (int m = 0; m < 4; ++m) {
                if (tkv[ai * 4 + m] >= 0) { const int tk = tkv[ai * 4 + m]; u16* dst = MO + ((size_t)(tk & 1) * M + (tk >> 1)) * D + col0;
#pragma unroll
                    for (int bj = 0; bj < 2; ++bj) { const float us = MOE_FP8 ? 1.0f / (S8_ACT * S8_WD) : 1.0f; const f32x4 v0 = acc[ai][bj][m][0] * us, v1 = acc[ai][bj][m][1] * us;
                        u32x4 w; w.x = cvt_pk_bf16(v0[0], v0[1]); w.y = cvt_pk_bf16(v0[2], v0[3]); w.z = cvt_pk_bf16(v1[0], v1[1]); w.w = cvt_pk_bf16(v1[2], v1[3]);
                        *(u32x4*)(dst + bj * 128) = w; } } }
    }
};

template <class Epi, class Sched, bool GATHER, bool FP8 = false>
__device__ __forceinline__ void gemm_phase(LAS unsigned char* lds, const int K, const Sched& S, const Epi& E) {
    const int tid = threadIdx.x, wid = __builtin_amdgcn_readfirstlane(tid >> 6), lane = tid & 63, wr = wid >> 2, wc = wid & 3, fr = lane & 15, fq = lane >> 4;
    const int nt = K / BK;
    EpiCtx ctx; ctx.wr = wr; ctx.wc = wc; ctx.fr = fr; ctx.fq = fq; ctx.tid = tid; ctx.lds = lds;
    unsigned voffA[2], voffB[2]; int RA[2]; unsigned CA[2];
#pragma unroll
    for (int i = 0; i < 2; ++i) { int R, C; stage_rc(tid * 16 + i * 8192, R, C); const int Rb = (R & ~31) + perm32(R & 31);
        voffA[i] = (unsigned)(R * K + C) * 2u; voffB[i] = (unsigned)(Rb * K + C) * 2u; RA[i] = R; CA[i] = (unsigned)C * 2u; }
    const size_t kstep = (size_t)(BK * 2);
    const size_t hstep = (size_t)HALF * K * 2;
    const unsigned ldsw = (unsigned)wid * 1024u;
    const int aoff = lds_byte(wr * 64 + fr, fq * 8), boff = lds_byte(wc * 32 + fr, fq * 8);
#define PG8_SA(b, h) (((b) * 2 + (h)) * HTB)
#define PG8_SB(b, h) ((4 + (b) * 2 + (h)) * HTB)
#define PG8_GLDS(src, dstoff) __builtin_amdgcn_global_load_lds((const unsigned*)(src), (LAS unsigned*)(lds + (dstoff)), 16, 0, 0)
#define PG8_STAGE_B(bufoff, gbase) do { _Pragma("unroll") for (int _i = 0; _i < 2; ++_i) PG8_GLDS((const char*)(gbase) + voffB[_i], (bufoff) + ldsw + _i * 8192); } while (0)
#define PG8_STAGE_A(bufoff, gk, h, VA) do { _Pragma("unroll") for (int _i = 0; _i < 2; ++_i) { \
        if constexpr (GATHER) PG8_GLDS((const char*)(gk) + VA[h][_i], (bufoff) + ldsw + _i * 8192); else PG8_GLDS((const char*)(gk) + (size_t)(h) * hstep + voffA[_i], (bufoff) + ldsw + _i * 8192); } } while (0)
#define PG8_LDA(dst, b, h) do { _Pragma("unroll") for (int m = 0; m < 4; ++m) _Pragma("unroll") for (int k = 0; k < 2; ++k) dst[m][k] = *(const LAS bf16x8*)(lds + PG8_SA(b, h) + aoff + m * 2048 + k * 1024); } while (0)
#define PG8_LDB(dst, b, h) do { _Pragma("unroll") for (int n = 0; n < 2; ++n) _Pragma("unroll") for (int k = 0; k < 2; ++k) dst[n][k] = *(const LAS bf16x8*)(lds + PG8_SB(b, h) + boff + n * 2048 + k * 1024); } while (0)
#define PG8_MMA(ai, bj, At, Bt) do { __builtin_amdgcn_s_setprio(1); _Pragma("unroll") for (int m = 0; m < 4; ++m) _Pragma("unroll") for (int n = 0; n < 2; ++n) { \
        if constexpr (FP8) asm volatile("v_mfma_scale_f32_16x16x128_f8f6f4 %0, %1, %2, %0, %3, %3 op_sel_hi:[0,0,0]" : "+v"(acc[ai][bj][m][n]) : "v"(cat8(Bt[n][0], Bt[n][1])), "v"(cat8(At[m][0], At[m][1])), "v"(one_scale)); \
        else { _Pragma("unroll") for (int k = 0; k < 2; ++k) acc[ai][bj][m][n] = __builtin_amdgcn_mfma_f32_16x16x32_bf16(Bt[n][k], At[m][k], acc[ai][bj][m][n], 0, 0, 0); } } \
        __builtin_amdgcn_s_setprio(0); } while (0)
#define PG8_WAIT_V(n) asm volatile("s_waitcnt vmcnt(" #n ")" ::: "memory")
#define PG8_WAIT_L(n) asm volatile("s_waitcnt lgkmcnt(" #n ")" ::: "memory")
#define PG8_BAR __builtin_amdgcn_s_barrier()
#define PG8_SCHED __builtin_amdgcn_sched_barrier(0)
    const int one_scale = 0x7f7f7f7f;
    Unit cur, nxt; int ui = 0;
    if (!S.next(0, cur)) return;
    f32x4 acc[2][2][4][2];
#pragma unroll
    for (int a = 0; a < 2; ++a)
#pragma unroll
        for (int b = 0; b < 2; ++b)
#pragma unroll
            for (int m = 0; m < 4; ++m)
#pragma unroll
                for (int n = 0; n < 2; ++n) acc[a][b][m][n] = (f32x4){0.f, 0.f, 0.f, 0.f};
    bf16x8 At[4][2], B0[2][2], B1[2][2];
    const char* cA = S.a_base(cur); const char* cB = S.b_base(cur);
    unsigned vaC[2][2], vaN[2][2];
#pragma unroll
    for (int h = 0; h < 2; ++h)
#pragma unroll
        for (int i = 0; i < 2; ++i) { vaC[h][i] = GATHER ? S.a_off(cur, h * HALF + RA[i]) + CA[i] : 0u; vaN[h][i] = vaC[h][i]; }
    PG8_STAGE_B(PG8_SB(0, 0), cB); PG8_STAGE_B(PG8_SB(0, 1), cB + hstep); PG8_STAGE_A(PG8_SA(0, 0), cA, 0, vaC); PG8_STAGE_A(PG8_SA(0, 1), cA, 1, vaC);
    if (wr == 1) PG8_BAR;
    PG8_WAIT_V(2); PG8_BAR;
    PG8_STAGE_B(PG8_SB(1, 0), cB + kstep); PG8_STAGE_A(PG8_SA(1, 0), cA + kstep, 0, vaC); PG8_STAGE_B(PG8_SB(1, 1), cB + hstep + kstep);
    PG8_WAIT_V(6); PG8_BAR;
    for (;;) {
        const bool has_next = S.next(ui + 1, nxt);
        const char* nA = has_next ? S.a_base(nxt) : cA; const char* nB = has_next ? S.b_base(nxt) : cB;
        if constexpr (GATHER) { if (has_next) {
#pragma unroll
            for (int h = 0; h < 2; ++h)
#pragma unroll
                for (int i = 0; i < 2; ++i) vaN[h][i] = S.a_off(nxt, h * HALF + RA[i]) + CA[i]; } }
#pragma unroll 1
        for (int t = 0; t < nt; t += 2) {
            const bool last = (t == nt - 2);
            const char* a1 = cA + (size_t)(t + 1) * kstep;
            const char* a2 = last ? nA : cA + (size_t)(t + 2) * kstep; const char* b2 = last ? nB : cB + (size_t)(t + 2) * kstep;
            const char* a3 = a2 + kstep; const char* b3 = b2 + kstep;
            unsigned v2[2][2];
#pragma unroll
            for (int h = 0; h < 2; ++h)
#pragma unroll
                for (int i = 0; i < 2; ++i) v2[h][i] = (GATHER && last) ? vaN[h][i] : vaC[h][i];
            PG8_LDB(B0, 0, 0); PG8_LDB(B1, 0, 1); PG8_SCHED; PG8_LDA(At, 0, 0); PG8_STAGE_A(PG8_SA(1, 1), a1, 1, vaC);
            PG8_WAIT_V(8); PG8_WAIT_L(0); PG8_BAR; PG8_MMA(0, 0, At, B0); PG8_MMA(0, 1, At, B1); PG8_BAR; PG8_SCHED;
            PG8_LDA(At, 0, 1); PG8_STAGE_B(PG8_SB(0, 0), b2); PG8_STAGE_B(PG8_SB(0, 1), b2 + hstep); PG8_STAGE_A(PG8_SA(0, 0), a2, 0, v2);
            PG8_WAIT_V(8); PG8_WAIT_L(0); PG8_BAR; PG8_MMA(1, 0, At, B0); PG8_MMA(1, 1, At, B1); PG8_BAR; PG8_SCHED;
            PG8_LDB(B0, 1, 0); PG8_LDB(B1, 1, 1); PG8_SCHED; PG8_LDA(At, 1, 0); PG8_STAGE_A(PG8_SA(0, 1), a2, 1, v2);
            PG8_WAIT_V(8); PG8_WAIT_L(0); PG8_BAR; PG8_MMA(0, 0, At, B0); PG8_MMA(0, 1, At, B1); PG8_BAR; PG8_SCHED;
            PG8_LDA(At, 1, 1); PG8_STAGE_B(PG8_SB(1, 0), b3); PG8_STAGE_B(PG8_SB(1, 1), b3 + hstep); PG8_STAGE_A(PG8_SA(1, 0), a3, 0, v2);
            PG8_WAIT_V(8); PG8_WAIT_L(0); PG8_BAR; PG8_MMA(1, 0, At, B0); PG8_MMA(1, 1, At, B1); PG8_BAR; PG8_SCHED;
        }
        if (wr == 0) PG8_BAR;
        E(acc, cur, ctx);
        if (!has_next) break;
#pragma unroll
        for (int a = 0; a < 2; ++a)
#pragma unroll
            for (int b = 0; b < 2; ++b)
#pragma unroll
                for (int m = 0; m < 4; ++m)
#pragma unroll
                    for (int n = 0; n < 2; ++n) acc[a][b][m][n] = (f32x4){0.f, 0.f, 0.f, 0.f};
        cur = nxt; cA = nA; cB = nB; ++ui;
#pragma unroll
        for (int h = 0; h < 2; ++h)
#pragma unroll
            for (int i = 0; i < 2; ++i) vaC[h][i] = vaN[h][i];
        if (wr == 1) PG8_BAR;
    }
    PG8_WAIT_V(0);
    PG8_BAR;
#undef PG8_SA
#undef PG8_SB
#undef PG8_GLDS
#undef PG8_STAGE_A
#undef PG8_STAGE_B
#undef PG8_LDA
#undef PG8_LDB
#undef PG8_MMA
#undef PG8_WAIT_V
#undef PG8_WAIT_L
#undef PG8_BAR
#undef PG8_SCHED
}
}

#define XB_TMO      128
#define XB_XCNT(j)  (256  + 64 * (j))
#define XB_XSUB(j)  (1280 + 64 * (j))
#define XB_XGEN(j)  (2304 + 64 * (j))
#define XB_TOP      3328
#define XB_TOPGEN   3392
#define XCD_BAR_WORDS 3456
#define XB_SPIN_CAP (1u << 18)
__device__ __forceinline__ unsigned xb_ld(unsigned* p)              { return __hip_atomic_load(p, __ATOMIC_RELAXED, __HIP_MEMORY_SCOPE_AGENT); }
__device__ __forceinline__ unsigned xb_add(unsigned* p, unsigned v) { return __hip_atomic_fetch_add(p, v, __ATOMIC_RELAXED, __HIP_MEMORY_SCOPE_AGENT); }
__device__ __forceinline__ unsigned xb_xcc_id() { return (unsigned)__builtin_amdgcn_s_getreg((3 << 11) | 20) & 0xFu; }
#define XB_SPIN(cond, bar) do { unsigned _sp = 0; while (cond) { __builtin_amdgcn_s_sleep(1); \
    if ((++_sp & 255u) == 0u) { if (xb_ld(&(bar)[XB_TMO])) break; if (_sp > XB_SPIN_CAP) { atomicAdd(&(bar)[XB_TMO], 1u); break; } } } } while (0)
struct XcdBarrier { unsigned* bar; unsigned x; volatile LAS unsigned* st; };
__device__ __forceinline__ XcdBarrier xcd_barrier_post(unsigned* bar, volatile LAS unsigned* st) {
    XcdBarrier b; b.bar = bar; b.x = xb_xcc_id(); b.st = st;
    if (threadIdx.x == 0) (void)xb_add(&bar[XB_XCNT(b.x)], 1u);
    return b;
}
__device__ __forceinline__ void xcd_barrier_complete(unsigned* bar, unsigned x, unsigned& nloc, unsigned& nx) {
    const unsigned G = gridDim.x * gridDim.y * gridDim.z;
    unsigned sum, cnt, mine, sp = 0u;
    for (;;) {
        sum = 0u; cnt = 0u; mine = 0u;
#pragma unroll
        for (unsigned j = 0; j < 16; ++j) { const unsigned c = xb_ld(&bar[XB_XCNT(j)]); sum += c; cnt += (c > 0u) ? 1u : 0u; mine = (j == x) ? c : mine; }
        if (sum == G) break;
        __builtin_amdgcn_s_sleep(1);
        if ((++sp & 255u) == 0u) { if (xb_ld(&bar[XB_TMO])) break; if (sp > XB_SPIN_CAP) { atomicAdd(&bar[XB_TMO], 1u); break; } }
    }
    nloc = mine > 0u ? mine : 1u; nx = cnt > 0u ? cnt : 1u;
}
__device__ __forceinline__ void xcd_barrier(const XcdBarrier& b) {
    asm volatile("s_waitcnt vmcnt(0)" ::: "memory");
    __syncthreads();
    if (threadIdx.x == 0) {
        unsigned* bar = b.bar;
        __builtin_amdgcn_s_waitcnt(0);
        unsigned nloc = b.st[0], nx = b.st[1];
        if (nloc == 0u) { xcd_barrier_complete(bar, b.x, nloc, nx); b.st[0] = nloc; b.st[1] = nx; }
        const unsigned old = xb_add(&bar[XB_XSUB(b.x)], 1u);
        const unsigned gen = old / nloc;
        if (old + 1u == (gen + 1u) * nloc) {
            __builtin_amdgcn_fence(__ATOMIC_RELEASE, "agent");
            asm volatile("s_waitcnt vmcnt(0)" ::: "memory");
            const unsigned og = xb_add(&bar[XB_TOP], 1u);
            const unsigned tg = og / nx;
            if (og + 1u == (tg + 1u) * nx) xb_add(&bar[XB_TOPGEN], 1u);
            else XB_SPIN(xb_ld(&bar[XB_TOPGEN]) == tg, bar);
            __builtin_amdgcn_fence(__ATOMIC_ACQUIRE, "agent");
            xb_add(&bar[XB_XGEN(b.x)], 1u);
            asm volatile("s_waitcnt vmcnt(0)" ::: "memory");
        } else {
            XB_SPIN(xb_ld(&bar[XB_XGEN(b.x)]) == gen, bar);
            __builtin_amdgcn_fence(__ATOMIC_ACQUIRE, "agent");
            asm volatile("s_waitcnt vmcnt(0)" ::: "memory");
        }
    }
    __syncthreads();
}
constexpr int CW_BAR = 4096;

constexpr int XS_STRIDE = 272;
constexpr int LR_XS = 0, LR_XC = 35840, LR_HS = LR_XC + 34816, LR_CP = LR_HS + 34816, LR_HIN = LR_CP + 2560;
static_assert(LR_HIN + 512 <= RING_BYTES, "lru lds");
template <bool FINAL>
__device__ __forceinline__ void lru_phase(const Args& a, LAS unsigned char* lds, int G, int vcu) {
    const int tid = threadIdx.x, lane = tid & 63, w = __builtin_amdgcn_readfirstlane(tid >> 6), fr = lane & 15, fq = lane >> 4;
    const u16* XB = (const u16*)(a.ws + WS_XB); const u16* Y = (const u16*)(a.ws + WS_Y); u16* Gout = (u16*)(a.ws + WS_G);
    const u16* WAX = (const u16*)(a.ws + WS_WAX); float* CAR = (float*)(a.ws + WS_CAR); const float* spl = (const float*)(a.ws + WS_SPL);
    const float* cw = a.in[6]; const float* cb = a.in[7]; const float* b_a = a.in[9]; const float* b_x = a.in[11];
    LAS float* CP = (LAS float*)(lds + LR_CP); LAS float* HIN = (LAS float*)(lds + LR_HIN);
    for (int unit = vcu; unit < 256; unit += G) {
        const int n = unit & 7, chunk = unit >> 3, t0 = chunk * 512, ch0 = 128 * n;
        u32x4 xpre[5];
#define LRU_XLOAD(ts_) do { _Pragma("unroll") for (int i = 0; i < 5; ++i) { const int p = tid + 512 * i, row = p >> 4, pc = p & 15, t = (ts_) - 3 + row; xpre[i] = (u32x4){0u, 0u, 0u, 0u}; \
            if (p < 131 * 16 && t >= 0) xpre[i] = *(const u32x4*)(XB + (size_t)t * D + ch0 + 8 * pc); } } while (0)
        LRU_XLOAD(t0);
        bf16x8 bfr[4], bfi[4];
        { const u16* wb = WAX + ((size_t)n * 256 + 16 * w + fr) * 128 + 8 * fq;
#pragma unroll
          for (int s = 0; s < 4; ++s) { bfr[s] = *(const bf16x8*)(wb + 32 * s); bfi[s] = *(const bf16x8*)(wb + 128 * 128 + 32 * s); } }
        const int ch = ch0 + 16 * w + fr; const float nba = -LOG2E * b_a[ch], nbx = -LOG2E * b_x[ch], c1 = -8.0f * LOG2E * spl[ch];
        for (int i = tid; i < 5 * 128; i += 512) { const int k = i >> 7, c = i & 127; CP[i] = k < 4 ? cw[k * D + ch0 + c] : cb[ch0 + c]; }
        float H = 0.f, Ptot = 1.f;
        if (FINAL) {
            const int hh = lane >> 5, jj = lane & 31;
#pragma unroll
            for (int it = 0; it < 8; ++it) { const int cl = 16 * w + 2 * it + hh; float A = 1.f, h = 0.f;
                if (jj < chunk) { const f32x2v_t v = *(const f32x2v_t*)(CAR + (((size_t)n * 32 + jj) * 128 + cl) * 2); A = v.x; h = v.y; }
#pragma unroll
                for (int d = 1; d < 32; d <<= 1) { const float Ap = __shfl_up(A, d, 32), hp = __shfl_up(h, d, 32); if (jj >= d) { h = A * hp + h; A = A * Ap; } }
                if (jj == 31) HIN[cl] = h; }
        }
        __syncthreads();
        if (FINAL) H = HIN[16 * w + fr];
        for (int s = 0; s < 4; ++s) {
            const int ts = t0 + 128 * s;
#pragma unroll
            for (int i = 0; i < 5; ++i) { const int p = tid + 512 * i, row = p >> 4, pc = p & 15; if (p < 131 * 16) *(LAS u32x4*)(lds + LR_XS + row * XS_STRIDE + pc * 16) = xpre[i]; }
            __syncthreads();
            if (s < 3) LRU_XLOAD(ts + 128);
            u32x4 ypre[4];
            if (FINAL) {
#pragma unroll
                for (int i = 0; i < 4; ++i) { const int p = tid + 512 * i, row = p >> 4, pc = p & 15; ypre[i] = *(const u32x4*)(Y + (size_t)(ts + row) * D + ch0 + 8 * pc); } }
            { const int cg = tid & 15, tg = tid >> 4; float o[4][8], wk[4][8];
#pragma unroll
              for (int k = 0; k < 4; ++k) { const f32x4 w0 = *(const LAS f32x4*)(CP + k * 128 + 8 * cg), w1 = *(const LAS f32x4*)(CP + k * 128 + 8 * cg + 4);
#pragma unroll
                  for (int i = 0; i < 4; ++i) { wk[k][i] = w0[i]; wk[k][4 + i] = w1[i]; } }
              { const f32x4 b0 = *(const LAS f32x4*)(CP + 512 + 8 * cg), b1 = *(const LAS f32x4*)(CP + 512 + 8 * cg + 4);
#pragma unroll
                for (int jt = 0; jt < 4; ++jt)
#pragma unroll
                    for (int i = 0; i < 4; ++i) { o[jt][i] = b0[i]; o[jt][4 + i] = b1[i]; } }
#pragma unroll
              for (int rr = 0; rr < 7; ++rr) { const u32x4 xv = *(const LAS u32x4*)(lds + LR_XS + (4 * tg + rr) * XS_STRIDE + cg * 16); float xf[8];
                  xf[0] = bf2f(xv.x & 0xffffu); xf[1] = bf2f(xv.x >> 16); xf[2] = bf2f(xv.y & 0xffffu); xf[3] = bf2f(xv.y >> 16); xf[4] = bf2f(xv.z & 0xffffu); xf[5] = bf2f(xv.z >> 16); xf[6] = bf2f(xv.w & 0xffffu); xf[7] = bf2f(xv.w >> 16);
#pragma unroll
                  for (int jt = 0; jt < 4; ++jt) { const int k = rr - jt; if (k >= 0 && k <= 3) {
#pragma unroll
                      for (int i = 0; i < 8; ++i) o[jt][i] += xf[i] * wk[k][i]; } } }
#pragma unroll
              for (int jt = 0; jt < 4; ++jt) { u32x4 wv; wv.x = cvt_pk_bf16(o[jt][0], o[jt][1]); wv.y = cvt_pk_bf16(o[jt][2], o[jt][3]); wv.z = cvt_pk_bf16(o[jt][4], o[jt][5]); wv.w = cvt_pk_bf16(o[jt][6], o[jt][7]);
                  *(LAS u32x4*)(lds + LR_XC + (4 * tg + jt) * XS_STRIDE + cg * 16) = wv; } }
            __syncthreads();
            f32x4 ar[8], ag[8];
#pragma unroll
            for (int m = 0; m < 8; ++m) { ar[m] = (f32x4){0.f, 0.f, 0.f, 0.f}; ag[m] = (f32x4){0.f, 0.f, 0.f, 0.f}; }
#pragma unroll
            for (int m = 0; m < 8; ++m)
#pragma unroll
                for (int s2 = 0; s2 < 4; ++s2) { const bf16x8 af = *(const LAS bf16x8*)(lds + LR_XC + (16 * m + fr) * XS_STRIDE + (32 * s2 + 8 * fq) * 2);
                    ar[m] = __builtin_amdgcn_mfma_f32_16x16x32_bf16(af, bfr[s2], ar[m], 0, 0, 0); ag[m] = __builtin_amdgcn_mfma_f32_16x16x32_bf16(af, bfi[s2], ag[m], 0, 0, 0); }
#pragma unroll
            for (int m = 0; m < 8; ++m) {
                float av[4], hv[4]; float Aseg = 1.f, Bseg = 0.f;
#pragma unroll
                for (int j = 0; j < 4; ++j) { const int tl = 16 * m + 4 * fq + j;
                    const float rg = frcp(1.0f + fexp2(__builtin_fmaf(ar[m][j], -LOG2E, nba))), ig = frcp(1.0f + fexp2(__builtin_fmaf(ag[m][j], -LOG2E, nbx)));
                    const float a_ = fexp2(c1 * rg);
                    const float xc = bf2f(*(const LAS u16*)(lds + LR_XC + tl * XS_STRIDE + (16 * w + fr) * 2));
                    const float b_ = __builtin_amdgcn_sqrtf(__builtin_fmaf(-a_, a_, 1.0f)) * (ig * xc);
                    Bseg = __builtin_fmaf(a_, Bseg, b_); Aseg *= a_; av[j] = Aseg; hv[j] = Bseg; }
                const float A1 = __shfl_xor(Aseg, 16), B1 = __shfl_xor(Bseg, 16);
                const bool odd = (fq & 1) != 0, hi2 = fq >= 2;
                const float Ap = Aseg * A1, Bp = odd ? __builtin_fmaf(Aseg, B1, Bseg) : __builtin_fmaf(A1, Bseg, B1);
                const float A2 = __shfl_xor(Ap, 32), B2 = __shfl_xor(Bp, 32);
                const float hpair = hi2 ? __builtin_fmaf(A2, H, B2) : H;
                const float my = odd ? __builtin_fmaf(A1, hpair, B1) : hpair;
                const float Alo = hi2 ? A2 : Ap, Blo = hi2 ? B2 : Bp, Ahi = hi2 ? Ap : A2, Bhi = hi2 ? Bp : B2;
                H = __builtin_fmaf(Ahi, __builtin_fmaf(Alo, H, Blo), Bhi); Ptot *= Alo * Ahi;
                if (FINAL) {
#pragma unroll
                    for (int j = 0; j < 4; ++j) { const int tl = 16 * m + 4 * fq + j; *(LAS u16*)(lds + LR_HS + tl * XS_STRIDE + (16 * w + fr) * 2) = (u16)f2bf(__builtin_fmaf(av[j], my, hv[j])); } }
            }
            if (FINAL) {
                __syncthreads();
#pragma unroll
                for (int i = 0; i < 4; ++i) { const int p = tid + 512 * i, row = p >> 4, pc = p & 15; const size_t go = (size_t)(ts + row) * D + ch0 + 8 * pc;
                    const u32x4 hv = *(const LAS u32x4*)(lds + LR_HS + row * XS_STRIDE + pc * 16); const u32x4 yv = ypre[i]; u32x4 ov;
                    ov.x = cvt_pk_bf16(bf2f(hv.x & 0xffffu) * bf2f(yv.x & 0xffffu), bf2f(hv.x >> 16) * bf2f(yv.x >> 16)); ov.y = cvt_pk_bf16(bf2f(hv.y & 0xffffu) * bf2f(yv.y & 0xffffu), bf2f(hv.y >> 16) * bf2f(yv.y >> 16));
                    ov.z = cvt_pk_bf16(bf2f(hv.z & 0xffffu) * bf2f(yv.z & 0xffffu), bf2f(hv.z >> 16) * bf2f(yv.z >> 16)); ov.w = cvt_pk_bf16(bf2f(hv.w & 0xffffu) * bf2f(yv.w & 0xffffu), bf2f(hv.w >> 16) * bf2f(yv.w >> 16));
                    *(u32x4*)(Gout + go) = ov; }
            }
        }
#undef LRU_XLOAD
        if (!FINAL) { if (fq == 0) { f32x2v_t v; v.x = Ptot; v.y = H; *(f32x2v_t*)(CAR + (((size_t)n * 32 + chunk) * 128 + 16 * w + fr) * 2) = v; } }
        __syncthreads();
    }
}

constexpr int AT_KS = 144, AT_K = 0, AT_V = 256 * AT_KS;
__device__ __forceinline__ int crow(int r, int hi) { return (r & 3) + 8 * (r >> 2) + 4 * hi; }
__device__ __forceinline__ void attn_phase(const Args& a, LAS unsigned char* lds, int G, int vcu) {
    const int tid = threadIdx.x, lane = tid & 63, w = __builtin_amdgcn_readfirstlane(tid >> 6), r32 = lane & 31, hi = lane >> 5;
    const u16* Q = (const u16*)(a.ws + WS_Q); const u16* Kb = (const u16*)(a.ws + WS_K); const u16* Vb = (const u16*)(a.ws + WS_V); u16* ATT = (u16*)(a.ws + WS_ATT);
    const float* sinks = a.in[16];
    for (int unit = vcu; unit < 512; unit += G) {
        const int kvh = unit & 3, b = unit >> 2;
        for (int p = tid; p < 256 * 8; p += 512) { const int idx = p >> 3, pc = p & 7, t = 128 * (b - 1) + idx;
            if (t >= 0) { const u32x4 kv = *(const u32x4*)(Kb + (size_t)t * KVD + 64 * kvh + 8 * pc), vv = *(const u32x4*)(Vb + (size_t)t * KVD + 64 * kvh + 8 * pc);
                *(LAS u32x4*)(lds + AT_K + idx * AT_KS + pc * 16) = kv; *(LAS u32x4*)(lds + AT_V + idx * AT_KS + pc * 16) = vv; } }
        __syncthreads();
        const int head = 4 * kvh + (w >> 1), qh = w & 1; const float sink2 = sinks[head] * LOG2E;
        for (int qt = 0; qt < 2; ++qt) {
            const int q0 = 64 * qh + 32 * qt, t = 128 * b + q0 + r32;
            bf16x8 qf[4];
#pragma unroll
            for (int s = 0; s < 4; ++s) qf[s] = *(const bf16x8*)(Q + (size_t)t * D + 64 * head + 16 * s + 8 * hi);
            f32x16 o0, o1;
#pragma unroll
            for (int r = 0; r < 16; ++r) { o0[r] = 0.f; o1[r] = 0.f; }
            float mx = sink2, l = 1.0f; const int kt0 = q0 >> 5;
            for (int kk = 0; kk < 5; ++kk) { const int kt = kt0 + kk; if (b == 0 && kt < 4) continue;
                f32x16 sc;
#pragma unroll
                for (int r = 0; r < 16; ++r) sc[r] = 0.f;
#pragma unroll
                for (int s = 0; s < 4; ++s) { const bf16x8 kf = *(const LAS bf16x8*)(lds + AT_K + (32 * kt + r32) * AT_KS + (16 * s + 8 * hi) * 2); sc = __builtin_amdgcn_mfma_f32_32x32x16_bf16(kf, qf[s], sc, 0, 0, 0); }
                const int base = 32 * kt + 4 * hi - (128 + q0 + r32); float mt = -1.0e30f;
#pragma unroll
                for (int r = 0; r < 16; ++r) { const int rel = base + (r & 3) + 8 * (r >> 2); if (!(rel <= 0 && rel > -WIN)) sc[r] = -1.0e30f; mt = fmaxf(mt, sc[r]); }
                mt = fmaxf(mt, __shfl_xor(mt, 32));
                const float mn = fmaxf(mx, mt), al = fexp2(mx - mn); float ps = 0.f;
#pragma unroll
                for (int r = 0; r < 16; ++r) { const float p = fexp2(sc[r] - mn); sc[r] = p; ps += p; }
                ps += __shfl_xor(ps, 32); l = l * al + ps; mx = mn;
#pragma unroll
                for (int r = 0; r < 16; ++r) { o0[r] *= al; o1[r] *= al; }
                u32x4 pa, pb; pa.x = cvt_pk_bf16(sc[0], sc[1]); pa.y = cvt_pk_bf16(sc[2], sc[3]); pa.z = cvt_pk_bf16(sc[4], sc[5]); pa.w = cvt_pk_bf16(sc[6], sc[7]);
                pb.x = cvt_pk_bf16(sc[8], sc[9]); pb.y = cvt_pk_bf16(sc[10], sc[11]); pb.z = cvt_pk_bf16(sc[12], sc[13]); pb.w = cvt_pk_bf16(sc[14], sc[15]);
                const bf16x8 pf0 = __builtin_bit_cast(bf16x8, pa), pf1 = __builtin_bit_cast(bf16x8, pb);
#pragma unroll
                for (int s2 = 0; s2 < 2; ++s2)
#pragma unroll
                    for (int dt = 0; dt < 2; ++dt) {
                        const int va = AT_V + (32 * kt + 16 * s2 + 4 * hi + ((lane & 15) >> 2)) * AT_KS + (32 * dt + 16 * ((lane >> 4) & 1) + 4 * (lane & 3)) * 2;
                        const s16x4 lo = __builtin_bit_cast(s16x4, __builtin_amdgcn_ds_read_tr16_b64_v4i16((LAS s16x4*)(lds + va)));
                        const s16x4 hi4 = __builtin_bit_cast(s16x4, __builtin_amdgcn_ds_read_tr16_b64_v4i16((LAS s16x4*)(lds + va + 8 * AT_KS)));
                        const bf16x8 vf = (bf16x8){lo[0], lo[1], lo[2], lo[3], hi4[0], hi4[1], hi4[2], hi4[3]};
                        if (dt == 0) o0 = __builtin_amdgcn_mfma_f32_32x32x16_bf16(vf, s2 ? pf1 : pf0, o0, 0, 0, 0); else o1 = __builtin_amdgcn_mfma_f32_32x32x16_bf16(vf, s2 ? pf1 : pf0, o1, 0, 0, 0); }
            }
            const float il = 1.0f / l;
#pragma unroll
            for (int g4 = 0; g4 < 4; ++g4) { u32x2 w0, w1;
                w0.x = cvt_pk_bf16(o0[4 * g4] * il, o0[4 * g4 + 1] * il); w0.y = cvt_pk_bf16(o0[4 * g4 + 2] * il, o0[4 * g4 + 3] * il);
                w1.x = cvt_pk_bf16(o1[4 * g4] * il, o1[4 * g4 + 1] * il); w1.y = cvt_pk_bf16(o1[4 * g4 + 2] * il, o1[4 * g4 + 3] * il);
                *(u32x2*)(ATT + (size_t)t * D + 64 * head + 8 * g4 + 4 * hi) = w0; *(u32x2*)(ATT + (size_t)t * D + 64 * head + 32 + 8 * g4 + 4 * hi) = w1; }
        }
        __syncthreads();
    }
}

constexpr int NPHASE = 14;
__global__ void __launch_bounds__(512, 2) mega(Args a) {
    extern __shared__ __attribute__((aligned(16))) unsigned char lds_raw[];
    LAS unsigned char* lds = (LAS unsigned char*)lds_raw;
    const int tid = threadIdx.x, lane = tid & 63, wave = __builtin_amdgcn_readfirstlane(tid >> 6);
    const int G = gridDim.x; const int bx = blockIdx.x; const int vcu = (G % 8 == 0) ? (bx % 8) * (G / 8) + bx / 8 : bx;
    unsigned char* ws = a.ws; unsigned* ctl = (unsigned*)(ws + WS_CTL);
    volatile LAS unsigned* MISC = (volatile LAS unsigned*)(lds + LX_MISC);
    for (int u = tid; u < 112; u += 512) ((LAS unsigned*)(lds + LX_MISC))[u] = 0u;
    __syncthreads();
    const int lo = a.ph_lo, hi = a.ph_hi;
    XcdBarrier bar; bar.bar = ctl + CW_BAR; bar.x = 0; bar.st = nullptr;
    if (hi - lo > 1) bar = xcd_barrier_post(ctl + CW_BAR, MISC + 8);
#define IN(k) (lo <= (k) && (k) < hi)
#ifndef REP_MASK
#define REP_MASK 0
#endif
#define REPS(k) for (int rep_ = 0; rep_ < 1 + ((REP_MASK >> (k)) & 1); ++rep_)
#define SEAM(k) do { if (IN(k) && IN((k) + 1)) xcd_barrier(bar); } while (0)
    float* H = a.out; u16* HB = (u16*)(ws + WS_HB);
    float* SSP0 = (float*)(ws + WS_SSP); float* SSP1 = SSP0 + 65536; float* SSP2 = SSP1 + 65536; float* SSP3 = SSP2 + 65536;
    unsigned* cnt = ctl + CW_CNT; int* list = (int*)(ws + WS_LIST); float* gatew = (float*)(ws + WS_GATEW);
    const int gw = vcu * 8 + wave, NGW = G * 8;

    if (IN(0)) REPS(0) {
        tables_body(a, vcu * 512 + tid, G * 512);
        convert_body(a, (float*)(lds_raw + wave * 16384), gw, NGW, lane);
        rowprep_body(a.in[0], HB, SSP0, gw, NGW, lane);
    }
    SEAM(0);
    if (IN(1)) REPS(1) { pg8::DenseSched S; S.o.init(M / 256, 2048 / 256, G, bx); S.A = (const char*)HB; S.Bt = (const char*)(ws + WS_WIN); S.K = 1024;
        pg8::EpiProj E{SSP0, (u16*)(ws + WS_Y), (u16*)(ws + WS_XB)}; pg8::gemm_phase<pg8::EpiProj, pg8::DenseSched, false>(lds, 1024, S, E); }
    SEAM(1);
    if (IN(2)) REPS(2) lru_phase<false>(a, lds, G, vcu);
    SEAM(2);
    if (IN(3)) REPS(3) lru_phase<true>(a, lds, G, vcu);
    SEAM(3);
    if (IN(4)) REPS(4) { pg8::DenseSched S; S.o.init(M / 256, 4, G, bx); S.A = (const char*)(ws + WS_G); S.Bt = (const char*)(ws + WS_WOUT); S.K = 1024;
        pg8::EpiRes E{a.in[0], HB, nullptr, SSP1, nullptr}; pg8::gemm_phase<pg8::EpiRes, pg8::DenseSched, false>(lds, 1024, S, E); }
    SEAM(4);
    if (IN(5)) REPS(5) { pg8::DenseSched S; S.o.init(M / 256, 7168 / 256, G, bx); S.A = (const char*)HB; S.Bt = (const char*)(ws + WS_WGU); S.K = 1024;
        pg8::EpiGateUp E{SSP1, (u16*)(ws + WS_ACT)}; pg8::gemm_phase<pg8::EpiGateUp, pg8::DenseSched, false>(lds, 1024, S, E); }
    SEAM(5);
    if (IN(6)) { pg8::DenseSched S; S.o.init(M / 256, 4, G, bx); S.A = (const char*)(ws + WS_ACT); S.Bt = (const char*)(ws + WS_WD); S.K = DFF;
        pg8::EpiRes E{nullptr, HB, nullptr, SSP2, nullptr}; pg8::gemm_phase<pg8::EpiRes, pg8::DenseSched, false>(lds, DFF, S, E); }
    SEAM(6);
    if (IN(7)) REPS(7) { pg8::DenseSched S; S.o.init(M / 256, NQKV / 256, G, bx); S.A = (const char*)HB; S.Bt = (const char*)(ws + WS_WQKV); S.K = 1024;
        pg8::EpiQKV E{SSP2, a.in[15], (const u16*)(ws + WS_ROPE), (u16*)(ws + WS_Q), (u16*)(ws + WS_K), (u16*)(ws + WS_V)}; pg8::gemm_phase<pg8::EpiQKV, pg8::DenseSched, false>(lds, 1024, S, E); }
    SEAM(7);
    if (IN(8)) REPS(8) attn_phase(a, lds, G, vcu);
    SEAM(8);
    if (IN(9)) { pg8::DenseSched S; S.o.init(M / 256, 4, G, bx); S.A = (const char*)(ws + WS_ATT); S.Bt = (const char*)(ws + WS_WO); S.K = 1024;
        pg8::EpiRes E{nullptr, HB, a.in[18], SSP3, MOE_FP8 ? (unsigned char*)(ws + WS_HB8) : nullptr}; pg8::gemm_phase<pg8::EpiRes, pg8::DenseSched, false>(lds, 1024, S, E); }
    SEAM(9);
    if (IN(10)) { for (int g = vcu; g < M / 64; g += G) router_group(HB, (const float*)(ws + WS_WR), SSP3, cnt, list, gatew, g, (float*)(lds_raw + LX_ROUT)); }
    SEAM(10);
    LAS int* tbl = (LAS int*)(lds + LX_TBL);
    if (IN(11) || IN(12)) { if (tid == 0) { int acc = 0; for (int e = 0; e < 8; ++e) { const int c = (int)__hip_atomic_load(cnt + e, __ATOMIC_RELAXED, __HIP_MEMORY_SCOPE_AGENT); tbl[e] = c; tbl[8 + e] = acc; acc += (c + 255) >> 8; } tbl[16] = acc; } __syncthreads(); }
    if (IN(11)) REPS(11) { pg8::MoeSched S; S.o.init(__builtin_amdgcn_readfirstlane(tbl[16]), 7168 / 256, G, bx); S.A = MOE_FP8 ? (const char*)(ws + WS_HB8) : (const char*)HB; S.Bt = (const char*)(ws + WS_WGU2); S.K = MOE_FP8 ? 512 : 1024; S.bstride = (size_t)7168 * 1024 * (MOE_FP8 ? 1 : 2); S.list = list; S.tbl = tbl;
        pg8::EpiMoeUp E{SSP3, list, gatew, tbl, (u16*)(ws + WS_ACT2)}; pg8::gemm_phase<pg8::EpiMoeUp, pg8::MoeSched, true, MOE_FP8 != 0>(lds, MOE_FP8 ? 512 : 1024, S, E); }
    SEAM(11);
    if (IN(12)) REPS(12) { pg8::MoeSched S; S.o.init(__builtin_amdgcn_readfirstlane(tbl[16]), 4, G, bx); S.A = (const char*)(ws + WS_ACT2); S.Bt = (const char*)(ws + WS_WD2); S.K = MOE_FP8 ? DFF / 2 : DFF; S.bstride = (size_t)1024 * DFF * (MOE_FP8 ? 1 : 2); S.list = nullptr; S.tbl = tbl;
        pg8::EpiMoeDown E{list, tbl, (u16*)(ws + WS_MO)}; pg8::gemm_phase<pg8::EpiMoeDown, pg8::MoeSched, false, MOE_FP8 != 0>(lds, MOE_FP8 ? DFF / 2 : DFF, S, E); }
    SEAM(12);
    if (IN(13)) final_body(H, HB, (const u16*)(ws + WS_MO), a.in[4], gw, NGW, lane);
#undef IN
#undef SEAM
}
#ifndef MK_MODE
#define MK_MODE 1
#endif
#ifndef FASTMASK
#define FASTMASK 0x3fff
#endif
extern "C" void kernel_launch(void* const* d_in, const int* in_sizes, int n_in, void* d_out, int out_size, void* d_ws, size_t ws_size, hipStream_t stream) {
    if (n_in != 26 || out_size != M * D || ws_size < WS_END) { fprintf(stderr, "kernel_launch: unexpected shapes (n_in %d out %d ws %zu, need %zu)\n", n_in, out_size, ws_size, (size_t)WS_END); return; }
    static int grid = 0;
    if (grid == 0) {
        int dev = 0, cus = 0, per_cu = 0;
        if (hipGetDevice(&dev) != hipSuccess || hipDeviceGetAttribute(&cus, hipDeviceAttributeMultiprocessorCount, dev) != hipSuccess) { grid = -1; return; }
        if (hipFuncSetAttribute((const void*)mega, hipFuncAttributeMaxDynamicSharedMemorySize, LDS_BYTES) != hipSuccess) { fprintf(stderr, "kernel_launch: hipFuncSetAttribute failed\n"); grid = -1; return; }
        if (hipOccupancyMaxActiveBlocksPerMultiprocessor(&per_cu, (const void*)mega, 512, LDS_BYTES) != hipSuccess || per_cu < 1) { fprintf(stderr, "kernel_launch: occupancy query says %d\n", per_cu); per_cu = 1; }
        (void)hipGetLastError();
        grid = cus;
    }
    if (grid < 0) return;
    unsigned char* ws = (unsigned char*)d_ws;
    (void)hipMemsetAsync(ws + WS_CTL, 0, CTL_BYTES, stream);
    Args a{};
    for (int i = 0; i < 26; ++i) a.in[i] = (const float*)d_in[i];
    a.pos = (const int*)d_in[1]; a.out = (float*)d_out; a.ws = ws; a.ph_lo = 0; a.ph_hi = NPHASE;
#if MK_MODE == 1
    hipLaunchKernelGGL(mega, dim3(grid), dim3(512), LDS_BYTES, stream, a);
#else
    float* H = (float*)d_out; u16* HB = (u16*)(ws + WS_HB);
    float* SSP0 = (float*)(ws + WS_SSP), *SSP1 = SSP0 + 65536, *SSP2 = SSP1 + 65536, *SSP3 = SSP2 + 65536;
    const unsigned* cnt = (const unsigned*)(ws + WS_CTL) + CW_CNT; const int* list = (const int*)(ws + WS_LIST); const float* gatew = (const float*)(ws + WS_GATEW);
    for (int p = 0; p < NPHASE; ++p) {
        if ((FASTMASK >> p) & 1) { a.ph_lo = p; a.ph_hi = p + 1; hipLaunchKernelGGL(mega, dim3(grid), dim3(512), LDS_BYTES, stream, a); continue; }
        switch (p) {
        case 0: k_tables<<<256, 256, 0, stream>>>(a); k_convert<<<2048, 256, 0, stream>>>(a); k_rowprep<<<1024, 256, 0, stream>>>(a.in[0], HB, SSP0); break;
        case 1: { NE_Proj e{HB, (const u16*)(ws + WS_WIN), SSP0, (u16*)(ws + WS_Y), (u16*)(ws + WS_XB)}; k_ngemm<<<dim3(2048 / 64, M / 64), 256, 0, stream>>>(e, 1024); } break;
        case 2: k_conv1d<<<(M * D) / 256, 256, 0, stream>>>((const u16*)(ws + WS_XB), a.in[6], a.in[7], (u16*)(ws + WS_XC));
                { NE_Gates e{(const u16*)(ws + WS_XC), (const u16*)(ws + WS_WAX), a.in[9], a.in[11], (const float*)(ws + WS_SPL), (float*)d_out, (float*)(ws + WS_BX)}; k_ngemm<<<dim3(128 / 64, M / 64, 8), 256, 0, stream>>>(e, 128); } break;
        case 3: k_scan_seq<<<16, 64, 0, stream>>>((const float*)d_out, (const float*)(ws + WS_BX), (const u16*)(ws + WS_Y), (u16*)(ws + WS_G)); break;
        case 4: { NE_Res e{(const u16*)(ws + WS_G), (const u16*)(ws + WS_WOUT), 1024, a.in[0], H, HB, nullptr}; k_ngemm<<<dim3(1024 / 64, M / 64), 256, 0, stream>>>(e, 1024); } k_ssp<<<1024, 256, 0, stream>>>(H, SSP1); break;
        case 5: { NE_GateUp e{HB, (const u16*)(ws + WS_WGU), SSP1, (u16*)(ws + WS_ACT)}; k_ngemm<<<dim3(DFF / 64, M / 64), 256, 0, stream>>>(e, 1024); } break;
        case 6: { NE_Res e{(const u16*)(ws + WS_ACT), (const u16*)(ws + WS_WD), DFF, nullptr, H, HB, nullptr}; k_ngemm<<<dim3(1024 / 64, M / 64), 256, 0, stream>>>(e, DFF); } k_ssp<<<1024, 256, 0, stream>>>(H, SSP2); break;
        case 7: { NE_QKV e{HB, (const u16*)(ws + WS_WQKV), SSP2, a.in[15], (const u16*)(ws + WS_ROPE), (u16*)(ws + WS_Q), (u16*)(ws + WS_K), (u16*)(ws + WS_V)}; k_ngemm<<<dim3(NQKV / 64, M / 64), 256, 0, stream>>>(e, 1024); } break;
        case 8: k_attn_ref<<<(M * NH) / 64, 64, 0, stream>>>((const u16*)(ws + WS_Q), (const u16*)(ws + WS_K), (const u16*)(ws + WS_V), a.in[16], (u16*)(ws + WS_ATT)); break;
        case 9: { NE_Res e{(const u16*)(ws + WS_ATT), (const u16*)(ws + WS_WO), 1024, nullptr, H, HB, a.in[18]}; k_ngemm<<<dim3(1024 / 64, M / 64), 256, 0, stream>>>(e, 1024); } k_ssp<<<1024, 256, 0, stream>>>(H, SSP3); break;
        case 10: k_router<<<256, 512, 0, stream>>>(a); break;
        case 11: { NE_MoeUp e{HB, (const u16*)(ws + WS_WGU2), SSP3, cnt, list, gatew, (u16*)(ws + WS_ACT2)}; k_ngemm<<<dim3(DFF / 64, MAXSLOT / 64), 256, 0, stream>>>(e, 1024); } break;
        case 12: { NE_MoeDown e{(const u16*)(ws + WS_ACT2), (const u16*)(ws + WS_WD2), cnt, list, (u16*)(ws + WS_MO)}; k_ngemm<<<dim3(1024 / 64, MAXSLOT / 64), 256, 0, stream>>>(e, DFF); } break;
        case 13: k_final<<<1024, 256, 0, stream>>>(H, HB, (const u16*)(ws + WS_MO), a.in[4]); break;
        }
    }
#endif
}
```

```cpp
#include <hip/hip_runtime.h>
#include <stdint.h>
#include <stdio.h>

typedef unsigned short u16;
typedef short bf16x8 __attribute__((ext_vector_type(8)));
typedef float f32x4 __attribute__((ext_vector_type(4)));
typedef unsigned u32x4 __attribute__((ext_vector_type(4)));
typedef unsigned u32x2 __attribute__((ext_vector_type(2)));

constexpr int M = 16384, D = 1024, DFF = 3584, NE = 8, NBLK = 8, RB = 128;
constexpr int NH = 16, NKV = 4, HD = 64, KVD = 256, NQKV = 1536, WIN = 128;
constexpr int MAXSLOT = 34816;
constexpr float EPS = 1e-6f;
#ifndef MOE_FP8
#define MOE_FP8 1
#endif
constexpr float S8_A = 16.0f, S8_W = 256.0f, S8_ACT = 8.0f, S8_WD = 512.0f;
#ifndef ATTN_FP8
#define ATTN_FP8 1
#endif
constexpr float S8_O = 32.0f;
constexpr float LOG2E = 1.4426950408889634f;

constexpr size_t MiB = 1u << 20;
constexpr size_t WS_CTL = 0, CTL_BYTES = 1 * MiB;
constexpr size_t WS_ROPE = 1 * MiB;
constexpr size_t WS_SSP = 2 * MiB;
constexpr size_t WS_SPL = 3 * MiB;
constexpr size_t WS_WR = 3 * MiB + 64 * 1024;
constexpr size_t WS_CAR = 3 * MiB + 128 * 1024;
constexpr size_t WS_LIST = 4 * MiB;
constexpr size_t WS_GATEW = WS_LIST;
constexpr size_t WS_WGU2 = 6 * MiB;
constexpr size_t WS_HB8 = 70 * MiB;
constexpr size_t WS_WD2 = 118 * MiB;
constexpr size_t WS_HB = 174 * MiB;
constexpr size_t WS_X = 206 * MiB;
constexpr size_t WS_WIN = WS_X;
constexpr size_t WS_WAX = WS_X + 4 * MiB;
constexpr size_t WS_WOUT = WS_X + 5 * MiB;
constexpr size_t WS_WGU = WS_X + 7 * MiB;
constexpr size_t WS_WD = WS_X + 21 * MiB;
constexpr size_t WS_WQKV = WS_X + 28 * MiB;
constexpr size_t WS_WO = WS_X + 31 * MiB;
constexpr size_t WS_Y = WS_X + 33 * MiB;
constexpr size_t WS_XB = WS_Y + 32 * MiB;
constexpr size_t WS_G = WS_XB + 32 * MiB;
constexpr size_t WS_ACT = WS_G + 32 * MiB;
constexpr size_t WS_XC = WS_ACT;
constexpr size_t WS_BX = WS_ACT + 32 * MiB;
constexpr size_t WS_Q = WS_Y;
constexpr size_t WS_K = WS_Y + 32 * MiB;
constexpr size_t WS_V = WS_K + 8 * MiB;
constexpr size_t WS_ATT = WS_V + 8 * MiB;
constexpr size_t WS_ACT2 = WS_X;
constexpr size_t WS_MO = WS_WGU2;
constexpr size_t WS_END = 447 * MiB;
static_assert(WS_ACT + (size_t)M * DFF * 2 <= WS_END && WS_ACT2 + (size_t)MAXSLOT * DFF * 2 <= WS_END, "ws map");
constexpr int CW_CNT = 64;

__device__ __forceinline__ unsigned f2bf(float f) { unsigned u = __builtin_bit_cast(unsigned, f); return (u + 0x7fffu + ((u >> 16) & 1u)) >> 16; }
__device__ __forceinline__ float bf2f(unsigned b) { return __builtin_bit_cast(float, b << 16); }
__device__ __forceinline__ float u2f(unsigned b) { return __builtin_bit_cast(float, b); }
__device__ __forceinline__ unsigned pk2(float lo, float hi) { return f2bf(lo) | (f2bf(hi) << 16); }
__device__ __forceinline__ float wave_sum(float v) {
#pragma unroll
    for (int o = 1; o < 64; o <<= 1) v += __shfl_xor(v, o);
    return v;
}
__device__ __forceinline__ float sigmoidf_(float x) { return 1.0f / (1.0f + __expf(-x)); }
__device__ __forceinline__ float gelu_tanh(float x) { const float z = 0.7978845608028654f * (x + 0.044715f * x * x * x); return x / (1.0f + __expf(-2.0f * z)); }
__device__ __forceinline__ float silu_(float x) { return x / (1.0f + __expf(-x)); }
__device__ __forceinline__ float one_minus_exp(float x) {
    if (x > -0.3f) { float p = 1.0f / 720.0f; p = p * x + 1.0f / 120.0f; p = p * x + 1.0f / 24.0f; p = p * x + 1.0f / 6.0f; p = p * x + 0.5f; p = p * x + 1.0f; return -x * p; }
    return 1.0f - __expf(x);
}
__device__ __forceinline__ float rstd_of(const float* ssp, int row) { const f32x4 p = *(const f32x4*)(ssp + 4 * (size_t)row); return rsqrtf(((p[0] + p[1]) + (p[2] + p[3])) * (1.0f / D) + EPS); }

struct Args {
    const float* in[26]; const int* pos; float* out; unsigned char* ws; int ph_lo, ph_hi;
};

__device__ __forceinline__ void tables_body(const Args& a, int gt, int NT) {
    u16* rope = (u16*)(a.ws + WS_ROPE);
    for (int i = gt; i < M * 8; i += NT) { const int t = i >> 3, f = i & 7;
        const double inv = f == 0 ? 1.0 : f == 1 ? 0.19392274474868576 : f == 2 ? 0.03760603093086393 : f == 3 ? 0.007292664737217109 : f == 4 ? 0.001414213562373095 : f == 5 ? 0.0002742481756762073 : f == 6 ? 5.318295896944988e-05 : 1.031338537721246e-05;
        const double ang = (double)a.pos[t] * inv; const double kq = __builtin_rint(ang * 0.6366197723675814); const double r = ang - kq * 1.5707963267948966, r2 = r * r;
        double s = -1.0 / 39916800.0; s = s * r2 + 1.0 / 362880.0; s = s * r2 - 1.0 / 5040.0; s = s * r2 + 1.0 / 120.0; s = s * r2 - 1.0 / 6.0; s = s * r2 + 1.0; s *= r;
        double c = 1.0 / 479001600.0; c = c * r2 - 1.0 / 3628800.0; c = c * r2 + 1.0 / 40320.0; c = c * r2 - 1.0 / 720.0; c = c * r2 + 1.0 / 24.0; c = c * r2 - 0.5; c = c * r2 + 1.0;
        const int q = (int)((long long)kq & 3); const double cs = q == 0 ? c : q == 1 ? -s : q == 2 ? -c : s, sn = q == 0 ? s : q == 1 ? c : q == 2 ? -s : -c;
        rope[t * 16 + f] = (u16)f2bf((float)cs); rope[t * 16 + 8 + f] = (u16)f2bf((float)sn); }
    float* spl = (float*)(a.ws + WS_SPL);
    for (int i = gt; i < 1024; i += NT) { const float z = __expf(-a.in[12][i]);
        float p = 0.2f; p = p * z - 0.25f; p = p * z + 1.0f / 3.0f; p = p * z - 0.5f; p = p * z + 1.0f; spl[i] = z < 0.05f ? z * p : __logf(1.0f + z); }
    float* wr = (float*)(a.ws + WS_WR);
    for (int i = gt; i < 8 * 1024; i += NT) { const int e = i >> 10, k = i & 1023; wr[i] = a.in[3][1024 + k] * a.in[22][k * 8 + e]; }
}
__global__ void k_tables(Args a) { tables_body(a, blockIdx.x * blockDim.x + threadIdx.x, gridDim.x * blockDim.x); }

struct ConvJob { const float* W; const float* g; u16* WT; int K, N, mode, row_off; float s8; };
__device__ __forceinline__ bool conv_job(const Args& a, int j, ConvJob& c) {
    unsigned char* ws = a.ws;
    c.g = nullptr; c.mode = 0; c.row_off = 0; c.s8 = 0.f;
    if (j == 0) { c.W = a.in[5]; c.g = a.in[2]; c.WT = (u16*)(ws + WS_WIN); c.K = 1024; c.N = 2048; return true; }
    if (j == 1) { c.W = a.in[13]; c.WT = (u16*)(ws + WS_WOUT); c.K = 1024; c.N = 1024; return true; }
    if (j == 2) { c.W = a.in[19]; c.g = a.in[3]; c.WT = (u16*)(ws + WS_WGU); c.K = 1024; c.N = DFF; c.mode = 1; return true; }
    if (j == 3) { c.W = a.in[20]; c.g = a.in[3]; c.WT = (u16*)(ws + WS_WGU); c.K = 1024; c.N = DFF; c.mode = 2; return true; }
    if (j == 4) { c.W = a.in[21]; c.WT = (u16*)(ws + WS_WD); c.K = DFF; c.N = 1024; return true; }
    if (j == 5) { c.W = a.in[14]; c.g = a.in[2] + 1024; c.WT = (u16*)(ws + WS_WQKV); c.K = 1024; c.N = NQKV; c.s8 = ATTN_FP8 ? S8_W : 0.f; return true; }
    if (j == 6) { c.W = a.in[17]; c.WT = (u16*)(ws + WS_WO); c.K = 1024; c.N = 1024; c.s8 = ATTN_FP8 ? S8_W : 0.f; return true; }
    j -= 7;
    if (j < 16) { const int n = j >> 1, x = j & 1; c.W = a.in[x ? 10 : 8] + (size_t)n * 128 * 128; c.WT = (u16*)(ws + WS_WAX) + (size_t)n * 256 * 128; c.K = 128; c.N = 128; c.row_off = x * 128; return true; }
    j -= 16;
    if (j < 16) { const int e = j >> 1, x = j & 1; c.W = a.in[x ? 24 : 23] + (size_t)e * 1024 * DFF; c.g = a.in[3] + 1024; c.WT = (u16*)(ws + WS_WGU2 + (size_t)e * 7168 * 1024 * (MOE_FP8 ? 1 : 2)); c.K = 1024; c.N = DFF; c.mode = 1 + x; c.s8 = MOE_FP8 ? S8_W : 0.f; return true; }
    j -= 16;
    if (j < 8) { c.W = a.in[25] + (size_t)j * DFF * 1024; c.WT = (u16*)(ws + WS_WD2 + (size_t)j * 1024 * DFF * (MOE_FP8 ? 1 : 2)); c.K = DFF; c.N = 1024; c.s8 = MOE_FP8 ? S8_WD : 0.f; return true; }
    return false;
}
constexpr int NJOBS = 7 + 16 + 16 + 8;
__device__ __forceinline__ void conv_item(const ConvJob& c, float*, int item, int lane) {
    const int nblk = c.N / 64, kb = item / nblk, nb = item % nblk, r4 = lane >> 4, cc = lane & 15, k0 = 64 * kb + 16 * r4, n0 = 64 * nb + 4 * cc;
    f32x4 v[16];
    const float* src = c.W + (size_t)k0 * c.N + n0;
#pragma unroll
    for (int i = 0; i < 16; ++i) v[i] = *(const f32x4*)(src + (size_t)i * c.N);
    if (c.g) { const f32x4 g0 = *(const f32x4*)(c.g + k0), g1 = *(const f32x4*)(c.g + k0 + 4), g2 = *(const f32x4*)(c.g + k0 + 8), g3 = *(const f32x4*)(c.g + k0 + 12);
#pragma unroll
        for (int i = 0; i < 4; ++i) { v[i] = v[i] * g0[i]; v[4 + i] = v[4 + i] * g1[i]; v[8 + i] = v[8 + i] * g2[i]; v[12 + i] = v[12 + i] * g3[i]; } }
    if (c.s8 != 0.f) {
#pragma unroll
        for (int j = 0; j < 4; ++j) { const int nn = n0 + j; const int r = c.mode == 0 ? c.row_off + nn : 256 * (nn >> 7) + (nn & 127) + (c.mode == 2 ? 128 : 0);
            u32x4 o;
#pragma unroll
            for (int q = 0; q < 4; ++q) { int w = 0; w = __builtin_amdgcn_cvt_pk_fp8_f32(v[4 * q][j] * c.s8, v[4 * q + 1][j] * c.s8, w, false); w = __builtin_amdgcn_cvt_pk_fp8_f32(v[4 * q + 2][j] * c.s8, v[4 * q + 3][j] * c.s8, w, true); o[q] = (unsigned)w; }
            *(u32x4*)((unsigned char*)c.WT + (size_t)r * c.K + k0) = o; }
        return; }
#pragma unroll
    for (int j = 0; j < 4; ++j) { const int nn = n0 + j; const int r = c.mode == 0 ? c.row_off + nn : 256 * (nn >> 7) + (nn & 127) + (c.mode == 2 ? 128 : 0);
        u32x4 o0, o1; o0.x = pk2(v[0][j], v[1][j]); o0.y = pk2(v[2][j], v[3][j]); o0.z = pk2(v[4][j], v[5][j]); o0.w = pk2(v[6][j], v[7][j]);
        o1.x = pk2(v[8][j], v[9][j]); o1.y = pk2(v[10][j], v[11][j]); o1.z = pk2(v[12][j], v[13][j]); o1.w = pk2(v[14][j], v[15][j]);
        u32x4* dst = (u32x4*)(c.WT + (size_t)r * c.K + k0); dst[0] = o0; dst[1] = o1; }
}
__device__ __forceinline__ void convert_body(const Args& a, float* scr, int gw, int NGW, int lane) {
    int base = 0;
    for (int j = 0; j < NJOBS; ++j) { ConvJob c; if (!conv_job(a, j, c)) break; const int items = (c.K / 64) * (c.N / 64);
        int first = (gw - base) % NGW; if (first < 0) first += NGW;
        for (int it = first; it < items; it += NGW) conv_item(c, scr, it, lane);
        base = (base + items) % NGW; }
}
__global__ __launch_bounds__(256) void k_convert(Args a) {
    __shared__ float scr_all[4][64 * 33];
    const int lane = threadIdx.x & 63, w = threadIdx.x >> 6;
    convert_body(a, scr_all[w], blockIdx.x * 4 + w, gridDim.x * 4, lane);
}

__device__ __forceinline__ void rowprep_body(const float* x, u16* hb, float* ssp, int gw, int NGW, int lane) {
    for (int r = gw; r < M; r += NGW) {
        const f32x4* xr = (const f32x4*)(x + (size_t)r * D) + lane * 4; float s = 0.f; u32x4 o0, o1;
        f32x4 v0 = xr[0], v1 = xr[1], v2 = xr[2], v3 = xr[3];
        s = (v0[0] * v0[0] + v0[1] * v0[1]) + (v0[2] * v0[2] + v0[3] * v0[3]) + (v1[0] * v1[0] + v1[1] * v1[1]) + (v1[2] * v1[2] + v1[3] * v1[3])
          + (v2[0] * v2[0] + v2[1] * v2[1]) + (v2[2] * v2[2] + v2[3] * v2[3]) + (v3[0] * v3[0] + v3[1] * v3[1]) + (v3[2] * v3[2] + v3[3] * v3[3]);
        o0.x = pk2(v0[0], v0[1]); o0.y = pk2(v0[2], v0[3]); o0.z = pk2(v1[0], v1[1]); o0.w = pk2(v1[2], v1[3]);
        o1.x = pk2(v2[0], v2[1]); o1.y = pk2(v2[2], v2[3]); o1.z = pk2(v3[0], v3[1]); o1.w = pk2(v3[2], v3[3]);
        u32x4* orow = (u32x4*)(hb + (size_t)r * D) + lane * 2; orow[0] = o0; orow[1] = o1;
        s += __shfl_xor(s, 1); s += __shfl_xor(s, 2); s += __shfl_xor(s, 4); s += __shfl_xor(s, 8);
        if ((lane & 15) == 0) ssp[4 * (size_t)r + (lane >> 4)] = s;
    }
}
__global__ __launch_bounds__(256) void k_rowprep(const float* x, u16* hb, float* ssp) { rowprep_body(x, hb, ssp, blockIdx.x * 4 + (threadIdx.x >> 6), gridDim.x * 4, threadIdx.x & 63); }
__global__ __launch_bounds__(256) void k_ssp(const float* h, float* ssp) {
    const int lane = threadIdx.x & 63, gw = blockIdx.x * 4 + (threadIdx.x >> 6), NGW = gridDim.x * 4;
    for (int r = gw; r < M; r += NGW) {
        const f32x4* xr = (const f32x4*)(h + (size_t)r * D) + lane * 4; float s = 0.f;
#pragma unroll
        for (int j = 0; j < 4; ++j) { const f32x4 v = xr[j]; s += (v[0] * v[0] + v[1] * v[1]) + (v[2] * v[2] + v[3] * v[3]); }
        s += __shfl_xor(s, 1); s += __shfl_xor(s, 2); s += __shfl_xor(s, 4); s += __shfl_xor(s, 8);
        if ((lane & 15) == 0) ssp[4 * (size_t)r + (lane >> 4)] = s;
    }
}

__device__ __forceinline__ void slot_info(const unsigned* cnt, int slot, int& e, int& pos, int& n) {
    int base = 0; e = -1; pos = 0; n = 0;
#pragma unroll
    for (int i = 0; i < NE; ++i) { const int c = (int)cnt[i], rows = ((c + 255) >> 8) << 8; if (e < 0 && slot < base + rows) { e = i; pos = slot - base; n = c; } base += rows; }
}

template <class E> __global__ __launch_bounds__(256) void k_ngemm(E e, int K) {
    const int lane = threadIdx.x & 63, w = threadIdx.x >> 6, fr = lane & 15, fq = lane >> 4;
    const int rb = blockIdx.y * 64, r0 = rb + (w >> 1) * 32, c0 = blockIdx.x * 64 + (w & 1) * 32;
    if (!e.tile_ok(rb)) return;
    constexpr int NP = E::PAIR ? 2 : 1;
    const u16* ap[2]; const u16* bp[2][NP];
#pragma unroll
    for (int i = 0; i < 2; ++i) ap[i] = e.a_row(r0 + 16 * i + fr) + 8 * fq;
#pragma unroll
    for (int j = 0; j < 2; ++j)
#pragma unroll
        for (int p = 0; p < NP; ++p) bp[j][p] = e.b_row(c0 + 16 * j + fr, p, rb) + 8 * fq;
    f32x4 acc[2][2][NP];
#pragma unroll
    for (int i = 0; i < 2; ++i)
#pragma unroll
        for (int j = 0; j < 2; ++j)
#pragma unroll
            for (int p = 0; p < NP; ++p) acc[i][j][p] = (f32x4){0.f, 0.f, 0.f, 0.f};
    for (int k = 0; k < K; k += 32) {
        bf16x8 av[2], bv[2][NP];
#pragma unroll
        for (int i = 0; i < 2; ++i) av[i] = *(const bf16x8*)(ap[i] + k);
#pragma unroll
        for (int j = 0; j < 2; ++j)
#pragma unroll
            for (int p = 0; p < NP; ++p) bv[j][p] = *(const bf16x8*)(bp[j][p] + k);
#pragma unroll
        for (int i = 0; i < 2; ++i)
#pragma unroll
            for (int j = 0; j < 2; ++j)
#pragma unroll
                for (int p = 0; p < NP; ++p) acc[i][j][p] = __builtin_amdgcn_mfma_f32_16x16x32_bf16(av[i], bv[j][p], acc[i][j][p], 0, 0, 0);
    }
#pragma unroll
    for (int i = 0; i < 2; ++i)
#pragma unroll
        for (int j = 0; j < 2; ++j)
#pragma unroll
            for (int q = 0; q < 4; ++q) { const float v0 = acc[i][j][0][q], v1 = E::PAIR ? acc[i][j][NP - 1][q] : 0.f; const float pv = __shfl_xor(v0, 8);
                e.store(r0 + 16 * i + 4 * fq + q, c0 + 16 * j + fr, v0, v1, pv); }
}

struct NE_Proj {
    static constexpr bool PAIR = false;
    const u16* A; const u16* Bt; const float* ssp; u16* Y; u16* XB;
    __device__ bool tile_ok(int) const { return true; }
    __device__ const u16* a_row(int r) const { return A + (size_t)r * D; }
    __device__ const u16* b_row(int c, int, int) const { return Bt + (size_t)c * D; }
    __device__ void store(int r, int c, float v, float, float) const { v *= rstd_of(ssp, r); if (c < 1024) Y[(size_t)r * D + c] = (u16)f2bf(gelu_tanh(v)); else XB[(size_t)r * D + c - 1024] = (u16)f2bf(v); }
};
struct NE_Gates {
    static constexpr bool PAIR = true;
    const u16* XC; const u16* WAX; const float* b_a; const float* b_x; const float* spl; float* LA; float* BX;
    __device__ bool tile_ok(int) const { return true; }
    __device__ const u16* a_row(int r) const { return XC + (size_t)r * D + 128 * blockIdx.z; }
    __device__ const u16* b_row(int c, int p, int) const { return WAX + ((size_t)blockIdx.z * 256 + c + 128 * p) * 128; }
    __device__ void store(int r, int c, float vr, float vi, float) const { const int ch = 128 * blockIdx.z + c;
        const float rg = sigmoidf_(vr + b_a[ch]), ig = sigmoidf_(vi + b_x[ch]), la = -8.0f * rg * spl[ch], xc = bf2f(XC[(size_t)r * D + ch]);
        LA[(size_t)r * D + ch] = la; BX[(size_t)r * D + ch] = sqrtf(one_minus_exp(2.0f * la)) * (ig * xc); }
};
struct NE_Res {
    static constexpr bool PAIR = false;
    const u16* A; const u16* Bt; int K; const float* Hin; float* Hout; u16* HB; const float* bias;
    __device__ bool tile_ok(int) const { return true; }
    __device__ const u16* a_row(int r) const { return A + (size_t)r * K; }
    __device__ const u16* b_row(int c, int, int) const { return Bt + (size_t)c * K; }
    __device__ void store(int r, int c, float v, float, float) const { const float h = (Hin ? Hin[(size_t)r * D + c] : bf2f(HB[(size_t)r * D + c])) + v + (bias ? bias[c] : 0.f); Hout[(size_t)r * D + c] = h; HB[(size_t)r * D + c] = (u16)f2bf(h); }
};
struct NE_GateUp {
    static constexpr bool PAIR = true;
    const u16* A; const u16* Bt; const float* ssp; u16* ACT;
    __device__ bool tile_ok(int) const { return true; }
    __device__ const u16* a_row(int r) const { return A + (size_t)r * D; }
    __device__ const u16* b_row(int c, int p, int) const { return Bt + (size_t)(256 * (c >> 7) + (c & 127) + 128 * p) * D; }
    __device__ void store(int r, int c, float g, float u, float) const { const float rs = rstd_of(ssp, r); ACT[(size_t)r * DFF + c] = (u16)f2bf(silu_(rs * g) * (rs * u)); }
};
struct NE_QKV {
    static constexpr bool PAIR = false;
    const u16* A; const u16* Bt; const float* ssp; const float* bias; const u16* rope; u16* Q; u16* Kb; u16* Vb;
    __device__ bool tile_ok(int) const { return true; }
    __device__ const u16* a_row(int r) const { return A + (size_t)r * D; }
    __device__ const u16* b_row(int c, int, int) const { return Bt + (size_t)c * D; }
    __device__ void store(int r, int c, float v, float, float pv) const {
        const float rs = rstd_of(ssp, r); v = rs * v + bias[c]; pv = rs * pv + bias[c ^ 8];
        const int d = c & 63;
        if (c < 1280 && d < 16) { const float cs = bf2f(rope[(size_t)r * 16 + (d & 7)]), sn = bf2f(rope[(size_t)r * 16 + 8 + (d & 7)]); v = d < 8 ? v * cs - pv * sn : v * cs + pv * sn; }
        if (c < 1024) Q[(size_t)r * D + c] = (u16)f2bf(v * (0.125f * LOG2E));
        else if (c < 1280) Kb[(size_t)r * KVD + c - 1024] = (u16)f2bf(v);
        else Vb[(size_t)r * KVD + c - 1280] = (u16)f2bf(v);
    }
};
struct NE_MoeUp {
    static constexpr bool PAIR = true;
    const u16* HB; const u16* WGU2; const float* ssp; const unsigned* cnt; const int* list; const float* gatew; u16* ACT2;
    __device__ bool tile_ok(int rb) const { int e, pos, n; slot_info(cnt, rb, e, pos, n); return e >= 0; }
    __device__ const u16* a_row(int r) const { int e, pos, n; slot_info(cnt, r, e, pos, n); const int tok = (e >= 0 && pos < n) ? (list[((size_t)e * M + pos) * 4] >> 1) : 0; return HB + (size_t)tok * D; }
    __device__ const u16* b_row(int c, int p, int rb) const { int e, pos, n; slot_info(cnt, rb, e, pos, n); return WGU2 + ((size_t)e * 7168 + 256 * (c >> 7) + (c & 127) + 128 * p) * D; }
    __device__ void store(int r, int c, float g, float u, float) const { int e, pos, n; slot_info(cnt, r, e, pos, n); float o = 0.f;
        if (e >= 0 && pos < n) { const int tok = list[((size_t)e * M + pos) * 4] >> 1; const float rs = rstd_of(ssp, tok); o = silu_(rs * g) * (rs * u) * gatew[((size_t)e * M + pos) * 4 + 1]; }
        ACT2[(size_t)r * DFF + c] = (u16)f2bf(o); }
};
struct NE_MoeDown {
    static constexpr bool PAIR = false;
    const u16* ACT2; const u16* WD2; const unsigned* cnt; const int* list; u16* MO;
    __device__ bool tile_ok(int rb) const { int e, pos, n; slot_info(cnt, rb, e, pos, n); return e >= 0; }
    __device__ const u16* a_row(int r) const { return ACT2 + (size_t)r * DFF; }
    __device__ const u16* b_row(int c, int, int rb) const { int e, pos, n; slot_info(cnt, rb, e, pos, n); return WD2 + ((size_t)e * 1024 + c) * DFF; }
    __device__ void store(int r, int c, float v, float, float) const { int e, pos, n; slot_info(cnt, r, e, pos, n);
        if (e >= 0 && pos < n) { const int tk = list[((size_t)e * M + pos) * 4]; MO[((size_t)(tk & 1) * M + (tk >> 1)) * D + c] = (u16)f2bf(v); } }
};

__global__ void k_conv1d(const u16* XB, const float* cw, const float* cb, u16* XC) {
    const size_t i = (size_t)blockIdx.x * blockDim.x + threadIdx.x; if (i >= (size_t)M * D) return;
    const int t = (int)(i >> 10), c = (int)(i & 1023); float s = cb[c];
#pragma unroll
    for (int k = 0; k < 4; ++k) { const int tt = t - 3 + k; if (tt >= 0) s += bf2f(XB[(size_t)tt * D + c]) * cw[k * D + c]; }
    XC[i] = (u16)f2bf(s);
}
__global__ __launch_bounds__(64) void k_scan_seq(const float* LA, const float* BX, const u16* Y, u16* G) {
    const int c = blockIdx.x * 64 + threadIdx.x; float h = 0.f;
    for (int t0 = 0; t0 < M; t0 += 8) {
        float la[8], bx[8], y[8];
#pragma unroll
        for (int j = 0; j < 8; ++j) { la[j] = LA[(size_t)(t0 + j) * D + c]; bx[j] = BX[(size_t)(t0 + j) * D + c]; y[j] = bf2f(Y[(size_t)(t0 + j) * D + c]); }
#pragma unroll
        for (int j = 0; j < 8; ++j) { h = __expf(la[j]) * h + bx[j]; G[(size_t)(t0 + j) * D + c] = (u16)f2bf(h * y[j]); }
    }
}

__global__ __launch_bounds__(64) void k_attn_ref(const u16* Q, const u16* Kb, const u16* Vb, const float* sinks, u16* ATT) {
    const int i = blockIdx.x * 64 + threadIdx.x; const int h = i / M, t = i % M, kvh = h >> 2;
    float q[64], o[64];
#pragma unroll
    for (int d = 0; d < 64; d += 2) { const unsigned w = *(const unsigned*)(Q + (size_t)t * D + 64 * h + d); q[d] = bf2f(w & 0xffffu); q[d + 1] = bf2f(w >> 16); o[d] = 0.f; o[d + 1] = 0.f; }
    float m = sinks[h] * LOG2E, l = 1.0f;
    const int j0 = t - (WIN - 1) > 0 ? t - (WIN - 1) : 0;
    for (int j = j0; j <= t; ++j) {
        const u16* kr = Kb + (size_t)j * KVD + 64 * kvh; const u16* vr = Vb + (size_t)j * KVD + 64 * kvh; float s = 0.f;
#pragma unroll
        for (int d = 0; d < 64; d += 2) { const unsigned w = *(const unsigned*)(kr + d); s += q[d] * bf2f(w & 0xffffu) + q[d + 1] * bf2f(w >> 16); }
        const float mn = fmaxf(m, s), al = exp2f(m - mn), p = exp2f(s - mn); l = l * al + p; m = mn;
#pragma unroll
        for (int d = 0; d < 64; d += 2) { const unsigned w = *(const unsigned*)(vr + d); o[d] = o[d] * al + p * bf2f(w & 0xffffu); o[d + 1] = o[d + 1] * al + p * bf2f(w >> 16); }
    }
    const float il = 1.0f / l;
#pragma unroll
    for (int d = 0; d < 64; d += 2) *(unsigned*)(ATT + (size_t)t * D + 64 * h + d) = pk2(o[d] * il, o[d + 1] * il);
}

__device__ __forceinline__ void router_group(const u16* HB, const float* WR, const float* ssp, unsigned* cnt, int* list, float* gatew, int grp, float* lds  ) {
    const int lane = threadIdx.x & 63, w = threadIdx.x >> 6;
    for (int tt = 0; tt < 8; ++tt) {
        const int tl = 8 * w + tt, t = 64 * grp + tl;
        const u32x4* hr = (const u32x4*)(HB + (size_t)t * D + 16 * lane); const u32x4 h0 = hr[0], h1 = hr[1];
        float x[16];
        x[0] = bf2f(h0.x & 0xffffu); x[1] = bf2f(h0.x >> 16); x[2] = bf2f(h0.y & 0xffffu); x[3] = bf2f(h0.y >> 16); x[4] = bf2f(h0.z & 0xffffu); x[5] = bf2f(h0.z >> 16); x[6] = bf2f(h0.w & 0xffffu); x[7] = bf2f(h0.w >> 16);
        x[8] = bf2f(h1.x & 0xffffu); x[9] = bf2f(h1.x >> 16); x[10] = bf2f(h1.y & 0xffffu); x[11] = bf2f(h1.y >> 16); x[12] = bf2f(h1.z & 0xffffu); x[13] = bf2f(h1.z >> 16); x[14] = bf2f(h1.w & 0xffffu); x[15] = bf2f(h1.w >> 16);
        float lg[8];
#pragma unroll
        for (int e = 0; e < 8; ++e) { const float* wr = WR + e * 1024 + 16 * lane; float s = 0.f;
#pragma unroll
            for (int k = 0; k < 16; ++k) s += x[k] * wr[k];
            lg[e] = wave_sum(s); }
        if (lane == 0) {
            const float rs = rstd_of(ssp, t);
            int e1 = 0; float v1 = lg[0];
#pragma unroll
            for (int e = 1; e < 8; ++e) if (lg[e] > v1) { v1 = lg[e]; e1 = e; }
            int e2 = -1; float v2 = -3.0e38f;
#pragma unroll
            for (int e = 0; e < 8; ++e) if (e != e1 && lg[e] > v2) { v2 = lg[e]; e2 = e; }
            const float g1 = 1.0f / (1.0f + __expf((v2 - v1) * rs));
            lds[tl * 4 + 0] = __builtin_bit_cast(float, e1); lds[tl * 4 + 1] = __builtin_bit_cast(float, e2); lds[tl * 4 + 2] = g1; lds[tl * 4 + 3] = 1.0f - g1;
        }
    }
    __syncthreads();
    if (w == 0) {
        const int e1 = __builtin_bit_cast(int, lds[lane * 4 + 0]), e2 = __builtin_bit_cast(int, lds[lane * 4 + 1]); const float g1 = lds[lane * 4 + 2], g2 = lds[lane * 4 + 3];
        const int t = 64 * grp + lane; const unsigned long long lt = (1ull << lane) - 1ull; const float rsl = rstd_of(ssp, t);
        for (int e = 0; e < 8; ++e) {
            const unsigned long long m1 = __ballot(e1 == e), m2 = __ballot(e2 == e); const int n1 = __popcll(m1), n2 = __popcll(m2);
            unsigned base = 0; if (lane == 0 && n1 + n2 > 0) base = atomicAdd(cnt + e, (unsigned)(n1 + n2));
            base = __shfl(base, 0);
            if (e1 == e) { const unsigned p = base + __popcll(m1 & lt); u32x4 r; r.x = (unsigned)(2 * t); r.y = __builtin_bit_cast(unsigned, g1); r.z = __builtin_bit_cast(unsigned, rsl); r.w = 0u; *(u32x4*)(list + ((size_t)e * M + p) * 4) = r; }
            if (e2 == e) { const unsigned p = base + n1 + __popcll(m2 & lt); u32x4 r; r.x = (unsigned)(2 * t + 1); r.y = __builtin_bit_cast(unsigned, g2); r.z = __builtin_bit_cast(unsigned, rsl); r.w = 0u; *(u32x4*)(list + ((size_t)e * M + p) * 4) = r; }
        }
    }
    __syncthreads();
}
__global__ __launch_bounds__(512) void k_router(Args a) {
    __shared__ float lds[64 * 4];
    unsigned* cnt = (unsigned*)(a.ws + WS_CTL) + CW_CNT;
    for (int g = blockIdx.x; g < M / 64; g += gridDim.x)
        router_group((const u16*)(a.ws + WS_HB), (const float*)(a.ws + WS_WR), (const float*)(a.ws + WS_SSP + 3 * 256 * 1024), cnt, (int*)(a.ws + WS_LIST), (float*)(a.ws + WS_GATEW), g, lds);
}

__device__ __forceinline__ void final_body(float* H, const u16* HBr, const u16* MO, const float* g, int gw, int NGW, int lane) {
    for (int r = gw; r < M; r += NGW) {
        f32x4 v[4]; float s = 0.f;
#pragma unroll
        for (int j = 0; j < 4; ++j) { const int c = 256 * j + 4 * lane; { const u32x2 hb = *(const u32x2*)(HBr + (size_t)r * D + c); v[j] = (f32x4){bf2f(hb.x & 0xffffu), bf2f(hb.x >> 16), bf2f(hb.y & 0xffffu), bf2f(hb.y >> 16)}; }
            const u32x2 a0 = *(const u32x2*)(MO + (size_t)r * D + c), a1 = *(const u32x2*)(MO + ((size_t)M + r) * D + c);
            v[j][0] += bf2f(a0.x & 0xffffu) + bf2f(a1.x & 0xffffu); v[j][1] += bf2f(a0.x >> 16) + bf2f(a1.x >> 16); v[j][2] += bf2f(a0.y & 0xffffu) + bf2f(a1.y & 0xffffu); v[j][3] += bf2f(a0.y >> 16) + bf2f(a1.y >> 16);
            s += (v[j][0] * v[j][0] + v[j][1] * v[j][1]) + (v[j][2] * v[j][2] + v[j][3] * v[j][3]); }
        const float rs = rsqrtf(wave_sum(s) * (1.0f / D) + EPS);
#pragma unroll
        for (int j = 0; j < 4; ++j) { const int c = 256 * j + 4 * lane; const f32x4 gg = *(const f32x4*)(g + c); *(f32x4*)(H + (size_t)r * D + c) = v[j] * rs * gg; }
    }
}
__global__ __launch_bounds__(256) void k_final(float* H, const u16* HBr, const u16* MO, const float* g) { final_body(H, HBr, MO, g, blockIdx.x * 4 + (threadIdx.x >> 6), gridDim.x * 4, threadIdx.x & 63); }

#define LAS __attribute__((address_space(3)))
typedef float f32x16 __attribute__((ext_vector_type(16)));
typedef short s16x4 __attribute__((ext_vector_type(4)));
typedef float f32x2v_t __attribute__((ext_vector_type(2)));
__device__ __forceinline__ unsigned cvt_pk_bf16(float lo, float hi) { unsigned r; asm volatile("v_cvt_pk_bf16_f32 %0, %1, %2" : "=v"(r) : "v"(lo), "v"(hi)); return r; }
__device__ __forceinline__ float fexp2(float x) { return __builtin_amdgcn_exp2f(x); }
__device__ __forceinline__ float frcp(float x) { return __builtin_amdgcn_rcpf(x); }
__device__ __forceinline__ float fsigmoid(float x) { return frcp(1.0f + fexp2(-LOG2E * x)); }
__device__ __forceinline__ float fsilu(float x) { return x * frcp(1.0f + fexp2(-LOG2E * x)); }
__device__ __forceinline__ float fgelu_tanh(float x) { const float z = 0.7978845608028654f * (x + 0.044715f * x * x * x); return x * frcp(1.0f + fexp2(-2.0f * LOG2E * z)); }

__device__ __forceinline__ u32x2 pk8_fp8(const float (&o)[8], float sc) {
    float t[8];
#pragma unroll
    for (int i = 0; i < 8; ++i) t[i] = __builtin_fminf(__builtin_fmaxf(o[i] * sc, -448.0f), 448.0f);
    int w0 = 0, w1 = 0; w0 = __builtin_amdgcn_cvt_pk_fp8_f32(t[0], t[1], w0, false); w0 = __builtin_amdgcn_cvt_pk_fp8_f32(t[2], t[3], w0, true);
    w1 = __builtin_amdgcn_cvt_pk_fp8_f32(t[4], t[5], w1, false); w1 = __builtin_amdgcn_cvt_pk_fp8_f32(t[6], t[7], w1, true);
    u32x2 r; r.x = (unsigned)w0; r.y = (unsigned)w1; return r;
}
constexpr int RING_BYTES = 131072;
constexpr int LX_P = RING_BYTES;
constexpr int LX_TBL = RING_BYTES + 4096;
constexpr int LX_ROUT = RING_BYTES + 8192;
constexpr int LX_MISC = RING_BYTES + 12288;
constexpr int LDS_BYTES = 147456;

namespace pg8 {
constexpr int BM = 256, BK = 64, HALF = 128, HTB = HALF * BK * 2, STAGE_BYTES = 8 * HTB, NXCD = 8, WGM = 8;
__device__ __forceinline__ int lds_byte(int r, int c) { const int st = (r >> 4) * 2 + (c >> 5), rr = r & 15, cc = c & 31, ob = rr * 64 + cc * 2; return st * 1024 + (ob ^ (((ob >> 9) & 1) << 5)); }
__device__ __forceinline__ void stage_rc(int b, int& R, int& C) { const int st = b / 1024, sb = b % 1024, swz = sb ^ (((sb >> 9) & 1) << 5); R = (st >> 1) * 16 + swz / 64; C = (st & 1) * 32 + (swz % 64) / 2; }
__device__ __forceinline__ int perm32(int rho) { const int n = rho >> 4, i = rho & 15; return 8 * (i >> 2) + 4 * n + (i & 3); }

struct Unit { int pm, pn, e; };
struct TileOrder {
    int nM, nN, nwg, G, c;
    __device__ __forceinline__ void init(int nM_, int nN_, int G_, int c_) { nM = nM_; nN = nN_; nwg = nM * nN; G = G_; c = c_; }
    __device__ __forceinline__ bool next_tile(int i, int& pm, int& pn) const {
        const long L = (long)i * G + c; if (L >= nwg) return false;
        int wgid = (int)L; { const int q = nwg / NXCD, r = nwg % NXCD, xcd = wgid % NXCD, off = wgid / NXCD; wgid = (xcd < r ? xcd * (q + 1) : r * (q + 1) + (xcd - r) * q) + off; }
        const int nig = WGM * nN, gid = wgid / nig, fm = gid * WGM, gsz = (nM - fm) < WGM ? (nM - fm) : WGM;
        pm = fm + ((wgid % nig) % gsz); pn = (wgid % nig) / gsz; return true;
    }
};
struct DenseSched {
    TileOrder o; const char* A; const char* Bt; int K;
    __device__ __forceinline__ bool next(int i, Unit& u) const { u.e = 0; return o.next_tile(i, u.pm, u.pn); }
    __device__ __forceinline__ const char* a_base(const Unit& u) const { return A + (size_t)u.pm * 256 * K * 2; }
    __device__ __forceinline__ const char* b_base(const Unit& u) const { return Bt + (size_t)u.pn * 256 * K * 2; }
    __device__ __forceinline__ unsigned a_off(const Unit&, int) const { return 0u; }
};
struct MoeSched {
    TileOrder o; const char* A; const char* Bt; int K; size_t bstride; const int* list; const LAS int* tbl;
    __device__ __forceinline__ bool next(int i, Unit& u) const {
        if (!o.next_tile(i, u.pm, u.pn)) return false;
        int e = 0;
#pragma unroll
        for (int j = 1; j < 8; ++j) e += (u.pm >= tbl[8 + j]) ? 1 : 0;
        u.e = __builtin_amdgcn_readfirstlane(e); return true;
    }
    __device__ __forceinline__ const char* a_base(const Unit& u) const { return list ? A : A + (size_t)u.pm * 256 * K * 2; }
    __device__ __forceinline__ const char* b_base(const Unit& u) const { return Bt + (size_t)u.e * bstride + (size_t)u.pn * 256 * K * 2; }
    __device__ __forceinline__ unsigned a_off(const Unit& u, int rl) const {
        const int pos = (u.pm - tbl[8 + u.e]) * 256 + rl; const int tok = list[((size_t)u.e * M + (pos < tbl[u.e] ? pos : 0)) * 4] >> 1; return (unsigned)tok * (unsigned)(K * 2);
    }
};
struct EpiCtx { int wr, wc, fr, fq, tid; LAS unsigned char* lds; };
typedef int i32x4 __attribute__((ext_vector_type(4)));
typedef int i32x8 __attribute__((ext_vector_type(8)));
__device__ __forceinline__ i32x8 cat8(bf16x8 lo, bf16x8 hi) { return __builtin_shufflevector(__builtin_bit_cast(i32x4, lo), __builtin_bit_cast(i32x4, hi), 0, 1, 2, 3, 4, 5, 6, 7); }
#define ACC_T const f32x4 (&acc)[2][2][4][2]

struct EpiProj {
    const float* ssp; u16* Y; u16* XB;
    __device__ __forceinline__ void operator()(ACC_T, const Unit& u, const EpiCtx& c) const {
        const int row0 = u.pm * 256 + c.wr * 64 + c.fr; const bool isY = u.pn < 4; u16* base = isY ? Y : XB; const int col0 = (u.pn & 3) * 256 + c.wc * 32 + 8 * c.fq;
        float rsv[8];
#pragma unroll
        for (int i = 0; i < 8; ++i) rsv[i] = rstd_of(ssp, row0 + (i >> 2) * 128 + (i & 3) * 16);
#pragma unroll
        for (int ai = 0; ai < 2; ++ai)
#pragma unroll
            for (int m = 0; m < 4; ++m) { const int row = row0 + ai * 128 + m * 16; const float rs = rsv[ai * 4 + m]; u16* rowp = base + (size_t)row * D + col0;
#pragma unroll
                for (int bj = 0; bj < 2; ++bj) { f32x4 v0 = acc[ai][bj][m][0] * rs, v1 = acc[ai][bj][m][1] * rs;
                    if (isY) {
#pragma unroll
                        for (int j = 0; j < 4; ++j) { v0[j] = fgelu_tanh(v0[j]); v1[j] = fgelu_tanh(v1[j]); } }
                    u32x4 w; w.x = cvt_pk_bf16(v0[0], v0[1]); w.y = cvt_pk_bf16(v0[2], v0[3]); w.z = cvt_pk_bf16(v1[0], v1[1]); w.w = cvt_pk_bf16(v1[2], v1[3]);
                    *(u32x4*)(rowp + bj * 128) = w; } }
    }
};
struct EpiGateUp {
    const float* ssp; u16* ACT;
    __device__ __forceinline__ void operator()(ACC_T, const Unit& u, const EpiCtx& c) const {
        const int row0 = u.pm * 256 + c.wr * 64 + c.fr, col0 = u.pn * 128 + c.wc * 32 + 8 * c.fq;
        float rsv[8];
#pragma unroll
        for (int i = 0; i < 8; ++i) rsv[i] = rstd_of(ssp, row0 + (i >> 2) * 128 + (i & 3) * 16);
#pragma unroll
        for (int ai = 0; ai < 2; ++ai)
#pragma unroll
            for (int m = 0; m < 4; ++m) { const int row = row0 + ai * 128 + m * 16; const float rs = rsv[ai * 4 + m]; float o[8];
#pragma unroll
                for (int n = 0; n < 2; ++n)
#pragma unroll
                    for (int j = 0; j < 4; ++j) o[4 * n + j] = fsilu(acc[ai][0][m][n][j] * rs) * (acc[ai][1][m][n][j] * rs);
                u32x4 w; w.x = cvt_pk_bf16(o[0], o[1]); w.y = cvt_pk_bf16(o[2], o[3]); w.z = cvt_pk_bf16(o[4], o[5]); w.w = cvt_pk_bf16(o[6], o[7]);
                *(u32x4*)(ACT + (size_t)row * DFF + col0) = w; }
    }
};
struct EpiRes {
    const float* Xin; u16* HB; const float* bias; float* ssp; unsigned char* HB8; float ascale;
    __device__ __forceinline__ void operator()(ACC_T, const Unit& u, const EpiCtx& c) const {
        const int col0 = u.pn * 256 + c.wc * 32 + 8 * c.fq;
        f32x4 bv[2][2];
#pragma unroll
        for (int bj = 0; bj < 2; ++bj)
#pragma unroll
            for (int n = 0; n < 2; ++n) { bv[bj][n] = (f32x4){0.f, 0.f, 0.f, 0.f}; if (bias) bv[bj][n] = *(const f32x4*)(bias + col0 + bj * 128 + 4 * n); }
        LAS float* P = (LAS float*)(c.lds + LX_P);
#pragma unroll
        for (int g = 0; g < 4; ++g) {
            f32x4 hin[2][2][2];
#pragma unroll
            for (int q = 0; q < 2; ++q) { const int ai = g >> 1, m = (g & 1) * 2 + q; const size_t off = (size_t)(u.pm * 256 + ai * 128 + c.wr * 64 + m * 16 + c.fr) * D + col0;
#pragma unroll
                for (int bj = 0; bj < 2; ++bj) {
                    if (Xin) { hin[q][bj][0] = *(const f32x4*)(Xin + off + bj * 128); hin[q][bj][1] = *(const f32x4*)(Xin + off + bj * 128 + 4); }
                    else { const u32x4 hb = *(const u32x4*)(HB + off + bj * 128);
                        hin[q][bj][0] = (f32x4){bf2f(hb.x & 0xffffu), bf2f(hb.x >> 16), bf2f(hb.y & 0xffffu), bf2f(hb.y >> 16)}; hin[q][bj][1] = (f32x4){bf2f(hb.z & 0xffffu), bf2f(hb.z >> 16), bf2f(hb.w & 0xffffu), bf2f(hb.w >> 16)}; } } }
#pragma unroll
            for (int q = 0; q < 2; ++q) { const int ai = g >> 1, m = (g & 1) * 2 + q; const int rl = ai * 128 + c.wr * 64 + m * 16 + c.fr; const size_t off = (size_t)(u.pm * 256 + rl) * D + col0; float s = 0.f;
#pragma unroll
                for (int bj = 0; bj < 2; ++bj) {
                    const f32x4 h0 = hin[q][bj][0] + acc[ai][bj][m][0] * ascale + bv[bj][0], h1 = hin[q][bj][1] + acc[ai][bj][m][1] * ascale + bv[bj][1];
                    u32x4 w; w.x = cvt_pk_bf16(h0[0], h0[1]); w.y = cvt_pk_bf16(h0[2], h0[3]); w.z = cvt_pk_bf16(h1[0], h1[1]); w.w = cvt_pk_bf16(h1[2], h1[3]);
                    *(u32x4*)(HB + off + bj * 128) = w;
                    if (HB8) { const float o8[8] = {h0[0], h0[1], h0[2], h0[3], h1[0], h1[1], h1[2], h1[3]}; *(u32x2*)(HB8 + off + bj * 128) = pk8_fp8(o8, S8_A); }
                    s += ((h0[0] * h0[0] + h0[1] * h0[1]) + (h0[2] * h0[2] + h0[3] * h0[3])) + ((h1[0] * h1[0] + h1[1] * h1[1]) + (h1[2] * h1[2] + h1[3] * h1[3])); }
                s += __shfl_xor(s, 16); s += __shfl_xor(s, 32);
                if (c.fq == 0) P[rl * 4 + c.wc] = s; }
            asm volatile("" ::: "memory"); }
        asm volatile("s_waitcnt lgkmcnt(0)" ::: "memory"); __builtin_amdgcn_s_barrier(); asm volatile("" ::: "memory");
        if (c.tid < 256) { const f32x4 p = *(const LAS f32x4*)(P + 4 * c.tid); ssp[(size_t)(u.pm * 256 + c.tid) * 4 + u.pn] = (p[0] + p[1]) + (p[2] + p[3]); }
    }
};
struct EpiQKV {
    const float* ssp; const float* bias; const u16* rope; u16* Q; u16* Kb; u16* Vb; float ascale;
    __device__ __forceinline__ void operator()(ACC_T, const Unit& u, const EpiCtx& c) const {
        const int row0 = u.pm * 256 + c.wr * 64 + c.fr, bcol0 = u.pn * 256 + c.wc * 32 + 8 * c.fq;
        u16* base; int pitch, col0; float sc = 1.0f;
        if (u.pn < 4) { base = Q; pitch = D; col0 = bcol0; sc = 0.125f * LOG2E; } else if (u.pn == 4) { base = Kb; pitch = KVD; col0 = bcol0 - 1024; } else { base = Vb; pitch = KVD; col0 = bcol0 - 1280; }
        const bool rot = (u.pn < 5) && ((c.wc & 1) == 0);
        f32x4 bv[2][2];
#pragma unroll
        for (int bj = 0; bj < 2; ++bj)
#pragma unroll
            for (int n = 0; n < 2; ++n) bv[bj][n] = *(const f32x4*)(bias + bcol0 + bj * 128 + 4 * n);
        float rsv[8];
#pragma unroll
        for (int i = 0; i < 8; ++i) rsv[i] = rstd_of(ssp, row0 + (i >> 2) * 128 + (i & 3) * 16);
#pragma unroll
        for (int g = 0; g < 4; ++g) {
            u32x4 rpv[2][2];
            if (rot) {
#pragma unroll
                for (int q2 = 0; q2 < 2; ++q2) { const u32x4* rp = (const u32x4*)(rope + (size_t)(row0 + (g >> 1) * 128 + ((g & 1) * 2 + q2) * 16) * 16); rpv[q2][0] = rp[0]; rpv[q2][1] = rp[1]; } }
#pragma unroll
            for (int q2 = 0; q2 < 2; ++q2) { const int ai = g >> 1, m = (g & 1) * 2 + q2; const int row = row0 + ai * 128 + m * 16; const float rs = rsv[ai * 4 + m] * ascale;
                f32x4 cs0, cs1, sn0, sn1;
                if (rot) { const u32x4 cw = rpv[q2][0], sw = rpv[q2][1];
                    cs0 = (f32x4){bf2f(cw.x & 0xffffu), bf2f(cw.x >> 16), bf2f(cw.y & 0xffffu), bf2f(cw.y >> 16)}; cs1 = (f32x4){bf2f(cw.z & 0xffffu), bf2f(cw.z >> 16), bf2f(cw.w & 0xffffu), bf2f(cw.w >> 16)};
                    sn0 = (f32x4){bf2f(sw.x & 0xffffu), bf2f(sw.x >> 16), bf2f(sw.y & 0xffffu), bf2f(sw.y >> 16)}; sn1 = (f32x4){bf2f(sw.z & 0xffffu), bf2f(sw.z >> 16), bf2f(sw.w & 0xffffu), bf2f(sw.w >> 16)};
                    if (c.fq == 0) { sn0 = -sn0; sn1 = -sn1; } }
#pragma unroll
                for (int bj = 0; bj < 2; ++bj) { f32x4 v0 = acc[ai][bj][m][0] * rs + bv[bj][0], v1 = acc[ai][bj][m][1] * rs + bv[bj][1];
                    if (rot) { f32x4 p0, p1;
#pragma unroll
                        for (int j = 0; j < 4; ++j) { p0[j] = __shfl_xor(v0[j], 16); p1[j] = __shfl_xor(v1[j], 16); }
                        if (c.fq < 2) { v0 = v0 * cs0 + p0 * sn0; v1 = v1 * cs1 + p1 * sn1; } }
                    v0 = v0 * sc; v1 = v1 * sc;
                    u32x4 w; w.x = cvt_pk_bf16(v0[0], v0[1]); w.y = cvt_pk_bf16(v0[2], v0[3]); w.z = cvt_pk_bf16(v1[0], v1[1]); w.w = cvt_pk_bf16(v1[2], v1[3]);
                    *(u32x4*)(base + (size_t)row * pitch + col0 + bj * 128) = w; } } }
    }
};
struct EpiMoeUp {
    const float* ssp; const int* list; const float* gatew; const LAS int* tbl; u16* ACT2;
    __device__ __forceinline__ void operator()(ACC_T, const Unit& u, const EpiCtx& c) const {
        const int col0 = u.pn * 128 + c.wc * 32 + 8 * c.fq, n_e = tbl[u.e], pos0 = (u.pm - tbl[8 + u.e]) * 256;
        u32x4 rec[8];
#pragma unroll
        for (int i = 0; i < 8; ++i) { const int pos = pos0 + (i >> 2) * 128 + c.wr * 64 + (i & 3) * 16 + c.fr; rec[i] = *(const u32x4*)(list + ((size_t)u.e * M + (pos < n_e ? pos : 0)) * 4); }
#pragma unroll
        for (int ai = 0; ai < 2; ++ai)
#pragma unroll
            for (int m = 0; m < 4; ++m) { const int rl = ai * 128 + c.wr * 64 + m * 16 + c.fr;
                const bool valid = pos0 + rl < n_e; const unsigned gwu = rec[ai * 4 + m].y, rsu = rec[ai * 4 + m].z;
                const float gw = valid ? u2f(gwu) : 0.f; const float rs = u2f(rsu) * (MOE_FP8 ? 1.0f / (S8_A * S8_W) : 1.0f); float o[8];
#pragma unroll
                for (int n = 0; n < 2; ++n)
#pragma unroll
                    for (int j = 0; j < 4; ++j) o[4 * n + j] = fsilu(acc[ai][0][m][n][j] * rs) * (acc[ai][1][m][n][j] * rs) * gw;
                if (MOE_FP8) *(u32x2*)((unsigned char*)ACT2 + (size_t)(u.pm * 256 + rl) * DFF + col0) = pk8_fp8(o, S8_ACT);
                else { u32x4 w; w.x = cvt_pk_bf16(o[0], o[1]); w.y = cvt_pk_bf16(o[2], o[3]); w.z = cvt_pk_bf16(o[4], o[5]); w.w = cvt_pk_bf16(o[6], o[7]);
                    *(u32x4*)(ACT2 + (size_t)(u.pm * 256 + rl) * DFF + col0) = w; } }
    }
};
struct EpiMoeDown {
    const int* list; const LAS int* tbl; u16* MO;
    __device__ __forceinline__ void operator()(ACC_T, const Unit& u, const EpiCtx& c) const {
        const int col0 = u.pn * 256 + c.wc * 32 + 8 * c.fq, n_e = tbl[u.e], pos0 = (u.pm - tbl[8 + u.e]) * 256;
        int tkv[8];
#pragma unroll
        for (int i = 0; i < 8; ++i) { const int pos = pos0 + (i >> 2) * 128 + c.wr * 64 + (i & 3) * 16 + c.fr; const int v = list[((size_t)u.e * M + (pos < n_e ? pos : 0)) * 4]; tkv[i] = pos < n_e ? v : -1; }
#pragma unroll
        for (int ai = 0; ai < 2; ++ai)
#pragma unroll
            for (int m = 0; m < 4; ++m) {
                if (tkv[ai * 4 + m] >= 0) { const int tk = tkv[ai * 4 + m]; u16* dst = MO + ((size_t)(tk & 1) * M + (tk >> 1)) * D + col0;
#pragma unroll
                    for (int bj = 0; bj < 2; ++bj) { const float us = MOE_FP8 ? 1.0f / (S8_ACT * S8_WD) : 1.0f; const f32x4 v0 = acc[ai][bj][m][0] * us, v1 = acc[ai][bj][m][1] * us;
                        u32x4 w; w.x = cvt_pk_bf16(v0[0], v0[1]); w.y = cvt_pk_bf16(v0[2], v0[3]); w.z = cvt_pk_bf16(v1[0], v1[1]); w.w = cvt_pk_bf16(v1[2], v1[3]);
                        *(u32x4*)(dst + bj * 128) = w; } } }
    }
};

template <class Epi, class Sched, bool GATHER, bool FP8 = false>
__device__ __forceinline__ void gemm_phase(LAS unsigned char* lds, const int K, const Sched& S, const Epi& E) {
    const int tid = threadIdx.x, wid = __builtin_amdgcn_readfirstlane(tid >> 6), lane = tid & 63, wr = wid >> 2, wc = wid & 3, fr = lane & 15, fq = lane >> 4;
    const int nt = K / BK;
    EpiCtx ctx; ctx.wr = wr; ctx.wc = wc; ctx.fr = fr; ctx.fq = fq; ctx.tid = tid; ctx.lds = lds;
    unsigned voffA[2], voffB[2]; int RA[2]; unsigned CA[2];
#pragma unroll
    for (int i = 0; i < 2; ++i) { int R, C; stage_rc(tid * 16 + i * 8192, R, C); const int Rb = (R & ~31) + perm32(R & 31);
        voffA[i] = (unsigned)(R * K + C) * 2u; voffB[i] = (unsigned)(Rb * K + C) * 2u; RA[i] = R; CA[i] = (unsigned)C * 2u; }
    const size_t kstep = (size_t)(BK * 2);
    const size_t hstep = (size_t)HALF * K * 2;
    const unsigned ldsw = (unsigned)wid * 1024u;
    const int aoff = lds_byte(wr * 64 + fr, fq * 8), boff = lds_byte(wc * 32 + fr, fq * 8);
#define PG8_SA(b, h) (((b) * 2 + (h)) * HTB)
#define PG8_SB(b, h) ((4 + (b) * 2 + (h)) * HTB)
#define PG8_GLDS(src, dstoff) __builtin_amdgcn_global_load_lds((const unsigned*)(src), (LAS unsigned*)(lds + (dstoff)), 16, 0, 0)
#define PG8_STAGE_B(bufoff, gbase) do { _Pragma("unroll") for (int _i = 0; _i < 2; ++_i) PG8_GLDS((const char*)(gbase) + voffB[_i], (bufoff) + ldsw + _i * 8192); } while (0)
#define PG8_STAGE_A(bufoff, gk, h, VA) do { _Pragma("unroll") for (int _i = 0; _i < 2; ++_i) { \
        if constexpr (GATHER) PG8_GLDS((const char*)(gk) + VA[h][_i], (bufoff) + ldsw + _i * 8192); else PG8_GLDS((const char*)(gk) + (size_t)(h) * hstep + voffA[_i], (bufoff) + ldsw + _i * 8192); } } while (0)
#define PG8_LDA(dst, b, h) do { _Pragma("unroll") for (int m = 0; m < 4; ++m) _Pragma("unroll") for (int k = 0; k < 2; ++k) dst[m][k] = *(const LAS bf16x8*)(lds + PG8_SA(b, h) + aoff + m * 2048 + k * 1024); } while (0)
#define PG8_LDB(dst, b, h) do { _Pragma("unroll") for (int n = 0; n < 2; ++n) _Pragma("unroll") for (int k = 0; k < 2; ++k) dst[n][k] = *(const LAS bf16x8*)(lds + PG8_SB(b, h) + boff + n * 2048 + k * 1024); } while (0)
#define PG8_MMA(ai, bj, At, Bt) do { __builtin_amdgcn_s_setprio(1); _Pragma("unroll") for (int m = 0; m < 4; ++m) _Pragma("unroll") for (int n = 0; n < 2; ++n) { \
        if constexpr (FP8) asm volatile("v_mfma_scale_f32_16x16x128_f8f6f4 %0, %1, %2, %0, %3, %3 op_sel_hi:[0,0,0]" : "+v"(acc[ai][bj][m][n]) : "v"(cat8(Bt[n][0], Bt[n][1])), "v"(cat8(At[m][0], At[m][1])), "v"(one_scale)); \
        else { _Pragma("unroll") for (int k = 0; k < 2; ++k) acc[ai][bj][m][n] = __builtin_amdgcn_mfma_f32_16x16x32_bf16(Bt[n][k], At[m][k], acc[ai][bj][m][n], 0, 0, 0); } } \
        __builtin_amdgcn_s_setprio(0); } while (0)
#define PG8_WAIT_V(n) asm volatile("s_waitcnt vmcnt(" #n ")" ::: "memory")
#define PG8_WAIT_L(n) asm volatile("s_waitcnt lgkmcnt(" #n ")" ::: "memory")
#define PG8_BAR __builtin_amdgcn_s_barrier()
#define PG8_SCHED __builtin_amdgcn_sched_barrier(0)
    const int one_scale = 0x7f7f7f7f;
    Unit cur, nxt; int ui = 0;
    if (!S.next(0, cur)) return;
    f32x4 acc[2][2][4][2];
#pragma unroll
    for (int a = 0; a < 2; ++a)
#pragma unroll
        for (int b = 0; b < 2; ++b)
#pragma unroll
            for (int m = 0; m < 4; ++m)
#pragma unroll
                for (int n = 0; n < 2; ++n) acc[a][b][m][n] = (f32x4){0.f, 0.f, 0.f, 0.f};
    bf16x8 At[4][2], B0[2][2], B1[2][2];
    const char* cA = S.a_base(cur); const char* cB = S.b_base(cur);
    unsigned vaC[2][2], vaN[2][2];
#pragma unroll
    for (int h = 0; h < 2; ++h)
#pragma unroll
        for (int i = 0; i < 2; ++i) { vaC[h][i] = GATHER ? S.a_off(cur, h * HALF + RA[i]) + CA[i] : 0u; vaN[h][i] = vaC[h][i]; }
    PG8_STAGE_B(PG8_SB(0, 0), cB); PG8_STAGE_B(PG8_SB(0, 1), cB + hstep); PG8_STAGE_A(PG8_SA(0, 0), cA, 0, vaC); PG8_STAGE_A(PG8_SA(0, 1), cA, 1, vaC);
    if (wr == 1) PG8_BAR;
    PG8_WAIT_V(2); PG8_BAR;
    PG8_STAGE_B(PG8_SB(1, 0), cB + kstep); PG8_STAGE_A(PG8_SA(1, 0), cA + kstep, 0, vaC); PG8_STAGE_B(PG8_SB(1, 1), cB + hstep + kstep);
    PG8_WAIT_V(6); PG8_BAR;
    for (;;) {
        const bool has_next = S.next(ui + 1, nxt);
        const char* nA = has_next ? S.a_base(nxt) : cA; const char* nB = has_next ? S.b_base(nxt) : cB;
        if constexpr (GATHER) { if (has_next) {
#pragma unroll
            for (int h = 0; h < 2; ++h)
#pragma unroll
                for (int i = 0; i < 2; ++i) vaN[h][i] = S.a_off(nxt, h * HALF + RA[i]) + CA[i]; } }
#pragma unroll 1
        for (int t = 0; t < nt; t += 2) {
            const bool last = (t == nt - 2);
            const char* a1 = cA + (size_t)(t + 1) * kstep;
            const char* a2 = last ? nA : cA + (size_t)(t + 2) * kstep; const char* b2 = last ? nB : cB + (size_t)(t + 2) * kstep;
            const char* a3 = a2 + kstep; const char* b3 = b2 + kstep;
            unsigned v2[2][2];
#pragma unroll
            for (int h = 0; h < 2; ++h)
#pragma unroll
                for (int i = 0; i < 2; ++i) v2[h][i] = (GATHER && last) ? vaN[h][i] : vaC[h][i];
            PG8_LDB(B0, 0, 0); PG8_LDB(B1, 0, 1); PG8_SCHED; PG8_LDA(At, 0, 0); PG8_STAGE_A(PG8_SA(1, 1), a1, 1, vaC);
            PG8_WAIT_V(8); PG8_WAIT_L(0); PG8_BAR; PG8_MMA(0, 0, At, B0); PG8_MMA(0, 1, At, B1); PG8_BAR; PG8_SCHED;
            PG8_LDA(At, 0, 1); PG8_STAGE_B(PG8_SB(0, 0), b2); PG8_STAGE_B(PG8_SB(0, 1), b2 + hstep); PG8_STAGE_A(PG8_SA(0, 0), a2, 0, v2);
            PG8_WAIT_V(8); PG8_WAIT_L(0); PG8_BAR; PG8_MMA(1, 0, At, B0); PG8_MMA(1, 1, At, B1); PG8_BAR; PG8_SCHED;
            PG8_LDB(B0, 1, 0); PG8_LDB(B1, 1, 1); PG8_SCHED; PG8_LDA(At, 1, 0); PG8_STAGE_A(PG8_SA(0, 1), a2, 1, v2);
            PG8_WAIT_V(8); PG8_WAIT_L(0); PG8_BAR; PG8_MMA(0, 0, At, B0); PG8_MMA(0, 1, At, B1); PG8_BAR; PG8_SCHED;
            PG8_LDA(At, 1, 1); PG8_STAGE_B(PG8_SB(1, 0), b3); PG8_STAGE_B(PG8_SB(1, 1), b3 + hstep); PG8_STAGE_A(PG8_SA(1, 0), a3, 0, v2);
            PG8_WAIT_V(8); PG8_WAIT_L(0); PG8_BAR; PG8_MMA(1, 0, At, B0); PG8_MMA(1, 1, At, B1); PG8_BAR; PG8_SCHED;
        }
        if (wr == 0) PG8_BAR;
        E(acc, cur, ctx);
        if (!has_next) break;
#pragma unroll
        for (int a = 0; a < 2; ++a)
#pragma unroll
            for (int b = 0; b < 2; ++b)
#pragma unroll
                for (int m = 0; m < 4; ++m)
#pragma unroll
                    for (int n = 0; n < 2; ++n) acc[a][b][m][n] = (f32x4){0.f, 0.f, 0.f, 0.f};
        cur = nxt; cA = nA; cB = nB; ++ui;
#pragma unroll
        for (int h = 0; h < 2; ++h)
#pragma unroll
            for (int i = 0; i < 2; ++i) vaC[h][i] = vaN[h][i];
        if (wr == 1) PG8_BAR;
    }
    PG8_WAIT_V(0);
    PG8_BAR;
#undef PG8_SA
#undef PG8_SB
#undef PG8_GLDS
#undef PG8_STAGE_A
#undef PG8_STAGE_B
#undef PG8_LDA
#undef PG8_LDB
#undef PG8_MMA
#undef PG8_WAIT_V
#undef PG8_WAIT_L
#undef PG8_BAR
#undef PG8_SCHED
}
}

#define XB_TMO      128
#define XB_XCNT(j)  (256  + 64 * (j))
#define XB_XSUB(j)  (1280 + 64 * (j))
#define XB_XGEN(j)  (2304 + 64 * (j))
#define XB_TOP      3328
#define XB_TOPGEN   3392
#define XCD_BAR_WORDS 3456
#define XB_SPIN_CAP (1u << 18)
__device__ __forceinline__ unsigned xb_ld(unsigned* p)              { return __hip_atomic_load(p, __ATOMIC_RELAXED, __HIP_MEMORY_SCOPE_AGENT); }
__device__ __forceinline__ unsigned xb_add(unsigned* p, unsigned v) { return __hip_atomic_fetch_add(p, v, __ATOMIC_RELAXED, __HIP_MEMORY_SCOPE_AGENT); }
__device__ __forceinline__ unsigned xb_xcc_id() { return (unsigned)__builtin_amdgcn_s_getreg((3 << 11) | 20) & 0xFu; }
#define XB_SPIN(cond, bar) do { unsigned _sp = 0; while (cond) { __builtin_amdgcn_s_sleep(1); \
    if ((++_sp & 255u) == 0u) { if (xb_ld(&(bar)[XB_TMO])) break; if (_sp > XB_SPIN_CAP) { atomicAdd(&(bar)[XB_TMO], 1u); break; } } } } while (0)
struct XcdBarrier { unsigned* bar; unsigned x; volatile LAS unsigned* st; };
__device__ __forceinline__ XcdBarrier xcd_barrier_post(unsigned* bar, volatile LAS unsigned* st) {
    XcdBarrier b; b.bar = bar; b.x = xb_xcc_id(); b.st = st;
    if (threadIdx.x == 0) (void)xb_add(&bar[XB_XCNT(b.x)], 1u);
    return b;
}
__device__ __forceinline__ void xcd_barrier_complete(unsigned* bar, unsigned x, unsigned& nloc, unsigned& nx) {
    const unsigned G = gridDim.x * gridDim.y * gridDim.z;
    unsigned sum, cnt, mine, sp = 0u;
    for (;;) {
        sum = 0u; cnt = 0u; mine = 0u;
#pragma unroll
        for (unsigned j = 0; j < 16; ++j) { const unsigned c = xb_ld(&bar[XB_XCNT(j)]); sum += c; cnt += (c > 0u) ? 1u : 0u; mine = (j == x) ? c : mine; }
        if (sum == G) break;
        __builtin_amdgcn_s_sleep(1);
        if ((++sp & 255u) == 0u) { if (xb_ld(&bar[XB_TMO])) break; if (sp > XB_SPIN_CAP) { atomicAdd(&bar[XB_TMO], 1u); break; } }
    }
    nloc = mine > 0u ? mine : 1u; nx = cnt > 0u ? cnt : 1u;
}
__device__ __forceinline__ void xcd_barrier(const XcdBarrier& b) {
    asm volatile("s_waitcnt vmcnt(0)" ::: "memory");
    __syncthreads();
    if (threadIdx.x == 0) {
        unsigned* bar = b.bar;
        __builtin_amdgcn_s_waitcnt(0);
        unsigned nloc = b.st[0], nx = b.st[1];
        if (nloc == 0u) { xcd_barrier_complete(bar, b.x, nloc, nx); b.st[0] = nloc; b.st[1] = nx; }
        const unsigned old = xb_add(&bar[XB_XSUB(b.x)], 1u);
        const unsigned gen = old / nloc;
        if (old + 1u == (gen + 1u) * nloc) {
            __builtin_amdgcn_fence(__ATOMIC_RELEASE, "agent");
            asm volatile("s_waitcnt vmcnt(0)" ::: "memory");
            const unsigned og = xb_add(&bar[XB_TOP], 1u);
            const unsigned tg = og / nx;
            if (og + 1u == (tg + 1u) * nx) xb_add(&bar[XB_TOPGEN], 1u);
            else XB_SPIN(xb_ld(&bar[XB_TOPGEN]) == tg, bar);
            __builtin_amdgcn_fence(__ATOMIC_ACQUIRE, "agent");
            xb_add(&bar[XB_XGEN(b.x)], 1u);
            asm volatile("s_waitcnt vmcnt(0)" ::: "memory");
        } else {
            XB_SPIN(xb_ld(&bar[XB_XGEN(b.x)]) == gen, bar);
            __builtin_amdgcn_fence(__ATOMIC_ACQUIRE, "agent");
            asm volatile("s_waitcnt vmcnt(0)" ::: "memory");
        }
    }
    __syncthreads();
}
constexpr int CW_BAR = 4096;

constexpr int XS_STRIDE = 272;
constexpr int LR_XS = 0, LR_XC = 35840, LR_HS = LR_XC + 34816, LR_CP = LR_HS + 34816, LR_HIN = LR_CP + 2560;
static_assert(LR_HIN + 512 <= RING_BYTES, "lru lds");
template <bool FINAL>
__device__ __forceinline__ void lru_phase(const Args& a, LAS unsigned char* lds, int G, int vcu) {
    const int tid = threadIdx.x, lane = tid & 63, w = __builtin_amdgcn_readfirstlane(tid >> 6), fr = lane & 15, fq = lane >> 4;
    const u16* XB = (const u16*)(a.ws + WS_XB); const u16* Y = (const u16*)(a.ws + WS_Y); u16* Gout = (u16*)(a.ws + WS_G);
    const u16* WAX = (const u16*)(a.ws + WS_WAX); float* CAR = (float*)(a.ws + WS_CAR); const float* spl = (const float*)(a.ws + WS_SPL);
    const float* cw = a.in[6]; const float* cb = a.in[7]; const float* b_a = a.in[9]; const float* b_x = a.in[11];
    LAS float* CP = (LAS float*)(lds + LR_CP); LAS float* HIN = (LAS float*)(lds + LR_HIN);
    for (int unit = vcu; unit < 256; unit += G) {
        const int n = unit & 7, chunk = unit >> 3, t0 = chunk * 512, ch0 = 128 * n;
        u32x4 xpre[5];
#define LRU_XLOAD(ts_) do { _Pragma("unroll") for (int i = 0; i < 5; ++i) { const int p = tid + 512 * i, row = p >> 4, pc = p & 15, t = (ts_) - 3 + row; xpre[i] = (u32x4){0u, 0u, 0u, 0u}; \
            if (p < 131 * 16 && t >= 0) xpre[i] = *(const u32x4*)(XB + (size_t)t * D + ch0 + 8 * pc); } } while (0)
        LRU_XLOAD(t0);
        bf16x8 bfr[4], bfi[4];
        { const u16* wb = WAX + ((size_t)n * 256 + 16 * w + fr) * 128 + 8 * fq;
#pragma unroll
          for (int s = 0; s < 4; ++s) { bfr[s] = *(const bf16x8*)(wb + 32 * s); bfi[s] = *(const bf16x8*)(wb + 128 * 128 + 32 * s); } }
        const int ch = ch0 + 16 * w + fr; const float nba = -LOG2E * b_a[ch], nbx = -LOG2E * b_x[ch], c1 = -8.0f * LOG2E * spl[ch];
        for (int i = tid; i < 5 * 128; i += 512) { const int k = i >> 7, c = i & 127; CP[i] = k < 4 ? cw[k * D + ch0 + c] : cb[ch0 + c]; }
        float H = 0.f, Ptot = 1.f;
        if (FINAL) {
            const int hh = lane >> 5, jj = lane & 31;
#pragma unroll
            for (int it = 0; it < 8; ++it) { const int cl = 16 * w + 2 * it + hh; float A = 1.f, h = 0.f;
                if (jj < chunk) { const f32x2v_t v = *(const f32x2v_t*)(CAR + (((size_t)n * 32 + jj) * 128 + cl) * 2); A = v.x; h = v.y; }
#pragma unroll
                for (int d = 1; d < 32; d <<= 1) { const float Ap = __shfl_up(A, d, 32), hp = __shfl_up(h, d, 32); if (jj >= d) { h = A * hp + h; A = A * Ap; } }
                if (jj == 31) HIN[cl] = h; }
        }
        __syncthreads();
        if (FINAL) H = HIN[16 * w + fr];
        for (int s = 0; s < 4; ++s) {
            const int ts = t0 + 128 * s;
#pragma unroll
            for (int i = 0; i < 5; ++i) { const int p = tid + 512 * i, row = p >> 4, pc = p & 15; if (p < 131 * 16) *(LAS u32x4*)(lds + LR_XS + row * XS_STRIDE + pc * 16) = xpre[i]; }
            __syncthreads();
            if (s < 3) LRU_XLOAD(ts + 128);
            u32x4 ypre[4];
            if (FINAL) {
#pragma unroll
                for (int i = 0; i < 4; ++i) { const int p = tid + 512 * i, row = p >> 4, pc = p & 15; ypre[i] = *(const u32x4*)(Y + (size_t)(ts + row) * D + ch0 + 8 * pc); } }
            { const int cg = tid & 15, tg = tid >> 4; float o[4][8], wk[4][8];
#pragma unroll
              for (int k = 0; k < 4; ++k) { const f32x4 w0 = *(const LAS f32x4*)(CP + k * 128 + 8 * cg), w1 = *(const LAS f32x4*)(CP + k * 128 + 8 * cg + 4);
#pragma unroll
                  for (int i = 0; i < 4; ++i) { wk[k][i] = w0[i]; wk[k][4 + i] = w1[i]; } }
              { const f32x4 b0 = *(const LAS f32x4*)(CP + 512 + 8 * cg), b1 = *(const LAS f32x4*)(CP + 512 + 8 * cg + 4);
#pragma unroll
                for (int jt = 0; jt < 4; ++jt)
#pragma unroll
                    for (int i = 0; i < 4; ++i) { o[jt][i] = b0[i]; o[jt][4 + i] = b1[i]; } }
#pragma unroll
              for (int rr = 0; rr < 7; ++rr) { const u32x4 xv = *(const LAS u32x4*)(lds + LR_XS + (4 * tg + rr) * XS_STRIDE + cg * 16); float xf[8];
                  xf[0] = bf2f(xv.x & 0xffffu); xf[1] = bf2f(xv.x >> 16); xf[2] = bf2f(xv.y & 0xffffu); xf[3] = bf2f(xv.y >> 16); xf[4] = bf2f(xv.z & 0xffffu); xf[5] = bf2f(xv.z >> 16); xf[6] = bf2f(xv.w & 0xffffu); xf[7] = bf2f(xv.w >> 16);
#pragma unroll
                  for (int jt = 0; jt < 4; ++jt) { const int k = rr - jt; if (k >= 0 && k <= 3) {
#pragma unroll
                      for (int i = 0; i < 8; ++i) o[jt][i] += xf[i] * wk[k][i]; } } }
#pragma unroll
              for (int jt = 0; jt < 4; ++jt) { u32x4 wv; wv.x = cvt_pk_bf16(o[jt][0], o[jt][1]); wv.y = cvt_pk_bf16(o[jt][2], o[jt][3]); wv.z = cvt_pk_bf16(o[jt][4], o[jt][5]); wv.w = cvt_pk_bf16(o[jt][6], o[jt][7]);
                  *(LAS u32x4*)(lds + LR_XC + (4 * tg + jt) * XS_STRIDE + cg * 16) = wv; } }
            __syncthreads();
            f32x4 ar[8], ag[8];
#pragma unroll
            for (int m = 0; m < 8; ++m) { ar[m] = (f32x4){0.f, 0.f, 0.f, 0.f}; ag[m] = (f32x4){0.f, 0.f, 0.f, 0.f}; }
#pragma unroll
            for (int m = 0; m < 8; ++m)
#pragma unroll
                for (int s2 = 0; s2 < 4; ++s2) { const bf16x8 af = *(const LAS bf16x8*)(lds + LR_XC + (16 * m + fr) * XS_STRIDE + (32 * s2 + 8 * fq) * 2);
                    ar[m] = __builtin_amdgcn_mfma_f32_16x16x32_bf16(af, bfr[s2], ar[m], 0, 0, 0); ag[m] = __builtin_amdgcn_mfma_f32_16x16x32_bf16(af, bfi[s2], ag[m], 0, 0, 0); }
#pragma unroll
            for (int m = 0; m < 8; ++m) {
                float av[4], hv[4]; float Aseg = 1.f, Bseg = 0.f;
#pragma unroll
                for (int j = 0; j < 4; ++j) { const int tl = 16 * m + 4 * fq + j;
                    const float rg = frcp(1.0f + fexp2(__builtin_fmaf(ar[m][j], -LOG2E, nba))), ig = frcp(1.0f + fexp2(__builtin_fmaf(ag[m][j], -LOG2E, nbx)));
                    const float a_ = fexp2(c1 * rg);
                    const float xc = bf2f(*(const LAS u16*)(lds + LR_XC + tl * XS_STRIDE + (16 * w + fr) * 2));
                    const float b_ = __builtin_amdgcn_sqrtf(__builtin_fmaf(-a_, a_, 1.0f)) * (ig * xc);
                    Bseg = __builtin_fmaf(a_, Bseg, b_); Aseg *= a_; av[j] = Aseg; hv[j] = Bseg; }
                const float A1 = __shfl_xor(Aseg, 16), B1 = __shfl_xor(Bseg, 16);
                const bool odd = (fq & 1) != 0, hi2 = fq >= 2;
                const float Ap = Aseg * A1, Bp = odd ? __builtin_fmaf(Aseg, B1, Bseg) : __builtin_fmaf(A1, Bseg, B1);
                const float A2 = __shfl_xor(Ap, 32), B2 = __shfl_xor(Bp, 32);
                const float hpair = hi2 ? __builtin_fmaf(A2, H, B2) : H;
                const float my = odd ? __builtin_fmaf(A1, hpair, B1) : hpair;
                const float Alo = hi2 ? A2 : Ap, Blo = hi2 ? B2 : Bp, Ahi = hi2 ? Ap : A2, Bhi = hi2 ? Bp : B2;
                H = __builtin_fmaf(Ahi, __builtin_fmaf(Alo, H, Blo), Bhi); Ptot *= Alo * Ahi;
                if (FINAL) {
#pragma unroll
                    for (int j = 0; j < 4; ++j) { const int tl = 16 * m + 4 * fq + j; *(LAS u16*)(lds + LR_HS + tl * XS_STRIDE + (16 * w + fr) * 2) = (u16)f2bf(__builtin_fmaf(av[j], my, hv[j])); } }
            }
            if (FINAL) {
                __syncthreads();
#pragma unroll
                for (int i = 0; i < 4; ++i) { const int p = tid + 512 * i, row = p >> 4, pc = p & 15; const size_t go = (size_t)(ts + row) * D + ch0 + 8 * pc;
                    const u32x4 hv = *(const LAS u32x4*)(lds + LR_HS + row * XS_STRIDE + pc * 16); const u32x4 yv = ypre[i]; u32x4 ov;
                    ov.x = cvt_pk_bf16(bf2f(hv.x & 0xffffu) * bf2f(yv.x & 0xffffu), bf2f(hv.x >> 16) * bf2f(yv.x >> 16)); ov.y = cvt_pk_bf16(bf2f(hv.y & 0xffffu) * bf2f(yv.y & 0xffffu), bf2f(hv.y >> 16) * bf2f(yv.y >> 16));
                    ov.z = cvt_pk_bf16(bf2f(hv.z & 0xffffu) * bf2f(yv.z & 0xffffu), bf2f(hv.z >> 16) * bf2f(yv.z >> 16)); ov.w = cvt_pk_bf16(bf2f(hv.w & 0xffffu) * bf2f(yv.w & 0xffffu), bf2f(hv.w >> 16) * bf2f(yv.w >> 16));
                    *(u32x4*)(Gout + go) = ov; }
            }
        }
#undef LRU_XLOAD
        if (!FINAL) { if (fq == 0) { f32x2v_t v; v.x = Ptot; v.y = H; *(f32x2v_t*)(CAR + (((size_t)n * 32 + chunk) * 128 + 16 * w + fr) * 2) = v; } }
        __syncthreads();
    }
}

constexpr int AT_KS = 144, AT_K = 0, AT_V = 256 * AT_KS;
__device__ __forceinline__ int crow(int r, int hi) { return (r & 3) + 8 * (r >> 2) + 4 * hi; }
__device__ __forceinline__ void attn_phase(const Args& a, LAS unsigned char* lds, int G, int vcu) {
    const int tid = threadIdx.x, lane = tid & 63, w = __builtin_amdgcn_readfirstlane(tid >> 6), r32 = lane & 31, hi = lane >> 5;
    const u16* Q = (const u16*)(a.ws + WS_Q); const u16* Kb = (const u16*)(a.ws + WS_K); const u16* Vb = (const u16*)(a.ws + WS_V); u16* ATT = (u16*)(a.ws + WS_ATT);
    const float* sinks = a.in[16];
    for (int unit = vcu; unit < 512; unit += G) {
        const int kvh = unit & 3, b = unit >> 2;
        for (int p = tid; p < 256 * 8; p += 512) { const int idx = p >> 3, pc = p & 7, t = 128 * (b - 1) + idx;
            if (t >= 0) { const u32x4 kv = *(const u32x4*)(Kb + (size_t)t * KVD + 64 * kvh + 8 * pc), vv = *(const u32x4*)(Vb + (size_t)t * KVD + 64 * kvh + 8 * pc);
                *(LAS u32x4*)(lds + AT_K + idx * AT_KS + pc * 16) = kv; *(LAS u32x4*)(lds + AT_V + idx * AT_KS + pc * 16) = vv; } }
        __syncthreads();
        const int head = 4 * kvh + (w >> 1), qh = w & 1; const float sink2 = sinks[head] * LOG2E;
        for (int qt = 0; qt < 2; ++qt) {
            const int q0 = 64 * qh + 32 * qt, t = 128 * b + q0 + r32;
            bf16x8 qf[4];
#pragma unroll
            for (int s = 0; s < 4; ++s) qf[s] = *(const bf16x8*)(Q + (size_t)t * D + 64 * head + 16 * s + 8 * hi);
            f32x16 o0, o1;
#pragma unroll
            for (int r = 0; r < 16; ++r) { o0[r] = 0.f; o1[r] = 0.f; }
            float mx = sink2, l = 1.0f; const int kt0 = q0 >> 5;
            for (int kk = 0; kk < 5; ++kk) { const int kt = kt0 + kk; if (b == 0 && kt < 4) continue;
                f32x16 sc;
#pragma unroll
                for (int r = 0; r < 16; ++r) sc[r] = 0.f;
#pragma unroll
                for (int s = 0; s < 4; ++s) { const bf16x8 kf = *(const LAS bf16x8*)(lds + AT_K + (32 * kt + r32) * AT_KS + (16 * s + 8 * hi) * 2); sc = __builtin_amdgcn_mfma_f32_32x32x16_bf16(kf, qf[s], sc, 0, 0, 0); }
                const int base = 32 * kt + 4 * hi - (128 + q0 + r32); float mt = -1.0e30f;
#pragma unroll
                for (int r = 0; r < 16; ++r) { const int rel = base + (r & 3) + 8 * (r >> 2); if (!(rel <= 0 && rel > -WIN)) sc[r] = -1.0e30f; mt = fmaxf(mt, sc[r]); }
                mt = fmaxf(mt, __shfl_xor(mt, 32));
                const float mn = fmaxf(mx, mt), al = fexp2(mx - mn); float ps = 0.f;
#pragma unroll
                for (int r = 0; r < 16; ++r) { const float p = fexp2(sc[r] - mn); sc[r] = p; ps += p; }
                ps += __shfl_xor(ps, 32); l = l * al + ps; mx = mn;
#pragma unroll
                for (int r = 0; r < 16; ++r) { o0[r] *= al; o1[r] *= al; }
                u32x4 pa, pb; pa.x = cvt_pk_bf16(sc[0], sc[1]); pa.y = cvt_pk_bf16(sc[2], sc[3]); pa.z = cvt_pk_bf16(sc[4], sc[5]); pa.w = cvt_pk_bf16(sc[6], sc[7]);
                pb.x = cvt_pk_bf16(sc[8], sc[9]); pb.y = cvt_pk_bf16(sc[10], sc[11]); pb.z = cvt_pk_bf16(sc[12], sc[13]); pb.w = cvt_pk_bf16(sc[14], sc[15]);
                const bf16x8 pf0 = __builtin_bit_cast(bf16x8, pa), pf1 = __builtin_bit_cast(bf16x8, pb);
#pragma unroll
                for (int s2 = 0; s2 < 2; ++s2)
#pragma unroll
                    for (int dt = 0; dt < 2; ++dt) {
                        const int va = AT_V + (32 * kt + 16 * s2 + 4 * hi + ((lane & 15) >> 2)) * AT_KS + (32 * dt + 16 * ((lane >> 4) & 1) + 4 * (lane & 3)) * 2;
                        const s16x4 lo = __builtin_bit_cast(s16x4, __builtin_amdgcn_ds_read_tr16_b64_v4i16((LAS s16x4*)(lds + va)));
                        const s16x4 hi4 = __builtin_bit_cast(s16x4, __builtin_amdgcn_ds_read_tr16_b64_v4i16((LAS s16x4*)(lds + va + 8 * AT_KS)));
                        const bf16x8 vf = (bf16x8){lo[0], lo[1], lo[2], lo[3], hi4[0], hi4[1], hi4[2], hi4[3]};
                        if (dt == 0) o0 = __builtin_amdgcn_mfma_f32_32x32x16_bf16(vf, s2 ? pf1 : pf0, o0, 0, 0, 0); else o1 = __builtin_amdgcn_mfma_f32_32x32x16_bf16(vf, s2 ? pf1 : pf0, o1, 0, 0, 0); }
            }
            const float il = 1.0f / l;
#pragma unroll
            for (int g4 = 0; g4 < 4; ++g4) { u32x2 w0, w1;
                w0.x = cvt_pk_bf16(o0[4 * g4] * il, o0[4 * g4 + 1] * il); w0.y = cvt_pk_bf16(o0[4 * g4 + 2] * il, o0[4 * g4 + 3] * il);
                w1.x = cvt_pk_bf16(o1[4 * g4] * il, o1[4 * g4 + 1] * il); w1.y = cvt_pk_bf16(o1[4 * g4 + 2] * il, o1[4 * g4 + 3] * il);
                if (ATTN_FP8) { const float so = il * S8_O; int b0 = 0, b1 = 0;
                    b0 = __builtin_amdgcn_cvt_pk_fp8_f32(o0[4 * g4] * so, o0[4 * g4 + 1] * so, b0, false); b0 = __builtin_amdgcn_cvt_pk_fp8_f32(o0[4 * g4 + 2] * so, o0[4 * g4 + 3] * so, b0, true);
                    b1 = __builtin_amdgcn_cvt_pk_fp8_f32(o1[4 * g4] * so, o1[4 * g4 + 1] * so, b1, false); b1 = __builtin_amdgcn_cvt_pk_fp8_f32(o1[4 * g4 + 2] * so, o1[4 * g4 + 3] * so, b1, true);
                    unsigned char* A8 = (unsigned char*)ATT; *(int*)(A8 + (size_t)t * D + 64 * head + 8 * g4 + 4 * hi) = b0; *(int*)(A8 + (size_t)t * D + 64 * head + 32 + 8 * g4 + 4 * hi) = b1; }
                else { *(u32x2*)(ATT + (size_t)t * D + 64 * head + 8 * g4 + 4 * hi) = w0; *(u32x2*)(ATT + (size_t)t * D + 64 * head + 32 + 8 * g4 + 4 * hi) = w1; } }
        }
        __syncthreads();
    }
}

constexpr int NPHASE = 14;
__global__ void __launch_bounds__(512, 2) mega(Args a) {
    extern __shared__ __attribute__((aligned(16))) unsigned char lds_raw[];
    LAS unsigned char* lds = (LAS unsigned char*)lds_raw;
    const int tid = threadIdx.x, lane = tid & 63, wave = __builtin_amdgcn_readfirstlane(tid >> 6);
    const int G = gridDim.x; const int bx = blockIdx.x; const int vcu = (G % 8 == 0) ? (bx % 8) * (G / 8) + bx / 8 : bx;
    unsigned char* ws = a.ws; unsigned* ctl = (unsigned*)(ws + WS_CTL);
    volatile LAS unsigned* MISC = (volatile LAS unsigned*)(lds + LX_MISC);
    for (int u = tid; u < 112; u += 512) ((LAS unsigned*)(lds + LX_MISC))[u] = 0u;
    __syncthreads();
    const int lo = a.ph_lo, hi = a.ph_hi;
    XcdBarrier bar; bar.bar = ctl + CW_BAR; bar.x = 0; bar.st = nullptr;
    if (hi - lo > 1) bar = xcd_barrier_post(ctl + CW_BAR, MISC + 8);
#define IN(k) (lo <= (k) && (k) < hi)
#ifndef REP_MASK
#define REP_MASK 0
#endif
#define REPS(k) for (int rep_ = 0; rep_ < 1 + ((REP_MASK >> (k)) & 1); ++rep_)
#define SEAM(k) do { if (IN(k) && IN((k) + 1)) xcd_barrier(bar); } while (0)
    float* H = a.out; u16* HB = (u16*)(ws + WS_HB);
    float* SSP0 = (float*)(ws + WS_SSP); float* SSP1 = SSP0 + 65536; float* SSP2 = SSP1 + 65536; float* SSP3 = SSP2 + 65536;
    unsigned* cnt = ctl + CW_CNT; int* list = (int*)(ws + WS_LIST); float* gatew = (float*)(ws + WS_GATEW);
    const int gw = vcu * 8 + wave, NGW = G * 8;

    if (IN(0)) REPS(0) {
        tables_body(a, vcu * 512 + tid, G * 512);
        convert_body(a, (float*)(lds_raw + wave * 16384), gw, NGW, lane);
        rowprep_body(a.in[0], HB, SSP0, gw, NGW, lane);
    }
    SEAM(0);
    if (IN(1)) REPS(1) { pg8::DenseSched S; S.o.init(M / 256, 2048 / 256, G, bx); S.A = (const char*)HB; S.Bt = (const char*)(ws + WS_WIN); S.K = 1024;
        pg8::EpiProj E{SSP0, (u16*)(ws + WS_Y), (u16*)(ws + WS_XB)}; pg8::gemm_phase<pg8::EpiProj, pg8::DenseSched, false>(lds, 1024, S, E); }
    SEAM(1);
    if (IN(2)) REPS(2) lru_phase<false>(a, lds, G, vcu);
    SEAM(2);
    if (IN(3)) REPS(3) lru_phase<true>(a, lds, G, vcu);
    SEAM(3);
    if (IN(4)) REPS(4) { pg8::DenseSched S; S.o.init(M / 256, 4, G, bx); S.A = (const char*)(ws + WS_G); S.Bt = (const char*)(ws + WS_WOUT); S.K = 1024;
        pg8::EpiRes E{a.in[0], HB, nullptr, SSP1, nullptr, 1.0f}; pg8::gemm_phase<pg8::EpiRes, pg8::DenseSched, false>(lds, 1024, S, E); }
    SEAM(4);
    if (IN(5)) REPS(5) { pg8::DenseSched S; S.o.init(M / 256, 7168 / 256, G, bx); S.A = (const char*)HB; S.Bt = (const char*)(ws + WS_WGU); S.K = 1024;
        pg8::EpiGateUp E{SSP1, (u16*)(ws + WS_ACT)}; pg8::gemm_phase<pg8::EpiGateUp, pg8::DenseSched, false>(lds, 1024, S, E); }
    SEAM(5);
    if (IN(6)) { pg8::DenseSched S; S.o.init(M / 256, 4, G, bx); S.A = (const char*)(ws + WS_ACT); S.Bt = (const char*)(ws + WS_WD); S.K = DFF;
        pg8::EpiRes E{nullptr, HB, nullptr, SSP2, ATTN_FP8 ? (unsigned char*)(ws + WS_HB8) : nullptr, 1.0f}; pg8::gemm_phase<pg8::EpiRes, pg8::DenseSched, false>(lds, DFF, S, E); }
    SEAM(6);
    if (IN(7)) REPS(7) { pg8::DenseSched S; S.o.init(M / 256, NQKV / 256, G, bx); S.A = ATTN_FP8 ? (const char*)(ws + WS_HB8) : (const char*)HB; S.Bt = (const char*)(ws + WS_WQKV); S.K = ATTN_FP8 ? 512 : 1024;
        pg8::EpiQKV E{SSP2, a.in[15], (const u16*)(ws + WS_ROPE), (u16*)(ws + WS_Q), (u16*)(ws + WS_K), (u16*)(ws + WS_V), ATTN_FP8 ? 1.0f / (S8_A * S8_W) : 1.0f}; pg8::gemm_phase<pg8::EpiQKV, pg8::DenseSched, false, ATTN_FP8 != 0>(lds, ATTN_FP8 ? 512 : 1024, S, E); }
    SEAM(7);
    if (IN(8)) REPS(8) attn_phase(a, lds, G, vcu);
    SEAM(8);
    if (IN(9)) { pg8::DenseSched S; S.o.init(M / 256, 4, G, bx); S.A = (const char*)(ws + WS_ATT); S.Bt = (const char*)(ws + WS_WO); S.K = ATTN_FP8 ? 512 : 1024;
        pg8::EpiRes E{nullptr, HB, a.in[18], SSP3, MOE_FP8 ? (unsigned char*)(ws + WS_HB8) : nullptr, ATTN_FP8 ? 1.0f / (S8_O * S8_W) : 1.0f}; pg8::gemm_phase<pg8::EpiRes, pg8::DenseSched, false, ATTN_FP8 != 0>(lds, ATTN_FP8 ? 512 : 1024, S, E); }
    SEAM(9);
    if (IN(10)) { for (int g = vcu; g < M / 64; g += G) router_group(HB, (const float*)(ws + WS_WR), SSP3, cnt, list, gatew, g, (float*)(lds_raw + LX_ROUT)); }
    SEAM(10);
    LAS int* tbl = (LAS int*)(lds + LX_TBL);
    if (IN(11) || IN(12)) { if (tid == 0) { int acc = 0; for (int e = 0; e < 8; ++e) { const int c = (int)__hip_atomic_load(cnt + e, __ATOMIC_RELAXED, __HIP_MEMORY_SCOPE_AGENT); tbl[e] = c; tbl[8 + e] = acc; acc += (c + 255) >> 8; } tbl[16] = acc; } __syncthreads(); }
    if (IN(11)) REPS(11) { pg8::MoeSched S; S.o.init(__builtin_amdgcn_readfirstlane(tbl[16]), 7168 / 256, G, bx); S.A = MOE_FP8 ? (const char*)(ws + WS_HB8) : (const char*)HB; S.Bt = (const char*)(ws + WS_WGU2); S.K = MOE_FP8 ? 512 : 1024; S.bstride = (size_t)7168 * 1024 * (MOE_FP8 ? 1 : 2); S.list = list; S.tbl = tbl;
        pg8::EpiMoeUp E{SSP3, list, gatew, tbl, (u16*)(ws + WS_ACT2)}; pg8::gemm_phase<pg8::EpiMoeUp, pg8::MoeSched, true, MOE_FP8 != 0>(lds, MOE_FP8 ? 512 : 1024, S, E); }
    SEAM(11);
    if (IN(12)) REPS(12) { pg8::MoeSched S; S.o.init(__builtin_amdgcn_readfirstlane(tbl[16]), 4, G, bx); S.A = (const char*)(ws + WS_ACT2); S.Bt = (const char*)(ws + WS_WD2); S.K = MOE_FP8 ? DFF / 2 : DFF; S.bstride = (size_t)1024 * DFF * (MOE_FP8 ? 1 : 2); S.list = nullptr; S.tbl = tbl;
        pg8::EpiMoeDown E{list, tbl, (u16*)(ws + WS_MO)}; pg8::gemm_phase<pg8::EpiMoeDown, pg8::MoeSched, false, MOE_FP8 != 0>(lds, MOE_FP8 ? DFF / 2 : DFF, S, E); }
    SEAM(12);
    if (IN(13)) final_body(H, HB, (const u16*)(ws + WS_MO), a.in[4], gw, NGW, lane);
#undef IN
#undef SEAM
}
#ifndef MK_MODE
#define MK_MODE 1
#endif
#ifndef FASTMASK
#define FASTMASK 0x3fff
#endif
extern "C" void kernel_launch(void* const* d_in, const int* in_sizes, int n_in, void* d_out, int out_size, void* d_ws, size_t ws_size, hipStream_t stream) {
    if (n_in != 26 || out_size != M * D || ws_size < WS_END) { fprintf(stderr, "kernel_launch: unexpected shapes (n_in %d out %d ws %zu, need %zu)\n", n_in, out_size, ws_size, (size_t)WS_END); return; }
    static int grid = 0;
    if (grid == 0) {
        int dev = 0, cus = 0, per_cu = 0;
        if (hipGetDevice(&dev) != hipSuccess || hipDeviceGetAttribute(&cus, hipDeviceAttributeMultiprocessorCount, dev) != hipSuccess) { grid = -1; return; }
        if (hipFuncSetAttribute((const void*)mega, hipFuncAttributeMaxDynamicSharedMemorySize, LDS_BYTES) != hipSuccess) { fprintf(stderr, "kernel_launch: hipFuncSetAttribute failed\n"); grid = -1; return; }
        if (hipOccupancyMaxActiveBlocksPerMultiprocessor(&per_cu, (const void*)mega, 512, LDS_BYTES) != hipSuccess || per_cu < 1) { fprintf(stderr, "kernel_launch: occupancy query says %d\n", per_cu); per_cu = 1; }
        (void)hipGetLastError();
        grid = cus;
    }
    if (grid < 0) return;
    unsigned char* ws = (unsigned char*)d_ws;
    (void)hipMemsetAsync(ws + WS_CTL, 0, CTL_BYTES, stream);
    Args a{};
    for (int i = 0; i < 26; ++i) a.in[i] = (const float*)d_in[i];
    a.pos = (const int*)d_in[1]; a.out = (float*)d_out; a.ws = ws; a.ph_lo = 0; a.ph_hi = NPHASE;
#if MK_MODE == 1
    hipLaunchKernelGGL(mega, dim3(grid), dim3(512), LDS_BYTES, stream, a);
#else
    float* H = (float*)d_out; u16* HB = (u16*)(ws + WS_HB);
    float* SSP0 = (float*)(ws + WS_SSP), *SSP1 = SSP0 + 65536, *SSP2 = SSP1 + 65536, *SSP3 = SSP2 + 65536;
    const unsigned* cnt = (const unsigned*)(ws + WS_CTL) + CW_CNT; const int* list = (const int*)(ws + WS_LIST); const float* gatew = (const float*)(ws + WS_GATEW);
    for (int p = 0; p < NPHASE; ++p) {
        if ((FASTMASK >> p) & 1) { a.ph_lo = p; a.ph_hi = p + 1; hipLaunchKernelGGL(mega, dim3(grid), dim3(512), LDS_BYTES, stream, a); continue; }
        switch (p) {
        case 0: k_tables<<<256, 256, 0, stream>>>(a); k_convert<<<2048, 256, 0, stream>>>(a); k_rowprep<<<1024, 256, 0, stream>>>(a.in[0], HB, SSP0); break;
        case 1: { NE_Proj e{HB, (const u16*)(ws + WS_WIN), SSP0, (u16*)(ws + WS_Y), (u16*)(ws + WS_XB)}; k_ngemm<<<dim3(2048 / 64, M / 64), 256, 0, stream>>>(e, 1024); } break;
        case 2: k_conv1d<<<(M * D) / 256, 256, 0, stream>>>((const u16*)(ws + WS_XB), a.in[6], a.in[7], (u16*)(ws + WS_XC));
                { NE_Gates e{(const u16*)(ws + WS_XC), (const u16*)(ws + WS_WAX), a.in[9], a.in[11], (const float*)(ws + WS_SPL), (float*)d_out, (float*)(ws + WS_BX)}; k_ngemm<<<dim3(128 / 64, M / 64, 8), 256, 0, stream>>>(e, 128); } break;
        case 3: k_scan_seq<<<16, 64, 0, stream>>>((const float*)d_out, (const float*)(ws + WS_BX), (const u16*)(ws + WS_Y), (u16*)(ws + WS_G)); break;
        case 4: { NE_Res e{(const u16*)(ws + WS_G), (const u16*)(ws + WS_WOUT), 1024, a.in[0], H, HB, nullptr}; k_ngemm<<<dim3(1024 / 64, M / 64), 256, 0, stream>>>(e, 1024); } k_ssp<<<1024, 256, 0, stream>>>(H, SSP1); break;
        case 5: { NE_GateUp e{HB, (const u16*)(ws + WS_WGU), SSP1, (u16*)(ws + WS_ACT)}; k_ngemm<<<dim3(DFF / 64, M / 64), 256, 0, stream>>>(e, 1024); } break;
        case 6: { NE_Res e{(const u16*)(ws + WS_ACT), (const u16*)(ws + WS_WD), DFF, nullptr, H, HB, nullptr}; k_ngemm<<<dim3(1024 / 64, M / 64), 256, 0, stream>>>(e, DFF); } k_ssp<<<1024, 256, 0, stream>>>(H, SSP2); break;
        case 7: { NE_QKV e{HB, (const u16*)(ws + WS_WQKV), SSP2, a.in[15], (const u16*)(ws + WS_ROPE), (u16*)(ws + WS_Q), (u16*)(ws + WS_K), (u16*)(ws + WS_V)}; k_ngemm<<<dim3(NQKV / 64, M / 64), 256, 0, stream>>>(e, 1024); } break;
        case 8: k_attn_ref<<<(M * NH) / 64, 64, 0, stream>>>((const u16*)(ws + WS_Q), (const u16*)(ws + WS_K), (const u16*)(ws + WS_V), a.in[16], (u16*)(ws + WS_ATT)); break;
        case 9: { NE_Res e{(const u16*)(ws + WS_ATT), (const u16*)(ws + WS_WO), 1024, nullptr, H, HB, a.in[18]}; k_ngemm<<<dim3(1024 / 64, M / 64), 256, 0, stream>>>(e, 1024); } k_ssp<<<1024, 256, 0, stream>>>(H, SSP3); break;
        case 10: k_router<<<256, 512, 0, stream>>>(a); break;
        case 11: { NE_MoeUp e{HB, (const u16*)(ws + WS_WGU2), SSP3, cnt, list, gatew, (u16*)(ws + WS_ACT2)}; k_ngemm<<<dim3(DFF / 64, MAXSLOT / 64), 256, 0, stream>>>(e, 1024); } break;
        case 12: { NE_MoeDown e{(const u16*)(ws + WS_ACT2), (const u16*)(ws + WS_WD2), cnt, list, (u16*)(ws + WS_MO)}; k_ngemm<<<dim3(1024 / 64, MAXSLOT / 64), 256, 0, stream>>>(e, DFF); } break;
        case 13: k_final<<<1024, 256, 0, stream>>>(H, HB, (const u16*)(ws + WS_MO), a.in[4]); break;
        }
    }
#endif
}
```

```cpp
#include <hip/hip_runtime.h>
#include <stdint.h>
#include <stdio.h>

typedef unsigned short u16;
typedef short bf16x8 __attribute__((ext_vector_type(8)));
typedef float f32x4 __attribute__((ext_vector_type(4)));
typedef unsigned u32x4 __attribute__((ext_vector_type(4)));
typedef unsigned u32x2 __attribute__((ext_vector_type(2)));

constexpr int M = 16384, D = 1024, DFF = 3584, NE = 8, NBLK = 8, RB = 128;
constexpr int NH = 16, NKV = 4, HD = 64, KVD = 256, NQKV = 1536, WIN = 128;
constexpr int MAXSLOT = 34816;
constexpr float EPS = 1e-6f;
#ifndef MOE_FP8
#define MOE_FP8 1
#endif
constexpr float S8_A = 16.0f, S8_W = 256.0f, S8_ACT = 8.0f, S8_WD = 512.0f;
#ifndef ATTN_FP8
#define ATTN_FP8 1
#endif
constexpr float S8_O = 32.0f;
constexpr float LOG2E = 1.4426950408889634f;

constexpr size_t MiB = 1u << 20;
constexpr size_t WS_CTL = 0, CTL_BYTES = 1 * MiB;
constexpr size_t WS_ROPE = 1 * MiB;
constexpr size_t WS_SSP = 2 * MiB;
constexpr size_t WS_SPL = 3 * MiB;
constexpr size_t WS_WR = 3 * MiB + 64 * 1024;
constexpr size_t WS_CAR = 3 * MiB + 128 * 1024;
constexpr size_t WS_LIST = 4 * MiB;
constexpr size_t WS_GATEW = WS_LIST;
constexpr size_t WS_WGU2 = 6 * MiB;
constexpr size_t WS_HB8 = 70 * MiB;
constexpr size_t WS_WD2 = 118 * MiB;
constexpr size_t WS_HB = 174 * MiB;
constexpr size_t WS_X = 206 * MiB;
constexpr size_t WS_WIN = WS_X;
constexpr size_t WS_WAX = WS_X + 4 * MiB;
constexpr size_t WS_WOUT = WS_X + 5 * MiB;
constexpr size_t WS_WGU = WS_X + 7 * MiB;
constexpr size_t WS_WD = WS_X + 21 * MiB;
constexpr size_t WS_WQKV = WS_X + 28 * MiB;
constexpr size_t WS_WO = WS_X + 31 * MiB;
constexpr size_t WS_Y = WS_X + 33 * MiB;
constexpr size_t WS_XB = WS_Y + 32 * MiB;
constexpr size_t WS_G = WS_XB + 32 * MiB;
constexpr size_t WS_ACT = WS_G + 32 * MiB;
constexpr size_t WS_XC = WS_ACT;
constexpr size_t WS_BX = WS_ACT + 32 * MiB;
constexpr size_t WS_Q = WS_Y;
constexpr size_t WS_K = WS_Y + 32 * MiB;
constexpr size_t WS_V = WS_K + 8 * MiB;
constexpr size_t WS_ATT = WS_V + 8 * MiB;
constexpr size_t WS_ACT2 = WS_X;
constexpr size_t WS_MO = WS_WGU2;
constexpr size_t WS_END = 447 * MiB;
static_assert(WS_ACT + (size_t)M * DFF * 2 <= WS_END && WS_ACT2 + (size_t)MAXSLOT * DFF * 2 <= WS_END, "ws map");
constexpr int CW_CNT = 64;

__device__ __forceinline__ unsigned f2bf(float f) { unsigned u = __builtin_bit_cast(unsigned, f); return (u + 0x7fffu + ((u >> 16) & 1u)) >> 16; }
__device__ __forceinline__ float bf2f(unsigned b) { return __builtin_bit_cast(float, b << 16); }
__device__ __forceinline__ float u2f(unsigned b) { return __builtin_bit_cast(float, b); }
__device__ __forceinline__ unsigned pk2(float lo, float hi) { return f2bf(lo) | (f2bf(hi) << 16); }
__device__ __forceinline__ float wave_sum(float v) {
#pragma unroll
    for (int o = 1; o < 64; o <<= 1) v += __shfl_xor(v, o);
    return v;
}
__device__ __forceinline__ float sigmoidf_(float x) { return 1.0f / (1.0f + __expf(-x)); }
__device__ __forceinline__ float gelu_tanh(float x) { const float z = 0.7978845608028654f * (x + 0.044715f * x * x * x); return x / (1.0f + __expf(-2.0f * z)); }
__device__ __forceinline__ float silu_(float x) { return x / (1.0f + __expf(-x)); }
__device__ __forceinline__ float one_minus_exp(float x) {
    if (x > -0.3f) { float p = 1.0f / 720.0f; p = p * x + 1.0f / 120.0f; p = p * x + 1.0f / 24.0f; p = p * x + 1.0f / 6.0f; p = p * x + 0.5f; p = p * x + 1.0f; return -x * p; }
    return 1.0f - __expf(x);
}
__device__ __forceinline__ float rstd_of(const float* ssp, int row) { const f32x4 p = *(const f32x4*)(ssp + 4 * (size_t)row); return rsqrtf(((p[0] + p[1]) + (p[2] + p[3])) * (1.0f / D) + EPS); }

struct Args {
    const float* in[26]; const int* pos; float* out; unsigned char* ws; int ph_lo, ph_hi;
};

__device__ __forceinline__ void tables_body(const Args& a, int gt, int NT) {
    u16* rope = (u16*)(a.ws + WS_ROPE);
    for (int i = gt; i < M * 8; i += NT) { const int t = i >> 3, f = i & 7;
        const double inv = f == 0 ? 1.0 : f == 1 ? 0.19392274474868576 : f == 2 ? 0.03760603093086393 : f == 3 ? 0.007292664737217109 : f == 4 ? 0.001414213562373095 : f == 5 ? 0.0002742481756762073 : f == 6 ? 5.318295896944988e-05 : 1.031338537721246e-05;
        const double ang = (double)a.pos[t] * inv; const double kq = __builtin_rint(ang * 0.6366197723675814); const double r = ang - kq * 1.5707963267948966, r2 = r * r;
        double s = -1.0 / 39916800.0; s = s * r2 + 1.0 / 362880.0; s = s * r2 - 1.0 / 5040.0; s = s * r2 + 1.0 / 120.0; s = s * r2 - 1.0 / 6.0; s = s * r2 + 1.0; s *= r;
        double c = 1.0 / 479001600.0; c = c * r2 - 1.0 / 3628800.0; c = c * r2 + 1.0 / 40320.0; c = c * r2 - 1.0 / 720.0; c = c * r2 + 1.0 / 24.0; c = c * r2 - 0.5; c = c * r2 + 1.0;
        const int q = (int)((long long)kq & 3); const double cs = q == 0 ? c : q == 1 ? -s : q == 2 ? -c : s, sn = q == 0 ? s : q == 1 ? c : q == 2 ? -s : -c;
        rope[t * 16 + f] = (u16)f2bf((float)cs); rope[t * 16 + 8 + f] = (u16)f2bf((float)sn); }
    float* spl = (float*)(a.ws + WS_SPL);
    for (int i = gt; i < 1024; i += NT) { const float z = __expf(-a.in[12][i]);
        float p = 0.2f; p = p * z - 0.25f; p = p * z + 1.0f / 3.0f; p = p * z - 0.5f; p = p * z + 1.0f; spl[i] = z < 0.05f ? z * p : __logf(1.0f + z); }
    float* wr = (float*)(a.ws + WS_WR);
    for (int i = gt; i < 8 * 1024; i += NT) { const int e = i >> 10, k = i & 1023; wr[i] = a.in[3][1024 + k] * a.in[22][k * 8 + e]; }
}
__global__ void k_tables(Args a) { tables_body(a, blockIdx.x * blockDim.x + threadIdx.x, gridDim.x * blockDim.x); }

struct ConvJob { const float* W; const float* g; u16* WT; int K, N, mode, row_off; float s8; };
__device__ __forceinline__ bool conv_job(const Args& a, int j, ConvJob& c) {
    unsigned char* ws = a.ws;
    c.g = nullptr; c.mode = 0; c.row_off = 0; c.s8 = 0.f;
    if (j == 0) { c.W = a.in[5]; c.g = a.in[2]; c.WT = (u16*)(ws + WS_WIN); c.K = 1024; c.N = 2048; return true; }
    if (j == 1) { c.W = a.in[13]; c.WT = (u16*)(ws + WS_WOUT); c.K = 1024; c.N = 1024; return true; }
    if (j == 2) { c.W = a.in[19]; c.g = a.in[3]; c.WT = (u16*)(ws + WS_WGU); c.K = 1024; c.N = DFF; c.mode = 1; return true; }
    if (j == 3) { c.W = a.in[20]; c.g = a.in[3]; c.WT = (u16*)(ws + WS_WGU); c.K = 1024; c.N = DFF; c.mode = 2; return true; }
    if (j == 4) { c.W = a.in[21]; c.WT = (u16*)(ws + WS_WD); c.K = DFF; c.N = 1024; return true; }
    if (j == 5) { c.W = a.in[14]; c.g = a.in[2] + 1024; c.WT = (u16*)(ws + WS_WQKV); c.K = 1024; c.N = NQKV; c.s8 = ATTN_FP8 ? S8_W : 0.f; return true; }
    if (j == 6) { c.W = a.in[17]; c.WT = (u16*)(ws + WS_WO); c.K = 1024; c.N = 1024; c.s8 = ATTN_FP8 ? S8_W : 0.f; return true; }
    j -= 7;
    if (j < 16) { const int n = j >> 1, x = j & 1; c.W = a.in[x ? 10 : 8] + (size_t)n * 128 * 128; c.WT = (u16*)(ws + WS_WAX) + (size_t)n * 256 * 128; c.K = 128; c.N = 128; c.row_off = x * 128; return true; }
    j -= 16;
    if (j < 16) { const int e = j >> 1, x = j & 1; c.W = a.in[x ? 24 : 23] + (size_t)e * 1024 * DFF; c.g = a.in[3] + 1024; c.WT = (u16*)(ws + WS_WGU2 + (size_t)e * 7168 * 1024 * (MOE_FP8 ? 1 : 2)); c.K = 1024; c.N = DFF; c.mode = 1 + x; c.s8 = MOE_FP8 ? S8_W : 0.f; return true; }
    j -= 16;
    if (j < 8) { c.W = a.in[25] + (size_t)j * DFF * 1024; c.WT = (u16*)(ws + WS_WD2 + (size_t)j * 1024 * DFF * (MOE_FP8 ? 1 : 2)); c.K = DFF; c.N = 1024; c.s8 = MOE_FP8 ? S8_WD : 0.f; return true; }
    return false;
}
constexpr int NJOBS = 7 + 16 + 16 + 8;
__device__ __forceinline__ void conv_item(const ConvJob& c, float*, int item, int lane) {
    const int nblk = c.N / 64, kb = item / nblk, nb = item % nblk, r4 = lane >> 4, cc = lane & 15, k0 = 64 * kb + 16 * r4, n0 = 64 * nb + 4 * cc;
    f32x4 v[16];
    const float* src = c.W + (size_t)k0 * c.N + n0;
#pragma unroll
    for (int i = 0; i < 16; ++i) v[i] = *(const f32x4*)(src + (size_t)i * c.N);
    if (c.g) { const f32x4 g0 = *(const f32x4*)(c.g + k0), g1 = *(const f32x4*)(c.g + k0 + 4), g2 = *(const f32x4*)(c.g + k0 + 8), g3 = *(const f32x4*)(c.g + k0 + 12);
#pragma unroll
        for (int i = 0; i < 4; ++i) { v[i] = v[i] * g0[i]; v[4 + i] = v[4 + i] * g1[i]; v[8 + i] = v[8 + i] * g2[i]; v[12 + i] = v[12 + i] * g3[i]; } }
    if (c.s8 != 0.f) {
#pragma unroll
        for (int j = 0; j < 4; ++j) { const int nn = n0 + j; const int r = c.mode == 0 ? c.row_off + nn : 256 * (nn >> 7) + (nn & 127) + (c.mode == 2 ? 128 : 0);
            u32x4 o;
#pragma unroll
            for (int q = 0; q < 4; ++q) { int w = 0; w = __builtin_amdgcn_cvt_pk_fp8_f32(v[4 * q][j] * c.s8, v[4 * q + 1][j] * c.s8, w, false); w = __builtin_amdgcn_cvt_pk_fp8_f32(v[4 * q + 2][j] * c.s8, v[4 * q + 3][j] * c.s8, w, true); o[q] = (unsigned)w; }
            *(u32x4*)((unsigned char*)c.WT + (size_t)r * c.K + k0) = o; }
        return; }
#pragma unroll
    for (int j = 0; j < 4; ++j) { const int nn = n0 + j; const int r = c.mode == 0 ? c.row_off + nn : 256 * (nn >> 7) + (nn & 127) + (c.mode == 2 ? 128 : 0);
        u32x4 o0, o1; o0.x = pk2(v[0][j], v[1][j]); o0.y = pk2(v[2][j], v[3][j]); o0.z = pk2(v[4][j], v[5][j]); o0.w = pk2(v[6][j], v[7][j]);
        o1.x = pk2(v[8][j], v[9][j]); o1.y = pk2(v[10][j], v[11][j]); o1.z = pk2(v[12][j], v[13][j]); o1.w = pk2(v[14][j], v[15][j]);
        u32x4* dst = (u32x4*)(c.WT + (size_t)r * c.K + k0); dst[0] = o0; dst[1] = o1; }
}
__device__ __forceinline__ void convert_body(const Args& a, float* scr, int gw, int NGW, int lane) {
    int base = 0;
    for (int j = 0; j < NJOBS; ++j) { ConvJob c; if (!conv_job(a, j, c)) break; const int items = (c.K / 64) * (c.N / 64);
        int first = (gw - base) % NGW; if (first < 0) first += NGW;
        for (int it = first; it < items; it += NGW) conv_item(c, scr, it, lane);
        base = (base + items) % NGW; }
}
__global__ __launch_bounds__(256) void k_convert(Args a) {
    __shared__ float scr_all[4][64 * 33];
    const int lane = threadIdx.x & 63, w = threadIdx.x >> 6;
    convert_body(a, scr_all[w], blockIdx.x * 4 + w, gridDim.x * 4, lane);
}

__device__ __forceinline__ void rowprep_body(const float* x, u16* hb, float* ssp, int gw, int NGW, int lane) {
    for (int r = gw; r < M; r += NGW) {
        const f32x4* xr = (const f32x4*)(x + (size_t)r * D) + lane * 4; float s = 0.f; u32x4 o0, o1;
        f32x4 v0 = xr[0], v1 = xr[1], v2 = xr[2], v3 = xr[3];
        s = (v0[0] * v0[0] + v0[1] * v0[1]) + (v0[2] * v0[2] + v0[3] * v0[3]) + (v1[0] * v1[0] + v1[1] * v1[1]) + (v1[2] * v1[2] + v1[3] * v1[3])
          + (v2[0] * v2[0] + v2[1] * v2[1]) + (v2[2] * v2[2] + v2[3] * v2[3]) + (v3[0] * v3[0] + v3[1] * v3[1]) + (v3[2] * v3[2] + v3[3] * v3[3]);
        o0.x = pk2(v0[0], v0[1]); o0.y = pk2(v0[2], v0[3]); o0.z = pk2(v1[0], v1[1]); o0.w = pk2(v1[2], v1[3]);
        o1.x = pk2(v2[0], v2[1]); o1.y = pk2(v2[2], v2[3]); o1.z = pk2(v3[0], v3[1]); o1.w = pk2(v3[2], v3[3]);
        u32x4* orow = (u32x4*)(hb + (size_t)r * D) + lane * 2; orow[0] = o0; orow[1] = o1;
        s += __shfl_xor(s, 1); s += __shfl_xor(s, 2); s += __shfl_xor(s, 4); s += __shfl_xor(s, 8);
        if ((lane & 15) == 0) ssp[4 * (size_t)r + (lane >> 4)] = s;
    }
}
__global__ __launch_bounds__(256) void k_rowprep(const float* x, u16* hb, float* ssp) { rowprep_body(x, hb, ssp, blockIdx.x * 4 + (threadIdx.x >> 6), gridDim.x * 4, threadIdx.x & 63); }
__global__ __launch_bounds__(256) void k_ssp(const float* h, float* ssp) {
    const int lane = threadIdx.x & 63, gw = blockIdx.x * 4 + (threadIdx.x >> 6), NGW = gridDim.x * 4;
    for (int r = gw; r < M; r += NGW) {
        const f32x4* xr = (const f32x4*)(h + (size_t)r * D) + lane * 4; float s = 0.f;
#pragma unroll
        for (int j = 0; j < 4; ++j) { const f32x4 v = xr[j]; s += (v[0] * v[0] + v[1] * v[1]) + (v[2] * v[2] + v[3] * v[3]); }
        s += __shfl_xor(s, 1); s += __shfl_xor(s, 2); s += __shfl_xor(s, 4); s += __shfl_xor(s, 8);
        if ((lane & 15) == 0) ssp[4 * (size_t)r + (lane >> 4)] = s;
    }
}

__device__ __forceinline__ void slot_info(const unsigned* cnt, int slot, int& e, int& pos, int& n) {
    int base = 0; e = -1; pos = 0; n = 0;
#pragma unroll
    for (int i = 0; i < NE; ++i) { const int c = (int)cnt[i], rows = ((c + 255) >> 8) << 8; if (e < 0 && slot < base + rows) { e = i; pos = slot - base; n = c; } base += rows; }
}

template <class E> __global__ __launch_bounds__(256) void k_ngemm(E e, int K) {
    const int lane = threadIdx.x & 63, w = threadIdx.x >> 6, fr = lane & 15, fq = lane >> 4;
    const int rb = blockIdx.y * 64, r0 = rb + (w >> 1) * 32, c0 = blockIdx.x * 64 + (w & 1) * 32;
    if (!e.tile_ok(rb)) return;
    constexpr int NP = E::PAIR ? 2 : 1;
    const u16* ap[2]; const u16* bp[2][NP];
#pragma unroll
    for (int i = 0; i < 2; ++i) ap[i] = e.a_row(r0 + 16 * i + fr) + 8 * fq;
#pragma unroll
    for (int j = 0; j < 2; ++j)
#pragma unroll
        for (int p = 0; p < NP; ++p) bp[j][p] = e.b_row(c0 + 16 * j + fr, p, rb) + 8 * fq;
    f32x4 acc[2][2][NP];
#pragma unroll
    for (int i = 0; i < 2; ++i)
#pragma unroll
        for (int j = 0; j < 2; ++j)
#pragma unroll
            for (int p = 0; p < NP; ++p) acc[i][j][p] = (f32x4){0.f, 0.f, 0.f, 0.f};
    for (int k = 0; k < K; k += 32) {
        bf16x8 av[2], bv[2][NP];
#pragma unroll
        for (int i = 0; i < 2; ++i) av[i] = *(const bf16x8*)(ap[i] + k);
#pragma unroll
        for (int j = 0; j < 2; ++j)
#pragma unroll
            for (int p = 0; p < NP; ++p) bv[j][p] = *(const bf16x8*)(bp[j][p] + k);
#pragma unroll
        for (int i = 0; i < 2; ++i)
#pragma unroll
            for (int j = 0; j < 2; ++j)
#pragma unroll
                for (int p = 0; p < NP; ++p) acc[i][j][p] = __builtin_amdgcn_mfma_f32_16x16x32_bf16(av[i], bv[j][p], acc[i][j][p], 0, 0, 0);
    }
#pragma unroll
    for (int i = 0; i < 2; ++i)
#pragma unroll
        for (int j = 0; j < 2; ++j)
#pragma unroll
            for (int q = 0; q < 4; ++q) { const float v0 = acc[i][j][0][q], v1 = E::PAIR ? acc[i][j][NP - 1][q] : 0.f; const float pv = __shfl_xor(v0, 8);
                e.store(r0 + 16 * i + 4 * fq + q, c0 + 16 * j + fr, v0, v1, pv); }
}

struct NE_Proj {
    static constexpr bool PAIR = false;
    const u16* A; const u16* Bt; const float* ssp; u16* Y; u16* XB;
    __device__ bool tile_ok(int) const { return true; }
    __device__ const u16* a_row(int r) const { return A + (size_t)r * D; }
    __device__ const u16* b_row(int c, int, int) const { return Bt + (size_t)c * D; }
    __device__ void store(int r, int c, float v, float, float) const { v *= rstd_of(ssp, r); if (c < 1024) Y[(size_t)r * D + c] = (u16)f2bf(gelu_tanh(v)); else XB[(size_t)r * D + c - 1024] = (u16)f2bf(v); }
};
struct NE_Gates {
    static constexpr bool PAIR = true;
    const u16* XC; const u16* WAX; const float* b_a; const float* b_x; const float* spl; float* LA; float* BX;
    __device__ bool tile_ok(int) const { return true; }
    __device__ const u16* a_row(int r) const { return XC + (size_t)r * D + 128 * blockIdx.z; }
    __device__ const u16* b_row(int c, int p, int) const { return WAX + ((size_t)blockIdx.z * 256 + c + 128 * p) * 128; }
    __device__ void store(int r, int c, float vr, float vi, float) const { const int ch = 128 * blockIdx.z + c;
        const float rg = sigmoidf_(vr + b_a[ch]), ig = sigmoidf_(vi + b_x[ch]), la = -8.0f * rg * spl[ch], xc = bf2f(XC[(size_t)r * D + ch]);
        LA[(size_t)r * D + ch] = la; BX[(size_t)r * D + ch] = sqrtf(one_minus_exp(2.0f * la)) * (ig * xc); }
};
struct NE_Res {
    static constexpr bool PAIR = false;
    const u16* A; const u16* Bt; int K; const float* Hin; float* Hout; u16* HB; const float* bias;
    __device__ bool tile_ok(int) const { return true; }
    __device__ const u16* a_row(int r) const { return A + (size_t)r * K; }
    __device__ const u16* b_row(int c, int, int) const { return Bt + (size_t)c * K; }
    __device__ void store(int r, int c, float v, float, float) const { const float h = (Hin ? Hin[(size_t)r * D + c] : bf2f(HB[(size_t)r * D + c])) + v + (bias ? bias[c] : 0.f); Hout[(size_t)r * D + c] = h; HB[(size_t)r * D + c] = (u16)f2bf(h); }
};
struct NE_GateUp {
    static constexpr bool PAIR = true;
    const u16* A; const u16* Bt; const float* ssp; u16* ACT;
    __device__ bool tile_ok(int) const { return true; }
    __device__ const u16* a_row(int r) const { return A + (size_t)r * D; }
    __device__ const u16* b_row(int c, int p, int) const { return Bt + (size_t)(256 * (c >> 7) + (c & 127) + 128 * p) * D; }
    __device__ void store(int r, int c, float g, float u, float) const { const float rs = rstd_of(ssp, r); ACT[(size_t)r * DFF + c] = (u16)f2bf(silu_(rs * g) * (rs * u)); }
};
struct NE_QKV {
    static constexpr bool PAIR = false;
    const u16* A; const u16* Bt; const float* ssp; const float* bias; const u16* rope; u16* Q; u16* Kb; u16* Vb;
    __device__ bool tile_ok(int) const { return true; }
    __device__ const u16* a_row(int r) const { return A + (size_t)r * D; }
    __device__ const u16* b_row(int c, int, int) const { return Bt + (size_t)c * D; }
    __device__ void store(int r, int c, float v, float, float pv) const {
        const float rs = rstd_of(ssp, r); v = rs * v + bias[c]; pv = rs * pv + bias[c ^ 8];
        const int d = c & 63;
        if (c < 1280 && d < 16) { const float cs = bf2f(rope[(size_t)r * 16 + (d & 7)]), sn = bf2f(rope[(size_t)r * 16 + 8 + (d & 7)]); v = d < 8 ? v * cs - pv * sn : v * cs + pv * sn; }
        if (c < 1024) Q[(size_t)r * D + c] = (u16)f2bf(v * (0.125f * LOG2E));
        else if (c < 1280) Kb[(size_t)r * KVD + c - 1024] = (u16)f2bf(v);
        else Vb[(size_t)r * KVD + c - 1280] = (u16)f2bf(v);
    }
};
struct NE_MoeUp {
    static constexpr bool PAIR = true;
    const u16* HB; const u16* WGU2; const float* ssp; const unsigned* cnt; const int* list; const float* gatew; u16* ACT2;
    __device__ bool tile_ok(int rb) const { int e, pos, n; slot_info(cnt, rb, e, pos, n); return e >= 0; }
    __device__ const u16* a_row(int r) const { int e, pos, n; slot_info(cnt, r, e, pos, n); const int tok = (e >= 0 && pos < n) ? (list[((size_t)e * M + pos) * 4] >> 1) : 0; return HB + (size_t)tok * D; }
    __device__ const u16* b_row(int c, int p, int rb) const { int e, pos, n; slot_info(cnt, rb, e, pos, n); return WGU2 + ((size_t)e * 7168 + 256 * (c >> 7) + (c & 127) + 128 * p) * D; }
    __device__ void store(int r, int c, float g, float u, float) const { int e, pos, n; slot_info(cnt, r, e, pos, n); float o = 0.f;
        if (e >= 0 && pos < n) { const int tok = list[((size_t)e * M + pos) * 4] >> 1; const float rs = rstd_of(ssp, tok); o = silu_(rs * g) * (rs * u) * gatew[((size_t)e * M + pos) * 4 + 1]; }
        ACT2[(size_t)r * DFF + c] = (u16)f2bf(o); }
};
struct NE_MoeDown {
    static constexpr bool PAIR = false;
    const u16* ACT2; const u16* WD2; const unsigned* cnt; const int* list; u16* MO;
    __device__ bool tile_ok(int rb) const { int e, pos, n; slot_info(cnt, rb, e, pos, n); return e >= 0; }
    __device__ const u16* a_row(int r) const { return ACT2 + (size_t)r * DFF; }
    __device__ const u16* b_row(int c, int, int rb) const { int e, pos, n; slot_info(cnt, rb, e, pos, n); return WD2 + ((size_t)e * 1024 + c) * DFF; }
    __device__ void store(int r, int c, float v, float, float) const { int e, pos, n; slot_info(cnt, r, e, pos, n);
        if (e >= 0 && pos < n) { const int tk = list[((size_t)e * M + pos) * 4]; MO[((size_t)(tk & 1) * M + (tk >> 1)) * D + c] = (u16)f2bf(v); } }
};

__global__ void k_conv1d(const u16* XB, const float* cw, const float* cb, u16* XC) {
    const size_t i = (size_t)blockIdx.x * blockDim.x + threadIdx.x; if (i >= (size_t)M * D) return;
    const int t = (int)(i >> 10), c = (int)(i & 1023); float s = cb[c];
#pragma unroll
    for (int k = 0; k < 4; ++k) { const int tt = t - 3 + k; if (tt >= 0) s += bf2f(XB[(size_t)tt * D + c]) * cw[k * D + c]; }
    XC[i] = (u16)f2bf(s);
}
__global__ __launch_bounds__(64) void k_scan_seq(const float* LA, const float* BX, const u16* Y, u16* G) {
    const int c = blockIdx.x * 64 + threadIdx.x; float h = 0.f;
    for (int t0 = 0; t0 < M; t0 += 8) {
        float la[8], bx[8], y[8];
#pragma unroll
        for (int j = 0; j < 8; ++j) { la[j] = LA[(size_t)(t0 + j) * D + c]; bx[j] = BX[(size_t)(t0 + j) * D + c]; y[j] = bf2f(Y[(size_t)(t0 + j) * D + c]); }
#pragma unroll
        for (int j = 0; j < 8; ++j) { h = __expf(la[j]) * h + bx[j]; G[(size_t)(t0 + j) * D + c] = (u16)f2bf(h * y[j]); }
    }
}

__global__ __launch_bounds__(64) void k_attn_ref(const u16* Q, const u16* Kb, const u16* Vb, const float* sinks, u16* ATT) {
    const int i = blockIdx.x * 64 + threadIdx.x; const int h = i / M, t = i % M, kvh = h >> 2;
    float q[64], o[64];
#pragma unroll
    for (int d = 0; d < 64; d += 2) { const unsigned w = *(const unsigned*)(Q + (size_t)t * D + 64 * h + d); q[d] = bf2f(w & 0xffffu); q[d + 1] = bf2f(w >> 16); o[d] = 0.f; o[d + 1] = 0.f; }
    float m = sinks[h] * LOG2E, l = 1.0f;
    const int j0 = t - (WIN - 1) > 0 ? t - (WIN - 1) : 0;
    for (int j = j0; j <= t; ++j) {
        const u16* kr = Kb + (size_t)j * KVD + 64 * kvh; const u16* vr = Vb + (size_t)j * KVD + 64 * kvh; float s = 0.f;
#pragma unroll
        for (int d = 0; d < 64; d += 2) { const unsigned w = *(const unsigned*)(kr + d); s += q[d] * bf2f(w & 0xffffu) + q[d + 1] * bf2f(w >> 16); }
        const float mn = fmaxf(m, s), al = exp2f(m - mn), p = exp2f(s - mn); l = l * al + p; m = mn;
#pragma unroll
        for (int d = 0; d < 64; d += 2) { const unsigned w = *(const unsigned*)(vr + d); o[d] = o[d] * al + p * bf2f(w & 0xffffu); o[d + 1] = o[d + 1] * al + p * bf2f(w >> 16); }
    }
    const float il = 1.0f / l;
#pragma unroll
    for (int d = 0; d < 64; d += 2) *(unsigned*)(ATT + (size_t)t * D + 64 * h + d) = pk2(o[d] * il, o[d + 1] * il);
}

__device__ __forceinline__ void router_group(const u16* HB, const float* WR, const float* ssp, unsigned* cnt, int* list, float* gatew, int grp, float* lds  ) {
    const int lane = threadIdx.x & 63, w = threadIdx.x >> 6;
    for (int tt = 0; tt < 8; ++tt) {
        const int tl = 8 * w + tt, t = 64 * grp + tl;
        const u32x4* hr = (const u32x4*)(HB + (size_t)t * D + 16 * lane); const u32x4 h0 = hr[0], h1 = hr[1];
        float x[16];
        x[0] = bf2f(h0.x & 0xffffu); x[1] = bf2f(h0.x >> 16); x[2] = bf2f(h0.y & 0xffffu); x[3] = bf2f(h0.y >> 16); x[4] = bf2f(h0.z & 0xffffu); x[5] = bf2f(h0.z >> 16); x[6] = bf2f(h0.w & 0xffffu); x[7] = bf2f(h0.w >> 16);
        x[8] = bf2f(h1.x & 0xffffu); x[9] = bf2f(h1.x >> 16); x[10] = bf2f(h1.y & 0xffffu); x[11] = bf2f(h1.y >> 16); x[12] = bf2f(h1.z & 0xffffu); x[13] = bf2f(h1.z >> 16); x[14] = bf2f(h1.w & 0xffffu); x[15] = bf2f(h1.w >> 16);
        float lg[8];
#pragma unroll
        for (int e = 0; e < 8; ++e) { const float* wr = WR + e * 1024 + 16 * lane; float s = 0.f;
#pragma unroll
            for (int k = 0; k < 16; ++k) s += x[k] * wr[k];
            lg[e] = wave_sum(s); }
        if (lane == 0) {
            const float rs = rstd_of(ssp, t);
            int e1 = 0; float v1 = lg[0];
#pragma unroll
            for (int e = 1; e < 8; ++e) if (lg[e] > v1) { v1 = lg[e]; e1 = e; }
            int e2 = -1; float v2 = -3.0e38f;
#pragma unroll
            for (int e = 0; e < 8; ++e) if (e != e1 && lg[e] > v2) { v2 = lg[e]; e2 = e; }
            const float g1 = 1.0f / (1.0f + __expf((v2 - v1) * rs));
            lds[tl * 4 + 0] = __builtin_bit_cast(float, e1); lds[tl * 4 + 1] = __builtin_bit_cast(float, e2); lds[tl * 4 + 2] = g1; lds[tl * 4 + 3] = 1.0f - g1;
        }
    }
    __syncthreads();
    if (w == 0) {
        const int e1 = __builtin_bit_cast(int, lds[lane * 4 + 0]), e2 = __builtin_bit_cast(int, lds[lane * 4 + 1]); const float g1 = lds[lane * 4 + 2], g2 = lds[lane * 4 + 3];
        const int t = 64 * grp + lane; const unsigned long long lt = (1ull << lane) - 1ull; const float rsl = rstd_of(ssp, t);
        for (int e = 0; e < 8; ++e) {
            const unsigned long long m1 = __ballot(e1 == e), m2 = __ballot(e2 == e); const int n1 = __popcll(m1), n2 = __popcll(m2);
            unsigned base = 0; if (lane == 0 && n1 + n2 > 0) base = atomicAdd(cnt + e, (unsigned)(n1 + n2));
            base = __shfl(base, 0);
            if (e1 == e) { const unsigned p = base + __popcll(m1 & lt); u32x4 r; r.x = (unsigned)(2 * t); r.y = __builtin_bit_cast(unsigned, g1); r.z = __builtin_bit_cast(unsigned, rsl); r.w = 0u; *(u32x4*)(list + ((size_t)e * M + p) * 4) = r; }
            if (e2 == e) { const unsigned p = base + n1 + __popcll(m2 & lt); u32x4 r; r.x = (unsigned)(2 * t + 1); r.y = __builtin_bit_cast(unsigned, g2); r.z = __builtin_bit_cast(unsigned, rsl); r.w = 0u; *(u32x4*)(list + ((size_t)e * M + p) * 4) = r; }
        }
    }
    __syncthreads();
}
__global__ __launch_bounds__(512) void k_router(Args a) {
    __shared__ float lds[64 * 4];
    unsigned* cnt = (unsigned*)(a.ws + WS_CTL) + CW_CNT;
    for (int g = blockIdx.x; g < M / 64; g += gridDim.x)
        router_group((const u16*)(a.ws + WS_HB), (const float*)(a.ws + WS_WR), (const float*)(a.ws + WS_SSP + 3 * 256 * 1024), cnt, (int*)(a.ws + WS_LIST), (float*)(a.ws + WS_GATEW), g, lds);
}

__device__ __forceinline__ void final_body(float* H, const u16* HBr, const u16* MO, const float* g, int gw, int NGW, int lane) {
    for (int r = gw; r < M; r += NGW) {
        f32x4 v[4]; float s = 0.f;
#pragma unroll
        for (int j = 0; j < 4; ++j) { const int c = 256 * j + 4 * lane; { const u32x2 hb = *(const u32x2*)(HBr + (size_t)r * D + c); v[j] = (f32x4){bf2f(hb.x & 0xffffu), bf2f(hb.x >> 16), bf2f(hb.y & 0xffffu), bf2f(hb.y >> 16)}; }
            const u32x2 a0 = *(const u32x2*)(MO + (size_t)r * D + c), a1 = *(const u32x2*)(MO + ((size_t)M + r) * D + c);
            v[j][0] += bf2f(a0.x & 0xffffu) + bf2f(a1.x & 0xffffu); v[j][1] += bf2f(a0.x >> 16) + bf2f(a1.x >> 16); v[j][2] += bf2f(a0.y & 0xffffu) + bf2f(a1.y & 0xffffu); v[j][3] += bf2f(a0.y >> 16) + bf2f(a1.y >> 16);
            s += (v[j][0] * v[j][0] + v[j][1] * v[j][1]) + (v[j][2] * v[j][2] + v[j][3] * v[j][3]); }
        const float rs = rsqrtf(wave_sum(s) * (1.0f / D) + EPS);
#pragma unroll
        for (int j = 0; j < 4; ++j) { const int c = 256 * j + 4 * lane; const f32x4 gg = *(const f32x4*)(g + c); *(f32x4*)(H + (size_t)r * D + c) = v[j] * rs * gg; }
    }
}
__global__ __launch_bounds__(256) void k_final(float* H, const u16* HBr, const u16* MO, const float* g) { final_body(H, HBr, MO, g, blockIdx.x * 4 + (threadIdx.x >> 6), gridDim.x * 4, threadIdx.x & 63); }

#define LAS __attribute__((address_space(3)))
typedef float f32x16 __attribute__((ext_vector_type(16)));
typedef short s16x4 __attribute__((ext_vector_type(4)));
typedef float f32x2v_t __attribute__((ext_vector_type(2)));
__device__ __forceinline__ unsigned cvt_pk_bf16(float lo, float hi) { unsigned r; asm volatile("v_cvt_pk_bf16_f32 %0, %1, %2" : "=v"(r) : "v"(lo), "v"(hi)); return r; }
__device__ __forceinline__ float fexp2(float x) { return __builtin_amdgcn_exp2f(x); }
__device__ __forceinline__ float frcp(float x) { return __builtin_amdgcn_rcpf(x); }
__device__ __forceinline__ float fsigmoid(float x) { return frcp(1.0f + fexp2(-LOG2E * x)); }
__device__ __forceinline__ float fsilu(float x) { return x * frcp(1.0f + fexp2(-LOG2E * x)); }
__device__ __forceinline__ float fgelu_tanh(float x) { const float z = 0.7978845608028654f * (x + 0.044715f * x * x * x); return x * frcp(1.0f + fexp2(-2.0f * LOG2E * z)); }

__device__ __forceinline__ u32x2 pk8_fp8(const float (&o)[8], float sc) {
    float t[8];
#pragma unroll
    for (int i = 0; i < 8; ++i) t[i] = __builtin_fminf(__builtin_fmaxf(o[i] * sc, -448.0f), 448.0f);
    int w0 = 0, w1 = 0; w0 = __builtin_amdgcn_cvt_pk_fp8_f32(t[0], t[1], w0, false); w0 = __builtin_amdgcn_cvt_pk_fp8_f32(t[2], t[3], w0, true);
    w1 = __builtin_amdgcn_cvt_pk_fp8_f32(t[4], t[5], w1, false); w1 = __builtin_amdgcn_cvt_pk_fp8_f32(t[6], t[7], w1, true);
    u32x2 r; r.x = (unsigned)w0; r.y = (unsigned)w1; return r;
}
constexpr int RING_BYTES = 131072;
constexpr int LX_P = RING_BYTES;
constexpr int LX_TBL = RING_BYTES + 4096;
constexpr int LX_ROUT = RING_BYTES + 8192;
constexpr int LX_MISC = RING_BYTES + 12288;
constexpr int LDS_BYTES = 147456;

namespace pg8 {
constexpr int BM = 256, BK = 64, HALF = 128, HTB = HALF * BK * 2, STAGE_BYTES = 8 * HTB, NXCD = 8, WGM = 8;
__device__ __forceinline__ int lds_byte(int r, int c) { const int st = (r >> 4) * 2 + (c >> 5), rr = r & 15, cc = c & 31, ob = rr * 64 + cc * 2; return st * 1024 + (ob ^ (((ob >> 9) & 1) << 5)); }
__device__ __forceinline__ void stage_rc(int b, int& R, int& C) { const int st = b / 1024, sb = b % 1024, swz = sb ^ (((sb >> 9) & 1) << 5); R = (st >> 1) * 16 + swz / 64; C = (st & 1) * 32 + (swz % 64) / 2; }
__device__ __forceinline__ int perm32(int rho) { const int n = rho >> 4, i = rho & 15; return 8 * (i >> 2) + 4 * n + (i & 3); }

struct Unit { int pm, pn, e; };
struct TileOrder {
    int nM, nN, nwg, G, c;
    __device__ __forceinline__ void init(int nM_, int nN_, int G_, int c_) { nM = nM_; nN = nN_; nwg = nM * nN; G = G_; c = c_; }
    __device__ __forceinline__ bool next_tile(int i, int& pm, int& pn) const {
        const long L = (long)i * G + c; if (L >= nwg) return false;
        int wgid = (int)L; { const int q = nwg / NXCD, r = nwg % NXCD, xcd = wgid % NXCD, off = wgid / NXCD; wgid = (xcd < r ? xcd * (q + 1) : r * (q + 1) + (xcd - r) * q) + off; }
        const int nig = WGM * nN, gid = wgid / nig, fm = gid * WGM, gsz = (nM - fm) < WGM ? (nM - fm) : WGM;
        pm = fm + ((wgid % nig) % gsz); pn = (wgid % nig) / gsz; return true;
    }
};
struct DenseSched {
    TileOrder o; const char* A; const char* Bt; int K;
    __device__ __forceinline__ bool next(int i, Unit& u) const { u.e = 0; return o.next_tile(i, u.pm, u.pn); }
    __device__ __forceinline__ const char* a_base(const Unit& u) const { return A + (size_t)u.pm * 256 * K * 2; }
    __device__ __forceinline__ const char* b_base(const Unit& u) const { return Bt + (size_t)u.pn * 256 * K * 2; }
    __device__ __forceinline__ int a_raw(const Unit&, int) const { return 0; }
    __device__ __forceinline__ unsigned a_cvt(int) const { return 0u; }
};
struct MoeSched {
    TileOrder o; const char* A; const char* Bt; int K; size_t bstride; const int* list; const LAS int* tbl;
    __device__ __forceinline__ bool next(int i, Unit& u) const {
        if (!o.next_tile(i, u.pm, u.pn)) return false;
        int e = 0;
#pragma unroll
        for (int j = 1; j < 8; ++j) e += (u.pm >= tbl[8 + j]) ? 1 : 0;
        u.e = __builtin_amdgcn_readfirstlane(e); return true;
    }
    __device__ __forceinline__ const char* a_base(const Unit& u) const { return list ? A : A + (size_t)u.pm * 256 * K * 2; }
    __device__ __forceinline__ const char* b_base(const Unit& u) const { return Bt + (size_t)u.e * bstride + (size_t)u.pn * 256 * K * 2; }
    __device__ __forceinline__ int a_raw(const Unit& u, int rl) const {
        const int pos = (u.pm - tbl[8 + u.e]) * 256 + rl; return list[((size_t)u.e * M + (pos < tbl[u.e] ? pos : 0)) * 4]; }
    __device__ __forceinline__ unsigned a_cvt(int raw) const { return (unsigned)(raw >> 1) * (unsigned)(K * 2); }
};
struct EpiCtx { int wr, wc, fr, fq, tid; LAS unsigned char* lds; };
typedef int i32x4 __attribute__((ext_vector_type(4)));
typedef int i32x8 __attribute__((ext_vector_type(8)));
__device__ __forceinline__ i32x8 cat8(bf16x8 lo, bf16x8 hi) { return __builtin_shufflevector(__builtin_bit_cast(i32x4, lo), __builtin_bit_cast(i32x4, hi), 0, 1, 2, 3, 4, 5, 6, 7); }
#define ACC_T const f32x4 (&acc)[2][2][4][2]

struct EpiProj {
    const float* ssp; u16* Y; u16* XB;
    __device__ __forceinline__ void operator()(ACC_T, const Unit& u, const EpiCtx& c) const {
        const int row0 = u.pm * 256 + c.wr * 64 + c.fr; const bool isY = u.pn < 4; u16* base = isY ? Y : XB; const int col0 = (u.pn & 3) * 256 + c.wc * 32 + 8 * c.fq;
        float rsv[8];
#pragma unroll
        for (int i = 0; i < 8; ++i) rsv[i] = rstd_of(ssp, row0 + (i >> 2) * 128 + (i & 3) * 16);
#pragma unroll
        for (int ai = 0; ai < 2; ++ai)
#pragma unroll
            for (int m = 0; m < 4; ++m) { const int row = row0 + ai * 128 + m * 16; const float rs = rsv[ai * 4 + m]; u16* rowp = base + (size_t)row * D + col0;
#pragma unroll
                for (int bj = 0; bj < 2; ++bj) { f32x4 v0 = acc[ai][bj][m][0] * rs, v1 = acc[ai][bj][m][1] * rs;
                    if (isY) {
#pragma unroll
                        for (int j = 0; j < 4; ++j) { v0[j] = fgelu_tanh(v0[j]); v1[j] = fgelu_tanh(v1[j]); } }
                    u32x4 w; w.x = cvt_pk_bf16(v0[0], v0[1]); w.y = cvt_pk_bf16(v0[2], v0[3]); w.z = cvt_pk_bf16(v1[0], v1[1]); w.w = cvt_pk_bf16(v1[2], v1[3]);
                    *(u32x4*)(rowp + bj * 128) = w; } }
    }
};
struct EpiGateUp {
    const float* ssp; u16* ACT;
    __device__ __forceinline__ void operator()(ACC_T, const Unit& u, const EpiCtx& c) const {
        const int row0 = u.pm * 256 + c.wr * 64 + c.fr, col0 = u.pn * 128 + c.wc * 32 + 8 * c.fq;
        float rsv[8];
#pragma unroll
        for (int i = 0; i < 8; ++i) rsv[i] = rstd_of(ssp, row0 + (i >> 2) * 128 + (i & 3) * 16);
#pragma unroll
        for (int ai = 0; ai < 2; ++ai)
#pragma unroll
            for (int m = 0; m < 4; ++m) { const int row = row0 + ai * 128 + m * 16; const float rs = rsv[ai * 4 + m]; float o[8];
#pragma unroll
                for (int n = 0; n < 2; ++n)
#pragma unroll
                    for (int j = 0; j < 4; ++j) o[4 * n + j] = fsilu(acc[ai][0][m][n][j] * rs) * (acc[ai][1][m][n][j] * rs);
                u32x4 w; w.x = cvt_pk_bf16(o[0], o[1]); w.y = cvt_pk_bf16(o[2], o[3]); w.z = cvt_pk_bf16(o[4], o[5]); w.w = cvt_pk_bf16(o[6], o[7]);
                *(u32x4*)(ACT + (size_t)row * DFF + col0) = w; }
    }
};
struct EpiRes {
    const float* Xin; u16* HB; const float* bias; float* ssp; unsigned char* HB8; float ascale;
    __device__ __forceinline__ void operator()(ACC_T, const Unit& u, const EpiCtx& c) const {
        const int col0 = u.pn * 256 + c.wc * 32 + 8 * c.fq;
        f32x4 bv[2][2];
#pragma unroll
        for (int bj = 0; bj < 2; ++bj)
#pragma unroll
            for (int n = 0; n < 2; ++n) { bv[bj][n] = (f32x4){0.f, 0.f, 0.f, 0.f}; if (bias) bv[bj][n] = *(const f32x4*)(bias + col0 + bj * 128 + 4 * n); }
        LAS float* P = (LAS float*)(c.lds + LX_P);
#pragma unroll
        for (int g = 0; g < 4; ++g) {
            f32x4 hin[2][2][2];
#pragma unroll
            for (int q = 0; q < 2; ++q) { const int ai = g >> 1, m = (g & 1) * 2 + q; const size_t off = (size_t)(u.pm * 256 + ai * 128 + c.wr * 64 + m * 16 + c.fr) * D + col0;
#pragma unroll
                for (int bj = 0; bj < 2; ++bj) {
                    if (Xin) { hin[q][bj][0] = *(const f32x4*)(Xin + off + bj * 128); hin[q][bj][1] = *(const f32x4*)(Xin + off + bj * 128 + 4); }
                    else { const u32x4 hb = *(const u32x4*)(HB + off + bj * 128);
                        hin[q][bj][0] = (f32x4){bf2f(hb.x & 0xffffu), bf2f(hb.x >> 16), bf2f(hb.y & 0xffffu), bf2f(hb.y >> 16)}; hin[q][bj][1] = (f32x4){bf2f(hb.z & 0xffffu), bf2f(hb.z >> 16), bf2f(hb.w & 0xffffu), bf2f(hb.w >> 16)}; } } }
#pragma unroll
            for (int q = 0; q < 2; ++q) { const int ai = g >> 1, m = (g & 1) * 2 + q; const int rl = ai * 128 + c.wr * 64 + m * 16 + c.fr; const size_t off = (size_t)(u.pm * 256 + rl) * D + col0; float s = 0.f;
#pragma unroll
                for (int bj = 0; bj < 2; ++bj) {
                    const f32x4 h0 = hin[q][bj][0] + acc[ai][bj][m][0] * ascale + bv[bj][0], h1 = hin[q][bj][1] + acc[ai][bj][m][1] * ascale + bv[bj][1];
                    u32x4 w; w.x = cvt_pk_bf16(h0[0], h0[1]); w.y = cvt_pk_bf16(h0[2], h0[3]); w.z = cvt_pk_bf16(h1[0], h1[1]); w.w = cvt_pk_bf16(h1[2], h1[3]);
                    *(u32x4*)(HB + off + bj * 128) = w;
                    if (HB8) { const float o8[8] = {h0[0], h0[1], h0[2], h0[3], h1[0], h1[1], h1[2], h1[3]}; *(u32x2*)(HB8 + off + bj * 128) = pk8_fp8(o8, S8_A); }
                    s += ((h0[0] * h0[0] + h0[1] * h0[1]) + (h0[2] * h0[2] + h0[3] * h0[3])) + ((h1[0] * h1[0] + h1[1] * h1[1]) + (h1[2] * h1[2] + h1[3] * h1[3])); }
                s += __shfl_xor(s, 16); s += __shfl_xor(s, 32);
                if (c.fq == 0) P[rl * 4 + c.wc] = s; }
            asm volatile("" ::: "memory"); }
        asm volatile("s_waitcnt lgkmcnt(0)" ::: "memory"); __builtin_amdgcn_s_barrier(); asm volatile("" ::: "memory");
        if (c.tid < 256) { const f32x4 p = *(const LAS f32x4*)(P + 4 * c.tid); ssp[(size_t)(u.pm * 256 + c.tid) * 4 + u.pn] = (p[0] + p[1]) + (p[2] + p[3]); }
    }
};
struct EpiQKV {
    const float* ssp; const float* bias; const u16* rope; u16* Q; u16* Kb; u16* Vb; float ascale;
    __device__ __forceinline__ void operator()(ACC_T, const Unit& u, const EpiCtx& c) const {
        const int row0 = u.pm * 256 + c.wr * 64 + c.fr, bcol0 = u.pn * 256 + c.wc * 32 + 8 * c.fq;
        u16* base; int pitch, col0; float sc = 1.0f;
        if (u.pn < 4) { base = Q; pitch = D; col0 = bcol0; sc = 0.125f * LOG2E; } else if (u.pn == 4) { base = Kb; pitch = KVD; col0 = bcol0 - 1024; } else { base = Vb; pitch = KVD; col0 = bcol0 - 1280; }
        const bool rot = (u.pn < 5) && ((c.wc & 1) == 0);
        f32x4 bv[2][2];
#pragma unroll
        for (int bj = 0; bj < 2; ++bj)
#pragma unroll
            for (int n = 0; n < 2; ++n) bv[bj][n] = *(const f32x4*)(bias + bcol0 + bj * 128 + 4 * n);
        float rsv[8];
#pragma unroll
        for (int i = 0; i < 8; ++i) rsv[i] = rstd_of(ssp, row0 + (i >> 2) * 128 + (i & 3) * 16);
#pragma unroll
        for (int g = 0; g < 4; ++g) {
            u32x4 rpv[2][2];
            if (rot) {
#pragma unroll
                for (int q2 = 0; q2 < 2; ++q2) { const u32x4* rp = (const u32x4*)(rope + (size_t)(row0 + (g >> 1) * 128 + ((g & 1) * 2 + q2) * 16) * 16); rpv[q2][0] = rp[0]; rpv[q2][1] = rp[1]; } }
#pragma unroll
            for (int q2 = 0; q2 < 2; ++q2) { const int ai = g >> 1, m = (g & 1) * 2 + q2; const int row = row0 + ai * 128 + m * 16; const float rs = rsv[ai * 4 + m] * ascale;
                f32x4 cs0, cs1, sn0, sn1;
                if (rot) { const u32x4 cw = rpv[q2][0], sw = rpv[q2][1];
                    cs0 = (f32x4){bf2f(cw.x & 0xffffu), bf2f(cw.x >> 16), bf2f(cw.y & 0xffffu), bf2f(cw.y >> 16)}; cs1 = (f32x4){bf2f(cw.z & 0xffffu), bf2f(cw.z >> 16), bf2f(cw.w & 0xffffu), bf2f(cw.w >> 16)};
                    sn0 = (f32x4){bf2f(sw.x & 0xffffu), bf2f(sw.x >> 16), bf2f(sw.y & 0xffffu), bf2f(sw.y >> 16)}; sn1 = (f32x4){bf2f(sw.z & 0xffffu), bf2f(sw.z >> 16), bf2f(sw.w & 0xffffu), bf2f(sw.w >> 16)};
                    if (c.fq == 0) { sn0 = -sn0; sn1 = -sn1; } }
#pragma unroll
                for (int bj = 0; bj < 2; ++bj) { f32x4 v0 = acc[ai][bj][m][0] * rs + bv[bj][0], v1 = acc[ai][bj][m][1] * rs + bv[bj][1];
                    if (rot) { f32x4 p0, p1;
#pragma unroll
                        for (int j = 0; j < 4; ++j) { p0[j] = __shfl_xor(v0[j], 16); p1[j] = __shfl_xor(v1[j], 16); }
                        if (c.fq < 2) { v0 = v0 * cs0 + p0 * sn0; v1 = v1 * cs1 + p1 * sn1; } }
                    v0 = v0 * sc; v1 = v1 * sc;
                    u32x4 w; w.x = cvt_pk_bf16(v0[0], v0[1]); w.y = cvt_pk_bf16(v0[2], v0[3]); w.z = cvt_pk_bf16(v1[0], v1[1]); w.w = cvt_pk_bf16(v1[2], v1[3]);
                    *(u32x4*)(base + (size_t)row * pitch + col0 + bj * 128) = w; } } }
    }
};
struct EpiMoeUp {
    const float* ssp; const int* list; const float* gatew; const LAS int* tbl; u16* ACT2;
    __device__ __forceinline__ void operator()(ACC_T, const Unit& u, const EpiCtx& c) const {
        const int col0 = u.pn * 128 + c.wc * 32 + 8 * c.fq, n_e = tbl[u.e], pos0 = (u.pm - tbl[8 + u.e]) * 256;
        u32x4 rec[8];
#pragma unroll
        for (int i = 0; i < 8; ++i) { const int pos = pos0 + (i >> 2) * 128 + c.wr * 64 + (i & 3) * 16 + c.fr; rec[i] = *(const u32x4*)(list + ((size_t)u.e * M + (pos < n_e ? pos : 0)) * 4); }
#pragma unroll
        for (int ai = 0; ai < 2; ++ai)
#pragma unroll
            for (int m = 0; m < 4; ++m) { const int rl = ai * 128 + c.wr * 64 + m * 16 + c.fr;
                const bool valid = pos0 + rl < n_e; const unsigned gwu = rec[ai * 4 + m].y, rsu = rec[ai * 4 + m].z;
                const float gw = valid ? u2f(gwu) : 0.f; const float rs = u2f(rsu) * (MOE_FP8 ? 1.0f / (S8_A * S8_W) : 1.0f); float o[8];
#pragma unroll
                for (int n = 0; n < 2; ++n)
#pragma unroll
                    for (int j = 0; j < 4; ++j) o[4 * n + j] = fsilu(acc[ai][0][m][n][j] * rs) * (acc[ai][1][m][n][j] * rs) * gw;
                if (MOE_FP8) *(u32x2*)((unsigned char*)ACT2 + (size_t)(u.pm * 256 + rl) * DFF + col0) = pk8_fp8(o, S8_ACT);
                else { u32x4 w; w.x = cvt_pk_bf16(o[0], o[1]); w.y = cvt_pk_bf16(o[2], o[3]); w.z = cvt_pk_bf16(o[4], o[5]); w.w = cvt_pk_bf16(o[6], o[7]);
                    *(u32x4*)(ACT2 + (size_t)(u.pm * 256 + rl) * DFF + col0) = w; } }
    }
};
struct EpiMoeDown {
    const int* list; const LAS int* tbl; u16* MO;
    __device__ __forceinline__ void operator()(ACC_T, const Unit& u, const EpiCtx& c) const {
        const int col0 = u.pn * 256 + c.wc * 32 + 8 * c.fq, n_e = tbl[u.e], pos0 = (u.pm - tbl[8 + u.e]) * 256;
        int tkv[8];
#pragma unroll
        for (int i = 0; i < 8; ++i) { const int pos = pos0 + (i >> 2) * 128 + c.wr * 64 + (i & 3) * 16 + c.fr; const int v = list[((size_t)u.e * M + (pos < n_e ? pos : 0)) * 4]; tkv[i] = pos < n_e ? v : -1; }
#pragma unroll
        for (int ai = 0; ai < 2; ++ai)
#pragma unroll
            for (int m = 0; m < 4; ++m) {
                if (tkv[ai * 4 + m] >= 0) { const int tk = tkv[ai * 4 + m]; u16* dst = MO + ((size_t)(tk & 1) * M + (tk >> 1)) * D + col0;
#pragma unroll
                    for (int bj = 0; bj < 2; ++bj) { const float us = MOE_FP8 ? 1.0f / (S8_ACT * S8_WD) : 1.0f; const f32x4 v0 = acc[ai][bj][m][0] * us, v1 = acc[ai][bj][m][1] * us;
                        u32x4 w; w.x = cvt_pk_bf16(v0[0], v0[1]); w.y = cvt_pk_bf16(v0[2], v0[3]); w.z = cvt_pk_bf16(v1[0], v1[1]); w.w = cvt_pk_bf16(v1[2], v1[3]);
                        *(u32x4*)(dst + bj * 128) = w; } } }
    }
};

template <class Epi, class Sched, bool GATHER, bool FP8 = false>
__device__ __forceinline__ void gemm_phase(LAS unsigned char* lds, const int K, const Sched& S, const Epi& E) {
    const int tid = threadIdx.x, wid = __builtin_amdgcn_readfirstlane(tid >> 6), lane = tid & 63, wr = wid >> 2, wc = wid & 3, fr = lane & 15, fq = lane >> 4;
    const int nt = K / BK;
    EpiCtx ctx; ctx.wr = wr; ctx.wc = wc; ctx.fr = fr; ctx.fq = fq; ctx.tid = tid; ctx.lds = lds;
    unsigned voffA[2], voffB[2]; int RA[2]; unsigned CA[2];
#pragma unroll
    for (int i = 0; i < 2; ++i) { int R, C; stage_rc(tid * 16 + i * 8192, R, C); const int Rb = (R & ~31) + perm32(R & 31);
        voffA[i] = (unsigned)(R * K + C) * 2u; voffB[i] = (unsigned)(Rb * K + C) * 2u; RA[i] = R; CA[i] = (unsigned)C * 2u; }
    const size_t kstep = (size_t)(BK * 2);
    const size_t hstep = (size_t)HALF * K * 2;
    const unsigned ldsw = (unsigned)wid * 1024u;
    const int aoff = lds_byte(wr * 64 + fr, fq * 8), boff = lds_byte(wc * 32 + fr, fq * 8);
#define PG8_SA(b, h) (((b) * 2 + (h)) * HTB)
#define PG8_SB(b, h) ((4 + (b) * 2 + (h)) * HTB)
#define PG8_GLDS(src, dstoff) __builtin_amdgcn_global_load_lds((const unsigned*)(src), (LAS unsigned*)(lds + (dstoff)), 16, 0, 0)
#define PG8_STAGE_B(bufoff, gbase) do { _Pragma("unroll") for (int _i = 0; _i < 2; ++_i) PG8_GLDS((const char*)(gbase) + voffB[_i], (bufoff) + ldsw + _i * 8192); } while (0)
#define PG8_STAGE_A(bufoff, gk, h, VA) do { _Pragma("unroll") for (int _i = 0; _i < 2; ++_i) { \
        if constexpr (GATHER) PG8_GLDS((const char*)(gk) + VA[h][_i], (bufoff) + ldsw + _i * 8192); else PG8_GLDS((const char*)(gk) + (size_t)(h) * hstep + voffA[_i], (bufoff) + ldsw + _i * 8192); } } while (0)
#define PG8_LDA(dst, b, h) do { _Pragma("unroll") for (int m = 0; m < 4; ++m) _Pragma("unroll") for (int k = 0; k < 2; ++k) dst[m][k] = *(const LAS bf16x8*)(lds + PG8_SA(b, h) + aoff + m * 2048 + k * 1024); } while (0)
#define PG8_LDB(dst, b, h) do { _Pragma("unroll") for (int n = 0; n < 2; ++n) _Pragma("unroll") for (int k = 0; k < 2; ++k) dst[n][k] = *(const LAS bf16x8*)(lds + PG8_SB(b, h) + boff + n * 2048 + k * 1024); } while (0)
#define PG8_MMA(ai, bj, At, Bt) do { __builtin_amdgcn_s_setprio(1); _Pragma("unroll") for (int m = 0; m < 4; ++m) _Pragma("unroll") for (int n = 0; n < 2; ++n) { \
        if constexpr (FP8) asm volatile("v_mfma_scale_f32_16x16x128_f8f6f4 %0, %1, %2, %0, %3, %3 op_sel_hi:[0,0,0]" : "+v"(acc[ai][bj][m][n]) : "v"(cat8(Bt[n][0], Bt[n][1])), "v"(cat8(At[m][0], At[m][1])), "v"(one_scale)); \
        else { _Pragma("unroll") for (int k = 0; k < 2; ++k) acc[ai][bj][m][n] = __builtin_amdgcn_mfma_f32_16x16x32_bf16(Bt[n][k], At[m][k], acc[ai][bj][m][n], 0, 0, 0); } } \
        __builtin_amdgcn_s_setprio(0); } while (0)
#define PG8_WAIT_V(n) asm volatile("s_waitcnt vmcnt(" #n ")" ::: "memory")
#define PG8_WAIT_L(n) asm volatile("s_waitcnt lgkmcnt(" #n ")" ::: "memory")
#define PG8_BAR __builtin_amdgcn_s_barrier()
#define PG8_SCHED __builtin_amdgcn_sched_barrier(0)
    const int one_scale = 0x7f7f7f7f;
    Unit cur, nxt; int ui = 0;
    if (!S.next(0, cur)) return;
    f32x4 acc[2][2][4][2];
#pragma unroll
    for (int a = 0; a < 2; ++a)
#pragma unroll
        for (int b = 0; b < 2; ++b)
#pragma unroll
            for (int m = 0; m < 4; ++m)
#pragma unroll
                for (int n = 0; n < 2; ++n) acc[a][b][m][n] = (f32x4){0.f, 0.f, 0.f, 0.f};
    bf16x8 At[4][2], B0[2][2], B1[2][2];
    const char* cA = S.a_base(cur); const char* cB = S.b_base(cur);
    unsigned vaC[2][2], vaN[2][2];
#pragma unroll
    for (int h = 0; h < 2; ++h)
#pragma unroll
        for (int i = 0; i < 2; ++i) { vaC[h][i] = GATHER ? S.a_cvt(S.a_raw(cur, h * HALF + RA[i])) + CA[i] : 0u; vaN[h][i] = vaC[h][i]; }
    int rawN[2][2];
    if constexpr (GATHER) { Unit u1; const bool h1 = S.next(1, u1);
#pragma unroll
        for (int h = 0; h < 2; ++h)
#pragma unroll
            for (int i = 0; i < 2; ++i) rawN[h][i] = h1 ? S.a_raw(u1, h * HALF + RA[i]) : 0; }
    PG8_STAGE_B(PG8_SB(0, 0), cB); PG8_STAGE_B(PG8_SB(0, 1), cB + hstep); PG8_STAGE_A(PG8_SA(0, 0), cA, 0, vaC); PG8_STAGE_A(PG8_SA(0, 1), cA, 1, vaC);
    if (wr == 1) PG8_BAR;
    PG8_WAIT_V(2); PG8_BAR;
    PG8_STAGE_B(PG8_SB(1, 0), cB + kstep); PG8_STAGE_A(PG8_SA(1, 0), cA + kstep, 0, vaC); PG8_STAGE_B(PG8_SB(1, 1), cB + hstep + kstep);
    PG8_WAIT_V(6); PG8_BAR;
    for (;;) {
        const bool has_next = S.next(ui + 1, nxt);
        const char* nA = has_next ? S.a_base(nxt) : cA; const char* nB = has_next ? S.b_base(nxt) : cB;
        if constexpr (GATHER) {
#pragma unroll
            for (int h = 0; h < 2; ++h)
#pragma unroll
                for (int i = 0; i < 2; ++i) vaN[h][i] = S.a_cvt(rawN[h][i]) + CA[i]; }
#pragma unroll 1
        for (int t = 0; t < nt; t += 2) {
            const bool last = (t == nt - 2);
            const char* a1 = cA + (size_t)(t + 1) * kstep;
            const char* a2 = last ? nA : cA + (size_t)(t + 2) * kstep; const char* b2 = last ? nB : cB + (size_t)(t + 2) * kstep;
            const char* a3 = a2 + kstep; const char* b3 = b2 + kstep;
            unsigned v2[2][2];
#pragma unroll
            for (int h = 0; h < 2; ++h)
#pragma unroll
                for (int i = 0; i < 2; ++i) v2[h][i] = (GATHER && last) ? vaN[h][i] : vaC[h][i];
            PG8_LDB(B0, 0, 0); PG8_LDB(B1, 0, 1); PG8_SCHED; PG8_LDA(At, 0, 0); PG8_STAGE_A(PG8_SA(1, 1), a1, 1, vaC);
            PG8_WAIT_V(8); PG8_WAIT_L(0); PG8_BAR; PG8_MMA(0, 0, At, B0); PG8_MMA(0, 1, At, B1); PG8_BAR; PG8_SCHED;
            PG8_LDA(At, 0, 1); PG8_STAGE_B(PG8_SB(0, 0), b2); PG8_STAGE_B(PG8_SB(0, 1), b2 + hstep); PG8_STAGE_A(PG8_SA(0, 0), a2, 0, v2);
            PG8_WAIT_V(8); PG8_WAIT_L(0); PG8_BAR; PG8_MMA(1, 0, At, B0); PG8_MMA(1, 1, At, B1); PG8_BAR; PG8_SCHED;
            PG8_LDB(B0, 1, 0); PG8_LDB(B1, 1, 1); PG8_SCHED; PG8_LDA(At, 1, 0); PG8_STAGE_A(PG8_SA(0, 1), a2, 1, v2);
            PG8_WAIT_V(8); PG8_WAIT_L(0); PG8_BAR; PG8_MMA(0, 0, At, B0); PG8_MMA(0, 1, At, B1); PG8_BAR; PG8_SCHED;
            PG8_LDA(At, 1, 1); PG8_STAGE_B(PG8_SB(1, 0), b3); PG8_STAGE_B(PG8_SB(1, 1), b3 + hstep); PG8_STAGE_A(PG8_SA(1, 0), a3, 0, v2);
            PG8_WAIT_V(8); PG8_WAIT_L(0); PG8_BAR; PG8_MMA(1, 0, At, B0); PG8_MMA(1, 1, At, B1); PG8_BAR; PG8_SCHED;
        }
        if (wr == 0) PG8_BAR;
        if constexpr (GATHER) { Unit u2; const bool h2 = S.next(ui + 2, u2);
#pragma unroll
            for (int h = 0; h < 2; ++h)
#pragma unroll
                for (int i = 0; i < 2; ++i) rawN[h][i] = h2 ? S.a_raw(u2, h * HALF + RA[i]) : 0; }
        E(acc, cur, ctx);
        if (!has_next) break;
#pragma unroll
        for (int a = 0; a < 2; ++a)
#pragma unroll
            for (int b = 0; b < 2; ++b)
#pragma unroll
                for (int m = 0; m < 4; ++m)
#pragma unroll
                    for (int n = 0; n < 2; ++n) acc[a][b][m][n] = (f32x4){0.f, 0.f, 0.f, 0.f};
        cur = nxt; cA = nA; cB = nB; ++ui;
#pragma unroll
        for (int h = 0; h < 2; ++h)
#pragma unroll
            for (int i = 0; i < 2; ++i) vaC[h][i] = vaN[h][i];
        if (wr == 1) PG8_BAR;
    }
    PG8_WAIT_V(0);
    PG8_BAR;
#undef PG8_SA
#undef PG8_SB
#undef PG8_GLDS
#undef PG8_STAGE_A
#undef PG8_STAGE_B
#undef PG8_LDA
#undef PG8_LDB
#undef PG8_MMA
#undef PG8_WAIT_V
#undef PG8_WAIT_L
#undef PG8_BAR
#undef PG8_SCHED
}
}

#define XB_TMO      128
#define XB_XCNT(j)  (256  + 64 * (j))
#define XB_XSUB(j)  (1280 + 64 * (j))
#define XB_XGEN(j)  (2304 + 64 * (j))
#define XB_TOP      3328
#define XB_TOPGEN   3392
#define XCD_BAR_WORDS 3456
#define XB_SPIN_CAP (1u << 18)
__device__ __forceinline__ unsigned xb_ld(unsigned* p)              { return __hip_atomic_load(p, __ATOMIC_RELAXED, __HIP_MEMORY_SCOPE_AGENT); }
__device__ __forceinline__ unsigned xb_add(unsigned* p, unsigned v) { return __hip_atomic_fetch_add(p, v, __ATOMIC_RELAXED, __HIP_MEMORY_SCOPE_AGENT); }
__device__ __forceinline__ unsigned xb_xcc_id() { return (unsigned)__builtin_amdgcn_s_getreg((3 << 11) | 20) & 0xFu; }
#define XB_SPIN(cond, bar) do { unsigned _sp = 0; while (cond) { __builtin_amdgcn_s_sleep(1); \
    if ((++_sp & 255u) == 0u) { if (xb_ld(&(bar)[XB_TMO])) break; if (_sp > XB_SPIN_CAP) { atomicAdd(&(bar)[XB_TMO], 1u); break; } } } } while (0)
struct XcdBarrier { unsigned* bar; unsigned x; volatile LAS unsigned* st; };
__device__ __forceinline__ XcdBarrier xcd_barrier_post(unsigned* bar, volatile LAS unsigned* st) {
    XcdBarrier b; b.bar = bar; b.x = xb_xcc_id(); b.st = st;
    if (threadIdx.x == 0) (void)xb_add(&bar[XB_XCNT(b.x)], 1u);
    return b;
}
__device__ __forceinline__ void xcd_barrier_complete(unsigned* bar, unsigned x, unsigned& nloc, unsigned& nx) {
    const unsigned G = gridDim.x * gridDim.y * gridDim.z;
    unsigned sum, cnt, mine, sp = 0u;
    for (;;) {
        sum = 0u; cnt = 0u; mine = 0u;
#pragma unroll
        for (unsigned j = 0; j < 16; ++j) { const unsigned c = xb_ld(&bar[XB_XCNT(j)]); sum += c; cnt += (c > 0u) ? 1u : 0u; mine = (j == x) ? c : mine; }
        if (sum == G) break;
        __builtin_amdgcn_s_sleep(1);
        if ((++sp & 255u) == 0u) { if (xb_ld(&bar[XB_TMO])) break; if (sp > XB_SPIN_CAP) { atomicAdd(&bar[XB_TMO], 1u); break; } }
    }
    nloc = mine > 0u ? mine : 1u; nx = cnt > 0u ? cnt : 1u;
}
__device__ __forceinline__ void xcd_barrier(const XcdBarrier& b) {
    asm volatile("s_waitcnt vmcnt(0)" ::: "memory");
    __syncthreads();
    if (threadIdx.x == 0) {
        unsigned* bar = b.bar;
        __builtin_amdgcn_s_waitcnt(0);
        unsigned nloc = b.st[0], nx = b.st[1];
        if (nloc == 0u) { xcd_barrier_complete(bar, b.x, nloc, nx); b.st[0] = nloc; b.st[1] = nx; }
        const unsigned old = xb_add(&bar[XB_XSUB(b.x)], 1u);
        const unsigned gen = old / nloc;
        if (old + 1u == (gen + 1u) * nloc) {
            __builtin_amdgcn_fence(__ATOMIC_RELEASE, "agent");
            asm volatile("s_waitcnt vmcnt(0)" ::: "memory");
            const unsigned og = xb_add(&bar[XB_TOP], 1u);
            const unsigned tg = og / nx;
            if (og + 1u == (tg + 1u) * nx) xb_add(&bar[XB_TOPGEN], 1u);
            else XB_SPIN(xb_ld(&bar[XB_TOPGEN]) == tg, bar);
            __builtin_amdgcn_fence(__ATOMIC_ACQUIRE, "agent");
            xb_add(&bar[XB_XGEN(b.x)], 1u);
            asm volatile("s_waitcnt vmcnt(0)" ::: "memory");
        } else {
            XB_SPIN(xb_ld(&bar[XB_XGEN(b.x)]) == gen, bar);
            __builtin_amdgcn_fence(__ATOMIC_ACQUIRE, "agent");
            asm volatile("s_waitcnt vmcnt(0)" ::: "memory");
        }
    }
    __syncthreads();
}
constexpr int CW_BAR = 4096;

constexpr int XS_STRIDE = 272;
constexpr int LR_XS = 0, LR_XC = 35840, LR_HS = LR_XC + 34816, LR_CP = LR_HS + 34816, LR_HIN = LR_CP + 2560;
static_assert(LR_HIN + 512 <= RING_BYTES, "lru lds");
template <bool FINAL>
__device__ __forceinline__ void lru_phase(const Args& a, LAS unsigned char* lds, int G, int vcu) {
    const int tid = threadIdx.x, lane = tid & 63, w = __builtin_amdgcn_readfirstlane(tid >> 6), fr = lane & 15, fq = lane >> 4;
    const u16* XB = (const u16*)(a.ws + WS_XB); const u16* Y = (const u16*)(a.ws + WS_Y); u16* Gout = (u16*)(a.ws + WS_G);
    const u16* WAX = (const u16*)(a.ws + WS_WAX); float* CAR = (float*)(a.ws + WS_CAR); const float* spl = (const float*)(a.ws + WS_SPL);
    const float* cw = a.in[6]; const float* cb = a.in[7]; const float* b_a = a.in[9]; const float* b_x = a.in[11];
    LAS float* CP = (LAS float*)(lds + LR_CP); LAS float* HIN = (LAS float*)(lds + LR_HIN);
    for (int unit = vcu; unit < 256; unit += G) {
        const int n = unit & 7, chunk = unit >> 3, t0 = chunk * 512, ch0 = 128 * n;
        u32x4 xpre[5];
#define LRU_XLOAD(ts_) do { _Pragma("unroll") for (int i = 0; i < 5; ++i) { const int p = tid + 512 * i, row = p >> 4, pc = p & 15, t = (ts_) - 3 + row; xpre[i] = (u32x4){0u, 0u, 0u, 0u}; \
            if (p < 131 * 16 && t >= 0) xpre[i] = *(const u32x4*)(XB + (size_t)t * D + ch0 + 8 * pc); } } while (0)
        LRU_XLOAD(t0);
        bf16x8 bfr[4], bfi[4];
        { const u16* wb = WAX + ((size_t)n * 256 + 16 * w + fr) * 128 + 8 * fq;
#pragma unroll
          for (int s = 0; s < 4; ++s) { bfr[s] = *(const bf16x8*)(wb + 32 * s); bfi[s] = *(const bf16x8*)(wb + 128 * 128 + 32 * s); } }
        const int ch = ch0 + 16 * w + fr; const float nba = -LOG2E * b_a[ch], nbx = -LOG2E * b_x[ch], c1 = -8.0f * LOG2E * spl[ch];
        for (int i = tid; i < 5 * 128; i += 512) { const int k = i >> 7, c = i & 127; CP[i] = k < 4 ? cw[k * D + ch0 + c] : cb[ch0 + c]; }
        float H = 0.f, Ptot = 1.f;
        if (FINAL) {
            const int hh = lane >> 5, jj = lane & 31;
#pragma unroll
            for (int it = 0; it < 8; ++it) { const int cl = 16 * w + 2 * it + hh; float A = 1.f, h = 0.f;
                if (jj < chunk) { const f32x2v_t v = *(const f32x2v_t*)(CAR + (((size_t)n * 32 + jj) * 128 + cl) * 2); A = v.x; h = v.y; }
#pragma unroll
                for (int d = 1; d < 32; d <<= 1) { const float Ap = __shfl_up(A, d, 32), hp = __shfl_up(h, d, 32); if (jj >= d) { h = A * hp + h; A = A * Ap; } }
                if (jj == 31) HIN[cl] = h; }
        }
        __syncthreads();
        if (FINAL) H = HIN[16 * w + fr];
        for (int s = 0; s < 4; ++s) {
            const int ts = t0 + 128 * s;
#pragma unroll
            for (int i = 0; i < 5; ++i) { const int p = tid + 512 * i, row = p >> 4, pc = p & 15; if (p < 131 * 16) *(LAS u32x4*)(lds + LR_XS + row * XS_STRIDE + pc * 16) = xpre[i]; }
            __syncthreads();
            if (s < 3) LRU_XLOAD(ts + 128);
            u32x4 ypre[4];
            if (FINAL) {
#pragma unroll
                for (int i = 0; i < 4; ++i) { const int p = tid + 512 * i, row = p >> 4, pc = p & 15; ypre[i] = *(const u32x4*)(Y + (size_t)(ts + row) * D + ch0 + 8 * pc); } }
            { const int cg = tid & 15, tg = tid >> 4; float o[4][8], wk[4][8];
#pragma unroll
              for (int k = 0; k < 4; ++k) { const f32x4 w0 = *(const LAS f32x4*)(CP + k * 128 + 8 * cg), w1 = *(const LAS f32x4*)(CP + k * 128 + 8 * cg + 4);
#pragma unroll
                  for (int i = 0; i < 4; ++i) { wk[k][i] = w0[i]; wk[k][4 + i] = w1[i]; } }
              { const f32x4 b0 = *(const LAS f32x4*)(CP + 512 + 8 * cg), b1 = *(const LAS f32x4*)(CP + 512 + 8 * cg + 4);
#pragma unroll
                for (int jt = 0; jt < 4; ++jt)
#pragma unroll
                    for (int i = 0; i < 4; ++i) { o[jt][i] = b0[i]; o[jt][4 + i] = b1[i]; } }
#pragma unroll
              for (int rr = 0; rr < 7; ++rr) { const u32x4 xv = *(const LAS u32x4*)(lds + LR_XS + (4 * tg + rr) * XS_STRIDE + cg * 16); float xf[8];
                  xf[0] = bf2f(xv.x & 0xffffu); xf[1] = bf2f(xv.x >> 16); xf[2] = bf2f(xv.y & 0xffffu); xf[3] = bf2f(xv.y >> 16); xf[4] = bf2f(xv.z & 0xffffu); xf[5] = bf2f(xv.z >> 16); xf[6] = bf2f(xv.w & 0xffffu); xf[7] = bf2f(xv.w >> 16);
#pragma unroll
                  for (int jt = 0; jt < 4; ++jt) { const int k = rr - jt; if (k >= 0 && k <= 3) {
#pragma unroll
                      for (int i = 0; i < 8; ++i) o[jt][i] += xf[i] * wk[k][i]; } } }
#pragma unroll
              for (int jt = 0; jt < 4; ++jt) { u32x4 wv; wv.x = cvt_pk_bf16(o[jt][0], o[jt][1]); wv.y = cvt_pk_bf16(o[jt][2], o[jt][3]); wv.z = cvt_pk_bf16(o[jt][4], o[jt][5]); wv.w = cvt_pk_bf16(o[jt][6], o[jt][7]);
                  *(LAS u32x4*)(lds + LR_XC + (4 * tg + jt) * XS_STRIDE + cg * 16) = wv; } }
            __syncthreads();
            f32x4 ar[8], ag[8];
#pragma unroll
            for (int m = 0; m < 8; ++m) { ar[m] = (f32x4){0.f, 0.f, 0.f, 0.f}; ag[m] = (f32x4){0.f, 0.f, 0.f, 0.f}; }
#pragma unroll
            for (int m = 0; m < 8; ++m)
#pragma unroll
                for (int s2 = 0; s2 < 4; ++s2) { const bf16x8 af = *(const LAS bf16x8*)(lds + LR_XC + (16 * m + fr) * XS_STRIDE + (32 * s2 + 8 * fq) * 2);
                    ar[m] = __builtin_amdgcn_mfma_f32_16x16x32_bf16(af, bfr[s2], ar[m], 0, 0, 0); ag[m] = __builtin_amdgcn_mfma_f32_16x16x32_bf16(af, bfi[s2], ag[m], 0, 0, 0); }
#pragma unroll
            for (int m = 0; m < 8; ++m) {
                float av[4], hv[4]; float Aseg = 1.f, Bseg = 0.f;
#pragma unroll
                for (int j = 0; j < 4; ++j) { const int tl = 16 * m + 4 * fq + j;
                    const float rg = frcp(1.0f + fexp2(__builtin_fmaf(ar[m][j], -LOG2E, nba))), ig = frcp(1.0f + fexp2(__builtin_fmaf(ag[m][j], -LOG2E, nbx)));
                    const float a_ = fexp2(c1 * rg);
                    const float xc = bf2f(*(const LAS u16*)(lds + LR_XC + tl * XS_STRIDE + (16 * w + fr) * 2));
                    const float b_ = __builtin_amdgcn_sqrtf(__builtin_fmaf(-a_, a_, 1.0f)) * (ig * xc);
                    Bseg = __builtin_fmaf(a_, Bseg, b_); Aseg *= a_; av[j] = Aseg; hv[j] = Bseg; }
                const float A1 = __shfl_xor(Aseg, 16), B1 = __shfl_xor(Bseg, 16);
                const bool odd = (fq & 1) != 0, hi2 = fq >= 2;
                const float Ap = Aseg * A1, Bp = odd ? __builtin_fmaf(Aseg, B1, Bseg) : __builtin_fmaf(A1, Bseg, B1);
                const float A2 = __shfl_xor(Ap, 32), B2 = __shfl_xor(Bp, 32);
                const float hpair = hi2 ? __builtin_fmaf(A2, H, B2) : H;
                const float my = odd ? __builtin_fmaf(A1, hpair, B1) : hpair;
                const float Alo = hi2 ? A2 : Ap, Blo = hi2 ? B2 : Bp, Ahi = hi2 ? Ap : A2, Bhi = hi2 ? Bp : B2;
                H = __builtin_fmaf(Ahi, __builtin_fmaf(Alo, H, Blo), Bhi); Ptot *= Alo * Ahi;
                if (FINAL) {
#pragma unroll
                    for (int j = 0; j < 4; ++j) { const int tl = 16 * m + 4 * fq + j; *(LAS u16*)(lds + LR_HS + tl * XS_STRIDE + (16 * w + fr) * 2) = (u16)f2bf(__builtin_fmaf(av[j], my, hv[j])); } }
            }
            if (FINAL) {
                __syncthreads();
#pragma unroll
                for (int i = 0; i < 4; ++i) { const int p = tid + 512 * i, row = p >> 4, pc = p & 15; const size_t go = (size_t)(ts + row) * D + ch0 + 8 * pc;
                    const u32x4 hv = *(const LAS u32x4*)(lds + LR_HS + row * XS_STRIDE + pc * 16); const u32x4 yv = ypre[i]; u32x4 ov;
                    ov.x = cvt_pk_bf16(bf2f(hv.x & 0xffffu) * bf2f(yv.x & 0xffffu), bf2f(hv.x >> 16) * bf2f(yv.x >> 16)); ov.y = cvt_pk_bf16(bf2f(hv.y & 0xffffu) * bf2f(yv.y & 0xffffu), bf2f(hv.y >> 16) * bf2f(yv.y >> 16));
                    ov.z = cvt_pk_bf16(bf2f(hv.z & 0xffffu) * bf2f(yv.z & 0xffffu), bf2f(hv.z >> 16) * bf2f(yv.z >> 16)); ov.w = cvt_pk_bf16(bf2f(hv.w & 0xffffu) * bf2f(yv.w & 0xffffu), bf2f(hv.w >> 16) * bf2f(yv.w >> 16));
                    *(u32x4*)(Gout + go) = ov; }
            }
        }
#undef LRU_XLOAD
        if (!FINAL) { if (fq == 0) { f32x2v_t v; v.x = Ptot; v.y = H; *(f32x2v_t*)(CAR + (((size_t)n * 32 + chunk) * 128 + 16 * w + fr) * 2) = v; } }
        __syncthreads();
    }
}

constexpr int AT_KS = 144, AT_K = 0, AT_V = 256 * AT_KS;
__device__ __forceinline__ int crow(int r, int hi) { return (r & 3) + 8 * (r >> 2) + 4 * hi; }
__device__ __forceinline__ void attn_phase(const Args& a, LAS unsigned char* lds, int G, int vcu) {
    const int tid = threadIdx.x, lane = tid & 63, w = __builtin_amdgcn_readfirstlane(tid >> 6), r32 = lane & 31, hi = lane >> 5;
    const u16* Q = (const u16*)(a.ws + WS_Q); const u16* Kb = (const u16*)(a.ws + WS_K); const u16* Vb = (const u16*)(a.ws + WS_V); u16* ATT = (u16*)(a.ws + WS_ATT);
    const float* sinks = a.in[16];
    for (int unit = vcu; unit < 512; unit += G) {
        const int kvh = unit & 3, b = unit >> 2;
        for (int p = tid; p < 256 * 8; p += 512) { const int idx = p >> 3, pc = p & 7, t = 128 * (b - 1) + idx;
            if (t >= 0) { const u32x4 kv = *(const u32x4*)(Kb + (size_t)t * KVD + 64 * kvh + 8 * pc), vv = *(const u32x4*)(Vb + (size_t)t * KVD + 64 * kvh + 8 * pc);
                *(LAS u32x4*)(lds + AT_K + idx * AT_KS + pc * 16) = kv; *(LAS u32x4*)(lds + AT_V + idx * AT_KS + pc * 16) = vv; } }
        __syncthreads();
        const int head = 4 * kvh + (w >> 1), qh = w & 1; const float sink2 = sinks[head] * LOG2E;
        for (int qt = 0; qt < 2; ++qt) {
            const int q0 = 64 * qh + 32 * qt, t = 128 * b + q0 + r32;
            bf16x8 qf[4];
#pragma unroll
            for (int s = 0; s < 4; ++s) qf[s] = *(const bf16x8*)(Q + (size_t)t * D + 64 * head + 16 * s + 8 * hi);
            f32x16 o0, o1;
#pragma unroll
            for (int r = 0; r < 16; ++r) { o0[r] = 0.f; o1[r] = 0.f; }
            float mx = sink2, l = 1.0f; const int kt0 = q0 >> 5;
            for (int kk = 0; kk < 5; ++kk) { const int kt = kt0 + kk; if (b == 0 && kt < 4) continue;
                f32x16 sc;
#pragma unroll
                for (int r = 0; r < 16; ++r) sc[r] = 0.f;
#pragma unroll
                for (int s = 0; s < 4; ++s) { const bf16x8 kf = *(const LAS bf16x8*)(lds + AT_K + (32 * kt + r32) * AT_KS + (16 * s + 8 * hi) * 2); sc = __builtin_amdgcn_mfma_f32_32x32x16_bf16(kf, qf[s], sc, 0, 0, 0); }
                const int base = 32 * kt + 4 * hi - (128 + q0 + r32); float mt = -1.0e30f;
#pragma unroll
                for (int r = 0; r < 16; ++r) { const int rel = base + (r & 3) + 8 * (r >> 2); if (!(rel <= 0 && rel > -WIN)) sc[r] = -1.0e30f; mt = fmaxf(mt, sc[r]); }
                mt = fmaxf(mt, __shfl_xor(mt, 32));
                const float mn = fmaxf(mx, mt), al = fexp2(mx - mn); float ps = 0.f;
#pragma unroll
                for (int r = 0; r < 16; ++r) { const float p = fexp2(sc[r] - mn); sc[r] = p; ps += p; }
                ps += __shfl_xor(ps, 32); l = l * al + ps; mx = mn;
#pragma unroll
                for (int r = 0; r < 16; ++r) { o0[r] *= al; o1[r] *= al; }
                u32x4 pa, pb; pa.x = cvt_pk_bf16(sc[0], sc[1]); pa.y = cvt_pk_bf16(sc[2], sc[3]); pa.z = cvt_pk_bf16(sc[4], sc[5]); pa.w = cvt_pk_bf16(sc[6], sc[7]);
                pb.x = cvt_pk_bf16(sc[8], sc[9]); pb.y = cvt_pk_bf16(sc[10], sc[11]); pb.z = cvt_pk_bf16(sc[12], sc[13]); pb.w = cvt_pk_bf16(sc[14], sc[15]);
                const bf16x8 pf0 = __builtin_bit_cast(bf16x8, pa), pf1 = __builtin_bit_cast(bf16x8, pb);
#pragma unroll
                for (int s2 = 0; s2 < 2; ++s2)
#pragma unroll
                    for (int dt = 0; dt < 2; ++dt) {
                        const int va = AT_V + (32 * kt + 16 * s2 + 4 * hi + ((lane & 15) >> 2)) * AT_KS + (32 * dt + 16 * ((lane >> 4) & 1) + 4 * (lane & 3)) * 2;
                        const s16x4 lo = __builtin_bit_cast(s16x4, __builtin_amdgcn_ds_read_tr16_b64_v4i16((LAS s16x4*)(lds + va)));
                        const s16x4 hi4 = __builtin_bit_cast(s16x4, __builtin_amdgcn_ds_read_tr16_b64_v4i16((LAS s16x4*)(lds + va + 8 * AT_KS)));
                        const bf16x8 vf = (bf16x8){lo[0], lo[1], lo[2], lo[3], hi4[0], hi4[1], hi4[2], hi4[3]};
                        if (dt == 0) o0 = __builtin_amdgcn_mfma_f32_32x32x16_bf16(vf, s2 ? pf1 : pf0, o0, 0, 0, 0); else o1 = __builtin_amdgcn_mfma_f32_32x32x16_bf16(vf, s2 ? pf1 : pf0, o1, 0, 0, 0); }
            }
            const float il = 1.0f / l;
#pragma unroll
            for (int g4 = 0; g4 < 4; ++g4) { u32x2 w0, w1;
                w0.x = cvt_pk_bf16(o0[4 * g4] * il, o0[4 * g4 + 1] * il); w0.y = cvt_pk_bf16(o0[4 * g4 + 2] * il, o0[4 * g4 + 3] * il);
                w1.x = cvt_pk_bf16(o1[4 * g4] * il, o1[4 * g4 + 1] * il); w1.y = cvt_pk_bf16(o1[4 * g4 + 2] * il, o1[4 * g4 + 3] * il);
                if (ATTN_FP8) { const float so = il * S8_O; int b0 = 0, b1 = 0;
                    b0 = __builtin_amdgcn_cvt_pk_fp8_f32(o0[4 * g4] * so, o0[4 * g4 + 1] * so, b0, false); b0 = __builtin_amdgcn_cvt_pk_fp8_f32(o0[4 * g4 + 2] * so, o0[4 * g4 + 3] * so, b0, true);
                    b1 = __builtin_amdgcn_cvt_pk_fp8_f32(o1[4 * g4] * so, o1[4 * g4 + 1] * so, b1, false); b1 = __builtin_amdgcn_cvt_pk_fp8_f32(o1[4 * g4 + 2] * so, o1[4 * g4 + 3] * so, b1, true);
                    unsigned char* A8 = (unsigned char*)ATT; *(int*)(A8 + (size_t)t * D + 64 * head + 8 * g4 + 4 * hi) = b0; *(int*)(A8 + (size_t)t * D + 64 * head + 32 + 8 * g4 + 4 * hi) = b1; }
                else { *(u32x2*)(ATT + (size_t)t * D + 64 * head + 8 * g4 + 4 * hi) = w0; *(u32x2*)(ATT + (size_t)t * D + 64 * head + 32 + 8 * g4 + 4 * hi) = w1; } }
        }
        __syncthreads();
    }
}

constexpr int NPHASE = 14;
__global__ void __launch_bounds__(512, 2) mega(Args a) {
    extern __shared__ __attribute__((aligned(16))) unsigned char lds_raw[];
    LAS unsigned char* lds = (LAS unsigned char*)lds_raw;
    const int tid = threadIdx.x, lane = tid & 63, wave = __builtin_amdgcn_readfirstlane(tid >> 6);
    const int G = gridDim.x; const int bx = blockIdx.x; const int vcu = (G % 8 == 0) ? (bx % 8) * (G / 8) + bx / 8 : bx;
    unsigned char* ws = a.ws; unsigned* ctl = (unsigned*)(ws + WS_CTL);
    volatile LAS unsigned* MISC = (volatile LAS unsigned*)(lds + LX_MISC);
    for (int u = tid; u < 112; u += 512) ((LAS unsigned*)(lds + LX_MISC))[u] = 0u;
    __syncthreads();
    const int lo = a.ph_lo, hi = a.ph_hi;
    XcdBarrier bar; bar.bar = ctl + CW_BAR; bar.x = 0; bar.st = nullptr;
    if (hi - lo > 1) bar = xcd_barrier_post(ctl + CW_BAR, MISC + 8);
#define IN(k) (lo <= (k) && (k) < hi)
#ifndef REP_MASK
#define REP_MASK 0
#endif
#define REPS(k) for (int rep_ = 0; rep_ < 1 + ((REP_MASK >> (k)) & 1); ++rep_)
#define SEAM(k) do { if (IN(k) && IN((k) + 1)) xcd_barrier(bar); } while (0)
    float* H = a.out; u16* HB = (u16*)(ws + WS_HB);
    float* SSP0 = (float*)(ws + WS_SSP); float* SSP1 = SSP0 + 65536; float* SSP2 = SSP1 + 65536; float* SSP3 = SSP2 + 65536;
    unsigned* cnt = ctl + CW_CNT; int* list = (int*)(ws + WS_LIST); float* gatew = (float*)(ws + WS_GATEW);
    const int gw = vcu * 8 + wave, NGW = G * 8;

    if (IN(0)) REPS(0) {
        tables_body(a, vcu * 512 + tid, G * 512);
        convert_body(a, (float*)(lds_raw + wave * 16384), gw, NGW, lane);
        rowprep_body(a.in[0], HB, SSP0, gw, NGW, lane);
    }
    SEAM(0);
    if (IN(1)) REPS(1) { pg8::DenseSched S; S.o.init(M / 256, 2048 / 256, G, bx); S.A = (const char*)HB; S.Bt = (const char*)(ws + WS_WIN); S.K = 1024;
        pg8::EpiProj E{SSP0, (u16*)(ws + WS_Y), (u16*)(ws + WS_XB)}; pg8::gemm_phase<pg8::EpiProj, pg8::DenseSched, false>(lds, 1024, S, E); }
    SEAM(1);
    if (IN(2)) REPS(2) lru_phase<false>(a, lds, G, vcu);
    SEAM(2);
    if (IN(3)) REPS(3) lru_phase<true>(a, lds, G, vcu);
    SEAM(3);
    if (IN(4)) REPS(4) { pg8::DenseSched S; S.o.init(M / 256, 4, G, bx); S.A = (const char*)(ws + WS_G); S.Bt = (const char*)(ws + WS_WOUT); S.K = 1024;
        pg8::EpiRes E{a.in[0], HB, nullptr, SSP1, nullptr, 1.0f}; pg8::gemm_phase<pg8::EpiRes, pg8::DenseSched, false>(lds, 1024, S, E); }
    SEAM(4);
    if (IN(5)) REPS(5) { pg8::DenseSched S; S.o.init(M / 256, 7168 / 256, G, bx); S.A = (const char*)HB; S.Bt = (const char*)(ws + WS_WGU); S.K = 1024;
        pg8::EpiGateUp E{SSP1, (u16*)(ws + WS_ACT)}; pg8::gemm_phase<pg8::EpiGateUp, pg8::DenseSched, false>(lds, 1024, S, E); }
    SEAM(5);
    if (IN(6)) { pg8::DenseSched S; S.o.init(M / 256, 4, G, bx); S.A = (const char*)(ws + WS_ACT); S.Bt = (const char*)(ws + WS_WD); S.K = DFF;
        pg8::EpiRes E{nullptr, HB, nullptr, SSP2, ATTN_FP8 ? (unsigned char*)(ws + WS_HB8) : nullptr, 1.0f}; pg8::gemm_phase<pg8::EpiRes, pg8::DenseSched, false>(lds, DFF, S, E); }
    SEAM(6);
    if (IN(7)) REPS(7) { pg8::DenseSched S; S.o.init(M / 256, NQKV / 256, G, bx); S.A = ATTN_FP8 ? (const char*)(ws + WS_HB8) : (const char*)HB; S.Bt = (const char*)(ws + WS_WQKV); S.K = ATTN_FP8 ? 512 : 1024;
        pg8::EpiQKV E{SSP2, a.in[15], (const u16*)(ws + WS_ROPE), (u16*)(ws + WS_Q), (u16*)(ws + WS_K), (u16*)(ws + WS_V), ATTN_FP8 ? 1.0f / (S8_A * S8_W) : 1.0f}; pg8::gemm_phase<pg8::EpiQKV, pg8::DenseSched, false, ATTN_FP8 != 0>(lds, ATTN_FP8 ? 512 : 1024, S, E); }
    SEAM(7);
    if (IN(8)) REPS(8) attn_phase(a, lds, G, vcu);
    SEAM(8);
    if (IN(9)) { pg8::DenseSched S; S.o.init(M / 256, 4, G, bx); S.A = (const char*)(ws + WS_ATT); S.Bt = (const char*)(ws + WS_WO); S.K = ATTN_FP8 ? 512 : 1024;
        pg8::EpiRes E{nullptr, HB, a.in[18], SSP3, MOE_FP8 ? (unsigned char*)(ws + WS_HB8) : nullptr, ATTN_FP8 ? 1.0f / (S8_O * S8_W) : 1.0f}; pg8::gemm_phase<pg8::EpiRes, pg8::DenseSched, false, ATTN_FP8 != 0>(lds, ATTN_FP8 ? 512 : 1024, S, E); }
    SEAM(9);
    if (IN(10)) { for (int g = vcu; g < M / 64; g += G) router_group(HB, (const float*)(ws + WS_WR), SSP3, cnt, list, gatew, g, (float*)(lds_raw + LX_ROUT)); }
    SEAM(10);
    LAS int* tbl = (LAS int*)(lds + LX_TBL);
    if (IN(11) || IN(12)) { if (tid == 0) { int acc = 0; for (int e = 0; e < 8; ++e) { const int c = (int)__hip_atomic_load(cnt + e, __ATOMIC_RELAXED, __HIP_MEMORY_SCOPE_AGENT); tbl[e] = c; tbl[8 + e] = acc; acc += (c + 255) >> 8; } tbl[16] = acc; } __syncthreads(); }
    if (IN(11)) REPS(11) { pg8::MoeSched S; S.o.init(__builtin_amdgcn_readfirstlane(tbl[16]), 7168 / 256, G, bx); S.A = MOE_FP8 ? (const char*)(ws + WS_HB8) : (const char*)HB; S.Bt = (const char*)(ws + WS_WGU2); S.K = MOE_FP8 ? 512 : 1024; S.bstride = (size_t)7168 * 1024 * (MOE_FP8 ? 1 : 2); S.list = list; S.tbl = tbl;
        pg8::EpiMoeUp E{SSP3, list, gatew, tbl, (u16*)(ws + WS_ACT2)}; pg8::gemm_phase<pg8::EpiMoeUp, pg8::MoeSched, true, MOE_FP8 != 0>(lds, MOE_FP8 ? 512 : 1024, S, E); }
    SEAM(11);
    if (IN(12)) REPS(12) { pg8::MoeSched S; S.o.init(__builtin_amdgcn_readfirstlane(tbl[16]), 4, G, bx); S.A = (const char*)(ws + WS_ACT2); S.Bt = (const char*)(ws + WS_WD2); S.K = MOE_FP8 ? DFF / 2 : DFF; S.bstride = (size_t)1024 * DFF * (MOE_FP8 ? 1 : 2); S.list = nullptr; S.tbl = tbl;
        pg8::EpiMoeDown E{list, tbl, (u16*)(ws + WS_MO)}; pg8::gemm_phase<pg8::EpiMoeDown, pg8::MoeSched, false, MOE_FP8 != 0>(lds, MOE_FP8 ? DFF / 2 : DFF, S, E); }
    SEAM(12);
    if (IN(13)) final_body(H, HB, (const u16*)(ws + WS_MO), a.in[4], gw, NGW, lane);
#undef IN
#undef SEAM
}
#ifndef MK_MODE
#define MK_MODE 1
#endif
#ifndef FASTMASK
#define FASTMASK 0x3fff
#endif
extern "C" void kernel_launch(void* const* d_in, const int* in_sizes, int n_in, void* d_out, int out_size, void* d_ws, size_t ws_size, hipStream_t stream) {
    if (n_in != 26 || out_size != M * D || ws_size < WS_END) { fprintf(stderr, "kernel_launch: unexpected shapes (n_in %d out %d ws %zu, need %zu)\n", n_in, out_size, ws_size, (size_t)WS_END); return; }
    static int grid = 0;
    if (grid == 0) {
        int dev = 0, cus = 0, per_cu = 0;
        if (hipGetDevice(&dev) != hipSuccess || hipDeviceGetAttribute(&cus, hipDeviceAttributeMultiprocessorCount, dev) != hipSuccess) { grid = -1; return; }
        if (hipFuncSetAttribute((const void*)mega, hipFuncAttributeMaxDynamicSharedMemorySize, LDS_BYTES) != hipSuccess) { fprintf(stderr, "kernel_launch: hipFuncSetAttribute failed\n"); grid = -1; return; }
        if (hipOccupancyMaxActiveBlocksPerMultiprocessor(&per_cu, (const void*)mega, 512, LDS_BYTES) != hipSuccess || per_cu < 1) { fprintf(stderr, "kernel_launch: occupancy query says %d\n", per_cu); per_cu = 1; }
        (void)hipGetLastError();
        grid = cus;
    }
    if (grid < 0) return;
    unsigned char* ws = (unsigned char*)d_ws;
    (void)hipMemsetAsync(ws + WS_CTL, 0, CTL_BYTES, stream);
    Args a{};
    for (int i = 0; i < 26; ++i) a.in[i] = (const float*)d_in[i];
    a.pos = (const int*)d_in[1]; a.out = (float*)d_out; a.ws = ws; a.ph_lo = 0; a.ph_hi = NPHASE;
#if MK_MODE == 1
    hipLaunchKernelGGL(mega, dim3(grid), dim3(512), LDS_BYTES, stream, a);
#else
    float* H = (float*)d_out; u16* HB = (u16*)(ws + WS_HB);
    float* SSP0 = (float*)(ws + WS_SSP), *SSP1 = SSP0 + 65536, *SSP2 = SSP1 + 65536, *SSP3 = SSP2 + 65536;
    const unsigned* cnt = (const unsigned*)(ws + WS_CTL) + CW_CNT; const int* list = (const int*)(ws + WS_LIST); const float* gatew = (const float*)(ws + WS_GATEW);
    for (int p = 0; p < NPHASE; ++p) {
        if ((FASTMASK >> p) & 1) { a.ph_lo = p; a.ph_hi = p + 1; hipLaunchKernelGGL(mega, dim3(grid), dim3(512), LDS_BYTES, stream, a); continue; }
        switch (p) {
        case 0: k_tables<<<256, 256, 0, stream>>>(a); k_convert<<<2048, 256, 0, stream>>>(a); k_rowprep<<<1024, 256, 0, stream>>>(a.in[0], HB, SSP0); break;
        case 1: { NE_Proj e{HB, (const u16*)(ws + WS_WIN), SSP0, (u16*)(ws + WS_Y), (u16*)(ws + WS_XB)}; k_ngemm<<<dim3(2048 / 64, M / 64), 256, 0, stream>>>(e, 1024); } break;
        case 2: k_conv1d<<<(M * D) / 256, 256, 0, stream>>>((const u16*)(ws + WS_XB), a.in[6], a.in[7], (u16*)(ws + WS_XC));
                { NE_Gates e{(const u16*)(ws + WS_XC), (const u16*)(ws + WS_WAX), a.in[9], a.in[11], (const float*)(ws + WS_SPL), (float*)d_out, (float*)(ws + WS_BX)}; k_ngemm<<<dim3(128 / 64, M / 64, 8), 256, 0, stream>>>(e, 128); } break;
        case 3: k_scan_seq<<<16, 64, 0, stream>>>((const float*)d_out, (const float*)(ws + WS_BX), (const u16*)(ws + WS_Y), (u16*)(ws + WS_G)); break;
        case 4: { NE_Res e{(const u16*)(ws + WS_G), (const u16*)(ws + WS_WOUT), 1024, a.in[0], H, HB, nullptr}; k_ngemm<<<dim3(1024 / 64, M / 64), 256, 0, stream>>>(e, 1024); } k_ssp<<<1024, 256, 0, stream>>>(H, SSP1); break;
        case 5: { NE_GateUp e{HB, (const u16*)(ws + WS_WGU), SSP1, (u16*)(ws + WS_ACT)}; k_ngemm<<<dim3(DFF / 64, M / 64), 256, 0, stream>>>(e, 1024); } break;
        case 6: { NE_Res e{(const u16*)(ws + WS_ACT), (const u16*)(ws + WS_WD), DFF, nullptr, H, HB, nullptr}; k_ngemm<<<dim3(1024 / 64, M / 64), 256, 0, stream>>>(e, DFF); } k_ssp<<<1024, 256, 0, stream>>>(H, SSP2); break;
        case 7: { NE_QKV e{HB, (const u16*)(ws + WS_WQKV), SSP2, a.in[15], (const u16*)(ws + WS_ROPE), (u16*)(ws + WS_Q), (u16*)(ws + WS_K), (u16*)(ws + WS_V)}; k_ngemm<<<dim3(NQKV / 64, M / 64), 256, 0, stream>>>(e, 1024); } break;
        case 8: k_attn_ref<<<(M * NH) / 64, 64, 0, stream>>>((const u16*)(ws + WS_Q), (const u16*)(ws + WS_K), (const u16*)(ws + WS_V), a.in[16], (u16*)(ws + WS_ATT)); break;
        case 9: { NE_Res e{(const u16*)(ws + WS_ATT), (const u16*)(ws + WS_WO), 1024, nullptr, H, HB, a.in[18]}; k_ngemm<<<dim3(1024 / 64, M / 64), 256, 0, stream>>>(e, 1024); } k_ssp<<<1024, 256, 0, stream>>>(H, SSP3); break;
        case 10: k_router<<<256, 512, 0, stream>>>(a); break;
        case 11: { NE_MoeUp e{HB, (const u16*)(ws + WS_WGU2), SSP3, cnt, list, gatew, (u16*)(ws + WS_ACT2)}; k_ngemm<<<dim3(DFF / 64, MAXSLOT / 64), 256, 0, stream>>>(e, 1024); } break;
        case 12: { NE_MoeDown e{(const u16*)(ws + WS_ACT2), (const u16*)(ws + WS_WD2), cnt, list, (u16*)(ws + WS_MO)}; k_ngemm<<<dim3(1024 / 64, MAXSLOT / 64), 256, 0, stream>>>(e, DFF); } break;
        case 13: k_final<<<1024, 256, 0, stream>>>(H, HB, (const u16*)(ws + WS_MO), a.in[4]); break;
        }
    }
#endif
}
```

```cpp
#include <hip/hip_runtime.h>
#include <stdint.h>
#include <stdio.h>

typedef unsigned short u16;
typedef short bf16x8 __attribute__((ext_vector_type(8)));
typedef float f32x4 __attribute__((ext_vector_type(4)));
typedef unsigned u32x4 __attribute__((ext_vector_type(4)));
typedef unsigned u32x2 __attribute__((ext_vector_type(2)));

constexpr int M = 16384, D = 1024, DFF = 3584, NE = 8, NBLK = 8, RB = 128;
constexpr int NH = 16, NKV = 4, HD = 64, KVD = 256, NQKV = 1536, WIN = 128;
constexpr int MAXSLOT = 34816;
constexpr float EPS = 1e-6f;
#ifndef MOE_FP8
#define MOE_FP8 1
#endif
constexpr float S8_A = 16.0f, S8_W = 256.0f, S8_ACT = 8.0f, S8_WD = 512.0f;
#ifndef ATTN_FP8
#define ATTN_FP8 1
#endif
constexpr float S8_O = 32.0f;
constexpr float LOG2E = 1.4426950408889634f;

constexpr size_t MiB = 1u << 20;
constexpr size_t WS_CTL = 0, CTL_BYTES = 1 * MiB;
constexpr size_t WS_ROPE = 1 * MiB;
constexpr size_t WS_SSP = 2 * MiB;
constexpr size_t WS_SPL = 3 * MiB;
constexpr size_t WS_WR = 3 * MiB + 64 * 1024;
constexpr size_t WS_CAR = 3 * MiB + 128 * 1024;
constexpr size_t WS_LIST = 4 * MiB;
constexpr size_t WS_GATEW = WS_LIST;
constexpr size_t WS_WGU2 = 6 * MiB;
constexpr size_t WS_HB8 = 70 * MiB;
constexpr size_t WS_WD2 = 118 * MiB;
constexpr size_t WS_HB = 174 * MiB;
constexpr size_t WS_X = 206 * MiB;
constexpr size_t WS_WIN = WS_X;
constexpr size_t WS_WAX = WS_X + 4 * MiB;
constexpr size_t WS_WOUT = WS_X + 5 * MiB;
constexpr size_t WS_WGU = WS_X + 7 * MiB;
constexpr size_t WS_WD = WS_X + 21 * MiB;
constexpr size_t WS_WQKV = WS_X + 28 * MiB;
constexpr size_t WS_WO = WS_X + 31 * MiB;
constexpr size_t WS_Y = WS_X + 33 * MiB;
constexpr size_t WS_XB = WS_Y + 32 * MiB;
constexpr size_t WS_G = WS_XB + 32 * MiB;
constexpr size_t WS_ACT = WS_G + 32 * MiB;
constexpr size_t WS_XC = WS_ACT;
constexpr size_t WS_BX = WS_ACT + 32 * MiB;
constexpr size_t WS_Q = WS_Y;
constexpr size_t WS_K = WS_Y + 32 * MiB;
constexpr size_t WS_V = WS_K + 8 * MiB;
constexpr size_t WS_ATT = WS_V + 8 * MiB;
constexpr size_t WS_ACT2 = WS_X;
constexpr size_t WS_MO = WS_WGU2;
constexpr size_t WS_END = 447 * MiB;
static_assert(WS_ACT + (size_t)M * DFF * 2 <= WS_END && WS_ACT2 + (size_t)MAXSLOT * DFF * 2 <= WS_END, "ws map");
constexpr int CW_CNT = 64;

__device__ __forceinline__ unsigned f2bf(float f) { unsigned u = __builtin_bit_cast(unsigned, f); return (u + 0x7fffu + ((u >> 16) & 1u)) >> 16; }
__device__ __forceinline__ float bf2f(unsigned b) { return __builtin_bit_cast(float, b << 16); }
__device__ __forceinline__ float u2f(unsigned b) { return __builtin_bit_cast(float, b); }
__device__ __forceinline__ int lane_now() { int l; asm volatile("v_mbcnt_lo_u32_b32 %0, -1, 0\n\tv_mbcnt_hi_u32_b32 %0, -1, %0" : "=v"(l)); return l; }
__device__ __forceinline__ unsigned pk2(float lo, float hi) { return f2bf(lo) | (f2bf(hi) << 16); }
__device__ __forceinline__ float wave_sum(float v) {
#pragma unroll
    for (int o = 1; o < 64; o <<= 1) v += __shfl_xor(v, o);
    return v;
}
__device__ __forceinline__ float sigmoidf_(float x) { return 1.0f / (1.0f + __expf(-x)); }
__device__ __forceinline__ float gelu_tanh(float x) { const float z = 0.7978845608028654f * (x + 0.044715f * x * x * x); return x / (1.0f + __expf(-2.0f * z)); }
__device__ __forceinline__ float silu_(float x) { return x / (1.0f + __expf(-x)); }
__device__ __forceinline__ float one_minus_exp(float x) {
    if (x > -0.3f) { float p = 1.0f / 720.0f; p = p * x + 1.0f / 120.0f; p = p * x + 1.0f / 24.0f; p = p * x + 1.0f / 6.0f; p = p * x + 0.5f; p = p * x + 1.0f; return -x * p; }
    return 1.0f - __expf(x);
}
__device__ __forceinline__ float rstd_of(const float* ssp, int row) { const f32x4 p = *(const f32x4*)(ssp + 4 * (size_t)row); return rsqrtf(((p[0] + p[1]) + (p[2] + p[3])) * (1.0f / D) + EPS); }

struct Args {
    const float* in[26]; const int* pos; float* out; unsigned char* ws; int ph_lo, ph_hi;
};

__device__ __forceinline__ void tables_body(const Args& a, int gt, int NT) {
    u16* rope = (u16*)(a.ws + WS_ROPE);
    for (int i = gt; i < M * 8; i += NT) { const int t = i >> 3, f = i & 7;
        const double inv = f == 0 ? 1.0 : f == 1 ? 0.19392274474868576 : f == 2 ? 0.03760603093086393 : f == 3 ? 0.007292664737217109 : f == 4 ? 0.001414213562373095 : f == 5 ? 0.0002742481756762073 : f == 6 ? 5.318295896944988e-05 : 1.031338537721246e-05;
        const double ang = (double)a.pos[t] * inv; const double kq = __builtin_rint(ang * 0.6366197723675814); const double r = ang - kq * 1.5707963267948966, r2 = r * r;
        double s = -1.0 / 39916800.0; s = s * r2 + 1.0 / 362880.0; s = s * r2 - 1.0 / 5040.0; s = s * r2 + 1.0 / 120.0; s = s * r2 - 1.0 / 6.0; s = s * r2 + 1.0; s *= r;
        double c = 1.0 / 479001600.0; c = c * r2 - 1.0 / 3628800.0; c = c * r2 + 1.0 / 40320.0; c = c * r2 - 1.0 / 720.0; c = c * r2 + 1.0 / 24.0; c = c * r2 - 0.5; c = c * r2 + 1.0;
        const int q = (int)((long long)kq & 3); const double cs = q == 0 ? c : q == 1 ? -s : q == 2 ? -c : s, sn = q == 0 ? s : q == 1 ? c : q == 2 ? -s : -c;
        rope[t * 16 + f] = (u16)f2bf((float)cs); rope[t * 16 + 8 + f] = (u16)f2bf((float)sn); }
    float* spl = (float*)(a.ws + WS_SPL);
    for (int i = gt; i < 1024; i += NT) { const float z = __expf(-a.in[12][i]);
        float p = 0.2f; p = p * z - 0.25f; p = p * z + 1.0f / 3.0f; p = p * z - 0.5f; p = p * z + 1.0f; spl[i] = z < 0.05f ? z * p : __logf(1.0f + z); }
    float* wr = (float*)(a.ws + WS_WR);
    for (int i = gt; i < 8 * 1024; i += NT) { const int e = i >> 10, k = i & 1023; wr[i] = a.in[3][1024 + k] * a.in[22][k * 8 + e]; }
}
__global__ void k_tables(Args a) { tables_body(a, blockIdx.x * blockDim.x + threadIdx.x, gridDim.x * blockDim.x); }

struct ConvJob { const float* W; const float* g; u16* WT; int K, N, mode, row_off; float s8; };
__device__ __forceinline__ bool conv_job(const Args& a, int j, ConvJob& c) {
    unsigned char* ws = a.ws;
    c.g = nullptr; c.mode = 0; c.row_off = 0; c.s8 = 0.f;
    if (j == 0) { c.W = a.in[5]; c.g = a.in[2]; c.WT = (u16*)(ws + WS_WIN); c.K = 1024; c.N = 2048; return true; }
    if (j == 1) { c.W = a.in[13]; c.WT = (u16*)(ws + WS_WOUT); c.K = 1024; c.N = 1024; return true; }
    if (j == 2) { c.W = a.in[19]; c.g = a.in[3]; c.WT = (u16*)(ws + WS_WGU); c.K = 1024; c.N = DFF; c.mode = 1; return true; }
    if (j == 3) { c.W = a.in[20]; c.g = a.in[3]; c.WT = (u16*)(ws + WS_WGU); c.K = 1024; c.N = DFF; c.mode = 2; return true; }
    if (j == 4) { c.W = a.in[21]; c.WT = (u16*)(ws + WS_WD); c.K = DFF; c.N = 1024; return true; }
    if (j == 5) { c.W = a.in[14]; c.g = a.in[2] + 1024; c.WT = (u16*)(ws + WS_WQKV); c.K = 1024; c.N = NQKV; c.s8 = ATTN_FP8 ? S8_W : 0.f; return true; }
    if (j == 6) { c.W = a.in[17]; c.WT = (u16*)(ws + WS_WO); c.K = 1024; c.N = 1024; c.s8 = ATTN_FP8 ? S8_W : 0.f; return true; }
    j -= 7;
    if (j < 16) { const int n = j >> 1, x = j & 1; c.W = a.in[x ? 10 : 8] + (size_t)n * 128 * 128; c.WT = (u16*)(ws + WS_WAX) + (size_t)n * 256 * 128; c.K = 128; c.N = 128; c.row_off = x * 128; return true; }
    j -= 16;
    if (j < 16) { const int e = j >> 1, x = j & 1; c.W = a.in[x ? 24 : 23] + (size_t)e * 1024 * DFF; c.g = a.in[3] + 1024; c.WT = (u16*)(ws + WS_WGU2 + (size_t)e * 7168 * 1024 * (MOE_FP8 ? 1 : 2)); c.K = 1024; c.N = DFF; c.mode = 1 + x; c.s8 = MOE_FP8 ? S8_W : 0.f; return true; }
    j -= 16;
    if (j < 8) { c.W = a.in[25] + (size_t)j * DFF * 1024; c.WT = (u16*)(ws + WS_WD2 + (size_t)j * 1024 * DFF * (MOE_FP8 ? 1 : 2)); c.K = DFF; c.N = 1024; c.s8 = MOE_FP8 ? S8_WD : 0.f; return true; }
    return false;
}
constexpr int NJOBS = 7 + 16 + 16 + 8;
__device__ __forceinline__ void conv_item(const ConvJob& c, float*, int item, int lane) {
    const int nblk = c.N / 64, kb = item / nblk, nb = item % nblk, r4 = lane >> 4, cc = lane & 15, k0 = 64 * kb + 16 * r4, n0 = 64 * nb + 4 * cc;
    f32x4 v[16];
    const float* src = c.W + (size_t)k0 * c.N + n0;
#pragma unroll
    for (int i = 0; i < 16; ++i) v[i] = __builtin_nontemporal_load((const f32x4*)(src + (size_t)i * c.N));
    if (c.g) { const f32x4 g0 = *(const f32x4*)(c.g + k0), g1 = *(const f32x4*)(c.g + k0 + 4), g2 = *(const f32x4*)(c.g + k0 + 8), g3 = *(const f32x4*)(c.g + k0 + 12);
#pragma unroll
        for (int i = 0; i < 4; ++i) { v[i] = v[i] * g0[i]; v[4 + i] = v[4 + i] * g1[i]; v[8 + i] = v[8 + i] * g2[i]; v[12 + i] = v[12 + i] * g3[i]; } }
    if (c.s8 != 0.f) {
#pragma unroll
        for (int j = 0; j < 4; ++j) { const int nn = n0 + j; const int r = c.mode == 0 ? c.row_off + nn : 256 * (nn >> 7) + (nn & 127) + (c.mode == 2 ? 128 : 0);
            u32x4 o;
#pragma unroll
            for (int q = 0; q < 4; ++q) { float t[4];
#pragma unroll
                for (int i = 0; i < 4; ++i) t[i] = __builtin_fminf(__builtin_fmaxf(v[4 * q + i][j] * c.s8, -448.0f), 448.0f);
                int w = 0; w = __builtin_amdgcn_cvt_pk_fp8_f32(t[0], t[1], w, false); w = __builtin_amdgcn_cvt_pk_fp8_f32(t[2], t[3], w, true); o[q] = (unsigned)w; }
            *(u32x4*)((unsigned char*)c.WT + (size_t)r * c.K + k0) = o; }
        return; }
#pragma unroll
    for (int j = 0; j < 4; ++j) { const int nn = n0 + j; const int r = c.mode == 0 ? c.row_off + nn : 256 * (nn >> 7) + (nn & 127) + (c.mode == 2 ? 128 : 0);
        u32x4 o0, o1; o0.x = pk2(v[0][j], v[1][j]); o0.y = pk2(v[2][j], v[3][j]); o0.z = pk2(v[4][j], v[5][j]); o0.w = pk2(v[6][j], v[7][j]);
        o1.x = pk2(v[8][j], v[9][j]); o1.y = pk2(v[10][j], v[11][j]); o1.z = pk2(v[12][j], v[13][j]); o1.w = pk2(v[14][j], v[15][j]);
        u32x4* dst = (u32x4*)(c.WT + (size_t)r * c.K + k0); dst[0] = o0; dst[1] = o1; }
}
constexpr int N_EARLY = 1, N_DEFER = 46;
__device__ __forceinline__ int early_job(int e) { return e; }
__device__ __forceinline__ int defer_job(int d) { return d < 16 ? 7 + d : d == 16 ? 1 : d < 19 ? d - 15 : d == 19 ? 4 : d < 22 ? d - 15 : d + 1; }
__device__ __forceinline__ void convert_body(const Args& a, float* scr, int gw, int NGW, int lane, bool all) {
    int base = 0;
    const int nj = all ? NJOBS : N_EARLY;
    for (int e = 0; e < nj; ++e) { ConvJob c; if (!conv_job(a, all ? e : early_job(e), c)) break; const int items = (c.K / 64) * (c.N / 64);
        int first = (gw - base) % NGW; if (first < 0) first += NGW;
        for (int it = first; it < items; it += NGW) conv_item(c, scr, it, lane);
        base = (base + items) % NGW; }
}
struct DeferState { int d, base, it; };
__device__ __forceinline__ bool defer_step(const Args& a, DeferState& st, int gw, int NGW, int lane, int dlimit) {
    while (st.d < dlimit) {
        ConvJob c; conv_job(a, defer_job(st.d), c); const int items = (c.K / 64) * (c.N / 64);
        if (st.it < 0) { int first = (gw - st.base) % NGW; if (first < 0) first += NGW; st.it = first; }
        if (st.it < items) { conv_item(c, nullptr, st.it, lane); st.it += NGW; return true; }
        st.base = (st.base + items) % NGW; ++st.d; st.it = -1;
    }
    return false;
}
__global__ __launch_bounds__(256) void k_convert(Args a) {
    __shared__ float scr_all[4][64 * 33];
    const int lane = threadIdx.x & 63, w = threadIdx.x >> 6;
    convert_body(a, scr_all[w], blockIdx.x * 4 + w, gridDim.x * 4, lane, true);
}

__device__ __forceinline__ void rowprep_body(const float* x, u16* hb, float* ssp, int gw, int NGW, int lane) {
    for (int r = gw; r < M; r += NGW) {
        const f32x4* xr = (const f32x4*)(x + (size_t)r * D) + lane * 4; float s = 0.f; u32x4 o0, o1;
        f32x4 v0 = xr[0], v1 = xr[1], v2 = xr[2], v3 = xr[3];
        s = (v0[0] * v0[0] + v0[1] * v0[1]) + (v0[2] * v0[2] + v0[3] * v0[3]) + (v1[0] * v1[0] + v1[1] * v1[1]) + (v1[2] * v1[2] + v1[3] * v1[3])
          + (v2[0] * v2[0] + v2[1] * v2[1]) + (v2[2] * v2[2] + v2[3] * v2[3]) + (v3[0] * v3[0] + v3[1] * v3[1]) + (v3[2] * v3[2] + v3[3] * v3[3]);
        o0.x = pk2(v0[0], v0[1]); o0.y = pk2(v0[2], v0[3]); o0.z = pk2(v1[0], v1[1]); o0.w = pk2(v1[2], v1[3]);
        o1.x = pk2(v2[0], v2[1]); o1.y = pk2(v2[2], v2[3]); o1.z = pk2(v3[0], v3[1]); o1.w = pk2(v3[2], v3[3]);
        u32x4* orow = (u32x4*)(hb + (size_t)r * D) + lane * 2; orow[0] = o0; orow[1] = o1;
        s += __shfl_xor(s, 1); s += __shfl_xor(s, 2); s += __shfl_xor(s, 4); s += __shfl_xor(s, 8);
        if ((lane & 15) == 0) ssp[4 * (size_t)r + (lane >> 4)] = s;
    }
}
__global__ __launch_bounds__(256) void k_rowprep(const float* x, u16* hb, float* ssp) { rowprep_body(x, hb, ssp, blockIdx.x * 4 + (threadIdx.x >> 6), gridDim.x * 4, threadIdx.x & 63); }
__global__ __launch_bounds__(256) void k_ssp(const float* h, float* ssp) {
    const int lane = threadIdx.x & 63, gw = blockIdx.x * 4 + (threadIdx.x >> 6), NGW = gridDim.x * 4;
    for (int r = gw; r < M; r += NGW) {
        const f32x4* xr = (const f32x4*)(h + (size_t)r * D) + lane * 4; float s = 0.f;
#pragma unroll
        for (int j = 0; j < 4; ++j) { const f32x4 v = xr[j]; s += (v[0] * v[0] + v[1] * v[1]) + (v[2] * v[2] + v[3] * v[3]); }
        s += __shfl_xor(s, 1); s += __shfl_xor(s, 2); s += __shfl_xor(s, 4); s += __shfl_xor(s, 8);
        if ((lane & 15) == 0) ssp[4 * (size_t)r + (lane >> 4)] = s;
    }
}

__device__ __forceinline__ void slot_info(const unsigned* cnt, int slot, int& e, int& pos, int& n) {
    int base = 0; e = -1; pos = 0; n = 0;
#pragma unroll
    for (int i = 0; i < NE; ++i) { const int c = (int)cnt[i], rows = ((c + 255) >> 8) << 8; if (e < 0 && slot < base + rows) { e = i; pos = slot - base; n = c; } base += rows; }
}

template <class E> __global__ __launch_bounds__(256) void k_ngemm(E e, int K) {
    const int lane = threadIdx.x & 63, w = threadIdx.x >> 6, fr = lane & 15, fq = lane >> 4;
    const int rb = blockIdx.y * 64, r0 = rb + (w >> 1) * 32, c0 = blockIdx.x * 64 + (w & 1) * 32;
    if (!e.tile_ok(rb)) return;
    constexpr int NP = E::PAIR ? 2 : 1;
    const u16* ap[2]; const u16* bp[2][NP];
#pragma unroll
    for (int i = 0; i < 2; ++i) ap[i] = e.a_row(r0 + 16 * i + fr) + 8 * fq;
#pragma unroll
    for (int j = 0; j < 2; ++j)
#pragma unroll
        for (int p = 0; p < NP; ++p) bp[j][p] = e.b_row(c0 + 16 * j + fr, p, rb) + 8 * fq;
    f32x4 acc[2][2][NP];
#pragma unroll
    for (int i = 0; i < 2; ++i)
#pragma unroll
        for (int j = 0; j < 2; ++j)
#pragma unroll
            for (int p = 0; p < NP; ++p) acc[i][j][p] = (f32x4){0.f, 0.f, 0.f, 0.f};
    for (int k = 0; k < K; k += 32) {
        bf16x8 av[2], bv[2][NP];
#pragma unroll
        for (int i = 0; i < 2; ++i) av[i] = *(const bf16x8*)(ap[i] + k);
#pragma unroll
        for (int j = 0; j < 2; ++j)
#pragma unroll
            for (int p = 0; p < NP; ++p) bv[j][p] = *(const bf16x8*)(bp[j][p] + k);
#pragma unroll
        for (int i = 0; i < 2; ++i)
#pragma unroll
            for (int j = 0; j < 2; ++j)
#pragma unroll
                for (int p = 0; p < NP; ++p) acc[i][j][p] = __builtin_amdgcn_mfma_f32_16x16x32_bf16(av[i], bv[j][p], acc[i][j][p], 0, 0, 0);
    }
#pragma unroll
    for (int i = 0; i < 2; ++i)
#pragma unroll
        for (int j = 0; j < 2; ++j)
#pragma unroll
            for (int q = 0; q < 4; ++q) { const float v0 = acc[i][j][0][q], v1 = E::PAIR ? acc[i][j][NP - 1][q] : 0.f; const float pv = __shfl_xor(v0, 8);
                e.store(r0 + 16 * i + 4 * fq + q, c0 + 16 * j + fr, v0, v1, pv); }
}

struct NE_Proj {
    static constexpr bool PAIR = false;
    const u16* A; const u16* Bt; const float* ssp; u16* Y; u16* XB;
    __device__ bool tile_ok(int) const { return true; }
    __device__ const u16* a_row(int r) const { return A + (size_t)r * D; }
    __device__ const u16* b_row(int c, int, int) const { return Bt + (size_t)c * D; }
    __device__ void store(int r, int c, float v, float, float) const { v *= rstd_of(ssp, r); if (c < 1024) Y[(size_t)r * D + c] = (u16)f2bf(gelu_tanh(v)); else XB[(size_t)r * D + c - 1024] = (u16)f2bf(v); }
};
struct NE_Gates {
    static constexpr bool PAIR = true;
    const u16* XC; const u16* WAX; const float* b_a; const float* b_x; const float* spl; float* LA; float* BX;
    __device__ bool tile_ok(int) const { return true; }
    __device__ const u16* a_row(int r) const { return XC + (size_t)r * D + 128 * blockIdx.z; }
    __device__ const u16* b_row(int c, int p, int) const { return WAX + ((size_t)blockIdx.z * 256 + c + 128 * p) * 128; }
    __device__ void store(int r, int c, float vr, float vi, float) const { const int ch = 128 * blockIdx.z + c;
        const float rg = sigmoidf_(vr + b_a[ch]), ig = sigmoidf_(vi + b_x[ch]), la = -8.0f * rg * spl[ch], xc = bf2f(XC[(size_t)r * D + ch]);
        LA[(size_t)r * D + ch] = la; BX[(size_t)r * D + ch] = sqrtf(one_minus_exp(2.0f * la)) * (ig * xc); }
};
struct NE_Res {
    static constexpr bool PAIR = false;
    const u16* A; const u16* Bt; int K; const float* Hin; float* Hout; u16* HB; const float* bias;
    __device__ bool tile_ok(int) const { return true; }
    __device__ const u16* a_row(int r) const { return A + (size_t)r * K; }
    __device__ const u16* b_row(int c, int, int) const { return Bt + (size_t)c * K; }
    __device__ void store(int r, int c, float v, float, float) const { const float h = (Hin ? Hin[(size_t)r * D + c] : bf2f(HB[(size_t)r * D + c])) + v + (bias ? bias[c] : 0.f); Hout[(size_t)r * D + c] = h; HB[(size_t)r * D + c] = (u16)f2bf(h); }
};
struct NE_GateUp {
    static constexpr bool PAIR = true;
    const u16* A; const u16* Bt; const float* ssp; u16* ACT;
    __device__ bool tile_ok(int) const { return true; }
    __device__ const u16* a_row(int r) const { return A + (size_t)r * D; }
    __device__ const u16* b_row(int c, int p, int) const { return Bt + (size_t)(256 * (c >> 7) + (c & 127) + 128 * p) * D; }
    __device__ void store(int r, int c, float g, float u, float) const { const float rs = rstd_of(ssp, r); ACT[(size_t)r * DFF + c] = (u16)f2bf(silu_(rs * g) * (rs * u)); }
};
struct NE_QKV {
    static constexpr bool PAIR = false;
    const u16* A; const u16* Bt; const float* ssp; const float* bias; const u16* rope; u16* Q; u16* Kb; u16* Vb;
    __device__ bool tile_ok(int) const { return true; }
    __device__ const u16* a_row(int r) const { return A + (size_t)r * D; }
    __device__ const u16* b_row(int c, int, int) const { return Bt + (size_t)c * D; }
    __device__ void store(int r, int c, float v, float, float pv) const {
        const float rs = rstd_of(ssp, r); v = rs * v + bias[c]; pv = rs * pv + bias[c ^ 8];
        const int d = c & 63;
        if (c < 1280 && d < 16) { const float cs = bf2f(rope[(size_t)r * 16 + (d & 7)]), sn = bf2f(rope[(size_t)r * 16 + 8 + (d & 7)]); v = d < 8 ? v * cs - pv * sn : v * cs + pv * sn; }
        if (c < 1024) Q[(size_t)r * D + c] = (u16)f2bf(v * (0.125f * LOG2E));
        else if (c < 1280) Kb[(size_t)r * KVD + c - 1024] = (u16)f2bf(v);
        else Vb[(size_t)r * KVD + c - 1280] = (u16)f2bf(v);
    }
};
struct NE_MoeUp {
    static constexpr bool PAIR = true;
    const u16* HB; const u16* WGU2; const float* ssp; const unsigned* cnt; const int* list; const float* gatew; u16* ACT2;
    __device__ bool tile_ok(int rb) const { int e, pos, n; slot_info(cnt, rb, e, pos, n); return e >= 0; }
    __device__ const u16* a_row(int r) const { int e, pos, n; slot_info(cnt, r, e, pos, n); const int tok = (e >= 0 && pos < n) ? (list[((size_t)e * M + pos) * 4] >> 1) : 0; return HB + (size_t)tok * D; }
    __device__ const u16* b_row(int c, int p, int rb) const { int e, pos, n; slot_info(cnt, rb, e, pos, n); return WGU2 + ((size_t)e * 7168 + 256 * (c >> 7) + (c & 127) + 128 * p) * D; }
    __device__ void store(int r, int c, float g, float u, float) const { int e, pos, n; slot_info(cnt, r, e, pos, n); float o = 0.f;
        if (e >= 0 && pos < n) { const int tok = list[((size_t)e * M + pos) * 4] >> 1; const float rs = rstd_of(ssp, tok); o = silu_(rs * g) * (rs * u) * gatew[((size_t)e * M + pos) * 4 + 1]; }
        ACT2[(size_t)r * DFF + c] = (u16)f2bf(o); }
};
struct NE_MoeDown {
    static constexpr bool PAIR = false;
    const u16* ACT2; const u16* WD2; const unsigned* cnt; const int* list; u16* MO;
    __device__ bool tile_ok(int rb) const { int e, pos, n; slot_info(cnt, rb, e, pos, n); return e >= 0; }
    __device__ const u16* a_row(int r) const { return ACT2 + (size_t)r * DFF; }
    __device__ const u16* b_row(int c, int, int rb) const { int e, pos, n; slot_info(cnt, rb, e, pos, n); return WD2 + ((size_t)e * 1024 + c) * DFF; }
    __device__ void store(int r, int c, float v, float, float) const { int e, pos, n; slot_info(cnt, r, e, pos, n);
        if (e >= 0 && pos < n) { const int tk = list[((size_t)e * M + pos) * 4]; MO[((size_t)(tk & 1) * M + (tk >> 1)) * D + c] = (u16)f2bf(v); } }
};

__global__ void k_conv1d(const u16* XB, const float* cw, const float* cb, u16* XC) {
    const size_t i = (size_t)blockIdx.x * blockDim.x + threadIdx.x; if (i >= (size_t)M * D) return;
    const int t = (int)(i >> 10), c = (int)(i & 1023); float s = cb[c];
#pragma unroll
    for (int k = 0; k < 4; ++k) { const int tt = t - 3 + k; if (tt >= 0) s += bf2f(XB[(size_t)tt * D + c]) * cw[k * D + c]; }
    XC[i] = (u16)f2bf(s);
}
__global__ __launch_bounds__(64) void k_scan_seq(const float* LA, const float* BX, const u16* Y, u16* G) {
    const int c = blockIdx.x * 64 + threadIdx.x; float h = 0.f;
    for (int t0 = 0; t0 < M; t0 += 8) {
        float la[8], bx[8], y[8];
#pragma unroll
        for (int j = 0; j < 8; ++j) { la[j] = LA[(size_t)(t0 + j) * D + c]; bx[j] = BX[(size_t)(t0 + j) * D + c]; y[j] = bf2f(Y[(size_t)(t0 + j) * D + c]); }
#pragma unroll
        for (int j = 0; j < 8; ++j) { h = __expf(la[j]) * h + bx[j]; G[(size_t)(t0 + j) * D + c] = (u16)f2bf(h * y[j]); }
    }
}

__global__ __launch_bounds__(64) void k_attn_ref(const u16* Q, const u16* Kb, const u16* Vb, const float* sinks, u16* ATT) {
    const int i = blockIdx.x * 64 + threadIdx.x; const int h = i / M, t = i % M, kvh = h >> 2;
    float q[64], o[64];
#pragma unroll
    for (int d = 0; d < 64; d += 2) { const unsigned w = *(const unsigned*)(Q + (size_t)t * D + 64 * h + d); q[d] = bf2f(w & 0xffffu); q[d + 1] = bf2f(w >> 16); o[d] = 0.f; o[d + 1] = 0.f; }
    float m = sinks[h] * LOG2E, l = 1.0f;
    const int j0 = t - (WIN - 1) > 0 ? t - (WIN - 1) : 0;
    for (int j = j0; j <= t; ++j) {
        const u16* kr = Kb + (size_t)j * KVD + 64 * kvh; const u16* vr = Vb + (size_t)j * KVD + 64 * kvh; float s = 0.f;
#pragma unroll
        for (int d = 0; d < 64; d += 2) { const unsigned w = *(const unsigned*)(kr + d); s += q[d] * bf2f(w & 0xffffu) + q[d + 1] * bf2f(w >> 16); }
        const float mn = fmaxf(m, s), al = exp2f(m - mn), p = exp2f(s - mn); l = l * al + p; m = mn;
#pragma unroll
        for (int d = 0; d < 64; d += 2) { const unsigned w = *(const unsigned*)(vr + d); o[d] = o[d] * al + p * bf2f(w & 0xffffu); o[d + 1] = o[d + 1] * al + p * bf2f(w >> 16); }
    }
    const float il = 1.0f / l;
#pragma unroll
    for (int d = 0; d < 64; d += 2) *(unsigned*)(ATT + (size_t)t * D + 64 * h + d) = pk2(o[d] * il, o[d + 1] * il);
}

__device__ __forceinline__ void router_group(const u16* HB, const float* WR, const float* ssp, unsigned* cnt, int* list, float* gatew, int grp, float* lds  , int w  ) {
    const int lane = lane_now();
    float v[64];
    {   u32x4 h[8][2];
#pragma unroll
        for (int tt = 0; tt < 8; ++tt) { const u32x4* hr = (const u32x4*)(HB + (size_t)(64 * grp + 8 * w + tt) * D + 16 * lane); h[tt][0] = hr[0]; h[tt][1] = hr[1]; }
#pragma unroll
        for (int e = 0; e < 8; ++e) { const f32x4* wr = (const f32x4*)(WR + e * 1024 + 16 * lane); const f32x4 w0 = wr[0], w1 = wr[1], w2 = wr[2], w3 = wr[3];
#pragma unroll
            for (int tt = 0; tt < 8; ++tt) { const u32x4 a = h[tt][0], b = h[tt][1]; float s = 0.f;
                s += bf2f(a.x & 0xffffu) * w0[0]; s += bf2f(a.x >> 16) * w0[1]; s += bf2f(a.y & 0xffffu) * w0[2]; s += bf2f(a.y >> 16) * w0[3];
                s += bf2f(a.z & 0xffffu) * w1[0]; s += bf2f(a.z >> 16) * w1[1]; s += bf2f(a.w & 0xffffu) * w1[2]; s += bf2f(a.w >> 16) * w1[3];
                s += bf2f(b.x & 0xffffu) * w2[0]; s += bf2f(b.x >> 16) * w2[1]; s += bf2f(b.y & 0xffffu) * w2[2]; s += bf2f(b.y >> 16) * w2[3];
                s += bf2f(b.z & 0xffffu) * w3[0]; s += bf2f(b.z >> 16) * w3[1]; s += bf2f(b.w & 0xffffu) * w3[2]; s += bf2f(b.w >> 16) * w3[3];
                v[tt * 8 + e] = s; } }
    }
#pragma unroll
    for (int b = 5; b >= 0; --b) { const int half = 1 << b; const bool up = ((lane >> b) & 1) != 0;
#pragma unroll
        for (int i = 0; i < half; ++i) { const float lo_ = v[i], hi_ = v[i + half]; const float send = up ? lo_ : hi_, keep = up ? hi_ : lo_; v[i] = keep + __shfl_xor(send, half); } }
    float* lgt = lds + 256 + 64 * w; lgt[lane] = v[0];
    __syncthreads();
    if (lane < 8) {
        const int tl = 8 * w + lane, t = 64 * grp + tl;
        const float rs = rstd_of(ssp, t);
        float lg[8];
#pragma unroll
        for (int e = 0; e < 8; ++e) lg[e] = lgt[lane * 8 + e];
        int e1 = 0; float v1 = lg[0];
#pragma unroll
        for (int e = 1; e < 8; ++e) if (lg[e] > v1) { v1 = lg[e]; e1 = e; }
        int e2 = -1; float v2 = -3.0e38f;
#pragma unroll
        for (int e = 0; e < 8; ++e) if (e != e1 && lg[e] > v2) { v2 = lg[e]; e2 = e; }
        const float g1 = 1.0f / (1.0f + __expf((v2 - v1) * rs));
        lds[tl * 4 + 0] = __builtin_bit_cast(float, e1); lds[tl * 4 + 1] = __builtin_bit_cast(float, e2); lds[tl * 4 + 2] = g1; lds[tl * 4 + 3] = 1.0f - g1;
    }
    __syncthreads();
    if (w == 0) {
        const int e1 = __builtin_bit_cast(int, lds[lane * 4 + 0]), e2 = __builtin_bit_cast(int, lds[lane * 4 + 1]); const float g1 = lds[lane * 4 + 2], g2 = lds[lane * 4 + 3];
        const int t = 64 * grp + lane; const unsigned long long lt = (1ull << lane) - 1ull; const float rsl = rstd_of(ssp, t);
        unsigned mycnt = 0u, off1 = 0u, off2 = 0u;
#pragma unroll
        for (int e = 0; e < 8; ++e) {
            const unsigned long long m1 = __ballot(e1 == e), m2 = __ballot(e2 == e); const unsigned n1 = (unsigned)__popcll(m1), n2 = (unsigned)__popcll(m2);
            if (lane == e) mycnt = n1 + n2;
            if (e1 == e) off1 = (unsigned)__popcll(m1 & lt);
            if (e2 == e) off2 = n1 + (unsigned)__popcll(m2 & lt);
        }
        unsigned base = 0u; if (lane < 8 && mycnt > 0u) base = atomicAdd(cnt + lane, mycnt);
        const unsigned b1 = (unsigned)__shfl((int)base, e1), b2 = (unsigned)__shfl((int)base, e2);
        { u32x4 r; r.x = (unsigned)(2 * t); r.y = __builtin_bit_cast(unsigned, g1); r.z = __builtin_bit_cast(unsigned, rsl); r.w = 0u; *(u32x4*)(list + ((size_t)e1 * M + b1 + off1) * 4) = r; }
        { u32x4 r; r.x = (unsigned)(2 * t + 1); r.y = __builtin_bit_cast(unsigned, g2); r.z = __builtin_bit_cast(unsigned, rsl); r.w = 0u; *(u32x4*)(list + ((size_t)e2 * M + b2 + off2) * 4) = r; }
    }
    __syncthreads();
}
__global__ __launch_bounds__(512) void k_router(Args a) {
    __shared__ float lds[64 * 4 + 512];
    unsigned* cnt = (unsigned*)(a.ws + WS_CTL) + CW_CNT;
    for (int g = blockIdx.x; g < M / 64; g += gridDim.x)
        router_group((const u16*)(a.ws + WS_HB), (const float*)(a.ws + WS_WR), (const float*)(a.ws + WS_SSP + 3 * 256 * 1024), cnt, (int*)(a.ws + WS_LIST), (float*)(a.ws + WS_GATEW), g, lds, (int)(threadIdx.x >> 6));
}

__device__ __forceinline__ void final_body(float* H, const u16* HBr, const u16* MO, const float* g, int gw, int NGW, int lane) {
    for (int r = gw; r < M; r += NGW) {
        f32x4 v[4]; float s = 0.f;
#pragma unroll
        for (int j = 0; j < 4; ++j) { const int c = 256 * j + 4 * lane; { const u32x2 hb = *(const u32x2*)(HBr + (size_t)r * D + c); v[j] = (f32x4){bf2f(hb.x & 0xffffu), bf2f(hb.x >> 16), bf2f(hb.y & 0xffffu), bf2f(hb.y >> 16)}; }
            const u32x2 a0 = *(const u32x2*)(MO + (size_t)r * D + c), a1 = *(const u32x2*)(MO + ((size_t)M + r) * D + c);
            v[j][0] += bf2f(a0.x & 0xffffu) + bf2f(a1.x & 0xffffu); v[j][1] += bf2f(a0.x >> 16) + bf2f(a1.x >> 16); v[j][2] += bf2f(a0.y & 0xffffu) + bf2f(a1.y & 0xffffu); v[j][3] += bf2f(a0.y >> 16) + bf2f(a1.y >> 16);
            s += (v[j][0] * v[j][0] + v[j][1] * v[j][1]) + (v[j][2] * v[j][2] + v[j][3] * v[j][3]); }
        const float rs = rsqrtf(wave_sum(s) * (1.0f / D) + EPS);
#pragma unroll
        for (int j = 0; j < 4; ++j) { const int c = 256 * j + 4 * lane; const f32x4 gg = *(const f32x4*)(g + c); *(f32x4*)(H + (size_t)r * D + c) = v[j] * rs * gg; }
    }
}
__global__ __launch_bounds__(256) void k_final(float* H, const u16* HBr, const u16* MO, const float* g) { final_body(H, HBr, MO, g, blockIdx.x * 4 + (threadIdx.x >> 6), gridDim.x * 4, threadIdx.x & 63); }

#define LAS __attribute__((address_space(3)))
typedef float f32x16 __attribute__((ext_vector_type(16)));
typedef short s16x4 __attribute__((ext_vector_type(4)));
typedef float f32x2v_t __attribute__((ext_vector_type(2)));
__device__ __forceinline__ unsigned cvt_pk_bf16(float lo, float hi) { unsigned r; asm volatile("v_cvt_pk_bf16_f32 %0, %1, %2" : "=v"(r) : "v"(lo), "v"(hi)); return r; }
__device__ __forceinline__ float fexp2(float x) { return __builtin_amdgcn_exp2f(x); }
__device__ __forceinline__ float frcp(float x) { return __builtin_amdgcn_rcpf(x); }
__device__ __forceinline__ float fsigmoid(float x) { return frcp(1.0f + fexp2(-LOG2E * x)); }
__device__ __forceinline__ float fsilu(float x) { return x * frcp(1.0f + fexp2(-LOG2E * x)); }
__device__ __forceinline__ float fgelu_tanh(float x) { const float z = 0.7978845608028654f * (x + 0.044715f * x * x * x); return x * frcp(1.0f + fexp2(-2.0f * LOG2E * z)); }

__device__ __forceinline__ u32x2 pk8_fp8(const float (&o)[8], float sc) {
    float t[8];
#pragma unroll
    for (int i = 0; i < 8; ++i) t[i] = __builtin_fminf(__builtin_fmaxf(o[i] * sc, -448.0f), 448.0f);
    int w0 = 0, w1 = 0; w0 = __builtin_amdgcn_cvt_pk_fp8_f32(t[0], t[1], w0, false); w0 = __builtin_amdgcn_cvt_pk_fp8_f32(t[2], t[3], w0, true);
    w1 = __builtin_amdgcn_cvt_pk_fp8_f32(t[4], t[5], w1, false); w1 = __builtin_amdgcn_cvt_pk_fp8_f32(t[6], t[7], w1, true);
    u32x2 r; r.x = (unsigned)w0; r.y = (unsigned)w1; return r;
}
typedef float f32x2p __attribute__((ext_vector_type(2)));
__device__ __forceinline__ f32x2p silu_mul2(f32x2p g, f32x2p u, float c1, float k) {
    const f32x2p ea = g * c1; f32x2p e; e.x = fexp2(ea.x); e.y = fexp2(ea.y);
    const f32x2p d = e * k + k; f32x2p r; r.x = frcp(d.x); r.y = frcp(d.y);
    return (g * u) * r;
}
__device__ __forceinline__ f32x2p gelu_tanh2(f32x2p x) {
    const f32x2p x2 = x * x, inner = x * (x2 * 0.044715f + 1.0f), ea = inner * (-2.0f * LOG2E * 0.7978845608028654f);
    f32x2p e; e.x = fexp2(ea.x); e.y = fexp2(ea.y); const f32x2p d = e + 1.0f; f32x2p r; r.x = frcp(d.x); r.y = frcp(d.y);
    return x * r;
}
constexpr int RING_BYTES = 131072;
constexpr int LX_P = RING_BYTES;
constexpr int LX_TBL = RING_BYTES + 4096;
constexpr int LX_ROUT = RING_BYTES + 8192;
constexpr int LX_MISC = RING_BYTES + 12288;
constexpr int LDS_BYTES = 147456;

namespace pg8 {
constexpr int BM = 256, BK = 64, HALF = 128, HTB = HALF * BK * 2, STAGE_BYTES = 8 * HTB, NXCD = 8;
__device__ __forceinline__ int lds_byte(int r, int c) { const int st = (r >> 4) * 2 + (c >> 5), rr = r & 15, cc = c & 31, ob = rr * 64 + cc * 2; return st * 1024 + (ob ^ (((ob >> 9) & 1) << 5)); }
__device__ __forceinline__ void stage_rc(int b, int& R, int& C) { const int st = b / 1024, sb = b % 1024, swz = sb ^ (((sb >> 9) & 1) << 5); R = (st >> 1) * 16 + swz / 64; C = (st & 1) * 32 + (swz % 64) / 2; }
__device__ __forceinline__ int perm32(int rho) { const int n = rho >> 4, i = rho & 15; return 8 * (i >> 2) + 4 * n + (i & 3); }

struct Unit { int pm, pn, e, kb, ke; };
struct TileOrder {
    int nM, nN, nwg, G, c, WGM;
    __device__ __forceinline__ void init(int nM_, int nN_, int G_, int c_, int wgm = 4) { nM = nM_; nN = nN_; nwg = nM * nN; G = G_; c = c_; WGM = wgm; }
    __device__ __forceinline__ bool next_tile(int i, int& pm, int& pn) const {
        const long L = (long)i * G + c; if (L >= nwg) return false;
        int wgid = (int)L; { const int q = nwg / NXCD, r = nwg % NXCD, xcd = wgid % NXCD, off = wgid / NXCD; wgid = (xcd < r ? xcd * (q + 1) : r * (q + 1) + (xcd - r) * q) + off; }
        const int nig = WGM * nN, gid = wgid / nig, fm = gid * WGM, gsz = (nM - fm) < WGM ? (nM - fm) : WGM;
        const int w2 = wgid % nig; if (gsz == WGM) { pm = fm + (w2 & (WGM - 1)); pn = w2 / WGM; } else { pm = fm + (w2 % gsz); pn = w2 / gsz; }
        return true;
    }
};
struct DenseSched {
    static constexpr bool SK = false;
    TileOrder o; const char* A; const char* Bt; int K;
    __device__ __forceinline__ bool next(int i, Unit& u) const { u.e = 0; return o.next_tile(i, u.pm, u.pn); }
    __device__ __forceinline__ const char* a_base(const Unit& u) const { return A + (size_t)u.pm * 256 * K * 2; }
    __device__ __forceinline__ const char* b_base(const Unit& u) const { return Bt + (size_t)u.pn * 256 * K * 2; }
    __device__ __forceinline__ int a_raw(const Unit&, int) const { return 0; }
    __device__ __forceinline__ unsigned a_cvt(int) const { return 0u; }
};
struct MoeSched {
    static constexpr bool SK = false;
    TileOrder o; const char* A; const char* Bt; int K; size_t bstride; const int* list; const LAS int* tbl;
    __device__ __forceinline__ bool next(int i, Unit& u) const {
        if (!o.next_tile(i, u.pm, u.pn)) return false;
        int e = 0;
#pragma unroll
        for (int j = 1; j < 8; ++j) e += (u.pm >= tbl[8 + j]) ? 1 : 0;
        u.e = __builtin_amdgcn_readfirstlane(e); return true;
    }
    __device__ __forceinline__ const char* a_base(const Unit& u) const { return list ? A : A + (size_t)u.pm * 256 * K * 2; }
    __device__ __forceinline__ const char* b_base(const Unit& u) const { return Bt + (size_t)u.e * bstride + (size_t)u.pn * 256 * K * 2; }
    __device__ __forceinline__ int a_raw(const Unit& u, int rl) const {
        const int pos = (u.pm - tbl[8 + u.e]) * 256 + rl; return list[((size_t)u.e * M + (pos < tbl[u.e] ? pos : 0)) * 4]; }
    __device__ __forceinline__ unsigned a_cvt(int raw) const { return (unsigned)(raw >> 1) * (unsigned)(K * 2); }
};
struct MoeSchedSK {
    static constexpr bool SK = true;
    const char* A; const char* Bt; int K; size_t bstride; const LAS int* tbl; int nM, j, s0, s1, IT, slot; float* part; unsigned* flags;
    __device__ __forceinline__ void init(int nM_, int bx, int K_) { nM = nM_; K = K_; IT = K_ >> 7; j = bx >> 3; const int x = bx & 7, T = ((nM_ + 7) >> 3) * IT; s0 = x * T / 8; s1 = (x + 1) * T / 8; slot = bx; }
    __device__ __forceinline__ bool next(int i, Unit& u) const {
        const int su0 = s0 / IT, su = su0 + i;
        if (su * IT >= s1) return false;
        u.pm = 8 * su + (j & 7); u.pn = j >> 3;
        if (u.pm >= nM) return false;
        u.kb = i == 0 ? s0 - su0 * IT : 0; const int rem = s1 - su * IT; u.ke = rem < IT ? rem : IT;
        int e = 0;
#pragma unroll
        for (int q = 1; q < 8; ++q) e += (u.pm >= tbl[8 + q]) ? 1 : 0;
        u.e = __builtin_amdgcn_readfirstlane(e); return true;
    }
    __device__ __forceinline__ const char* a_base(const Unit& u) const { return A + (size_t)u.pm * 256 * K * 2 + (size_t)u.kb * 256; }
    __device__ __forceinline__ const char* b_base(const Unit& u) const { return Bt + (size_t)u.e * bstride + (size_t)u.pn * 256 * K * 2 + (size_t)u.kb * 256; }
    __device__ __forceinline__ int a_raw(const Unit&, int) const { return 0; }
    __device__ __forceinline__ unsigned a_cvt(int) const { return 0u; }
};
struct EpiCtx { int wr, wc, fr, fq, tid; LAS unsigned char* lds; };
typedef int i32x4 __attribute__((ext_vector_type(4)));
typedef int i32x8 __attribute__((ext_vector_type(8)));
__device__ __forceinline__ i32x8 cat8(bf16x8 lo, bf16x8 hi) { return __builtin_shufflevector(__builtin_bit_cast(i32x4, lo), __builtin_bit_cast(i32x4, hi), 0, 1, 2, 3, 4, 5, 6, 7); }
#define ACC_T const f32x4 (&acc)[2][2][4][2]

struct EpiProj {
    static constexpr bool PRELOAD = false;
    const float* ssp; u16* Y; u16* XB;
    __device__ __forceinline__ void operator()(ACC_T, const Unit& u, const EpiCtx& c) const {
        const int row0 = u.pm * 256 + c.wr * 64 + c.fr; const bool isY = u.pn < 4; u16* base = isY ? Y : XB; const int col0 = (u.pn & 3) * 256 + c.wc * 32 + 8 * c.fq;
        float rsv[8];
#pragma unroll
        for (int i = 0; i < 8; ++i) rsv[i] = rstd_of(ssp, row0 + (i >> 2) * 128 + (i & 3) * 16);
#pragma unroll
        for (int ai = 0; ai < 2; ++ai)
#pragma unroll
            for (int m = 0; m < 4; ++m) { const int row = row0 + ai * 128 + m * 16; const float rs = rsv[ai * 4 + m]; u16* rowp = base + (size_t)row * D + col0;
#pragma unroll
                for (int bj = 0; bj < 2; ++bj) { f32x4 v0 = acc[ai][bj][m][0] * rs, v1 = acc[ai][bj][m][1] * rs;
                    if (isY) { const f32x2p a0 = gelu_tanh2((f32x2p){v0[0], v0[1]}), a1 = gelu_tanh2((f32x2p){v0[2], v0[3]}), b0 = gelu_tanh2((f32x2p){v1[0], v1[1]}), b1 = gelu_tanh2((f32x2p){v1[2], v1[3]});
                        v0 = (f32x4){a0.x, a0.y, a1.x, a1.y}; v1 = (f32x4){b0.x, b0.y, b1.x, b1.y}; }
                    u32x4 w; w.x = cvt_pk_bf16(v0[0], v0[1]); w.y = cvt_pk_bf16(v0[2], v0[3]); w.z = cvt_pk_bf16(v1[0], v1[1]); w.w = cvt_pk_bf16(v1[2], v1[3]);
                    *(u32x4*)(rowp + bj * 128) = w; } }
    }
};
struct EpiGateUp {
    static constexpr bool PRELOAD = false;
    const float* ssp; u16* ACT;
    __device__ __forceinline__ void operator()(ACC_T, const Unit& u, const EpiCtx& c) const {
        const int row0 = u.pm * 256 + c.wr * 64 + c.fr, col0 = u.pn * 128 + c.wc * 32 + 8 * c.fq;
        float rsv[8];
#pragma unroll
        for (int i = 0; i < 8; ++i) rsv[i] = rstd_of(ssp, row0 + (i >> 2) * 128 + (i & 3) * 16);
#pragma unroll
        for (int ai = 0; ai < 2; ++ai)
#pragma unroll
            for (int m = 0; m < 4; ++m) { const int row = row0 + ai * 128 + m * 16; const float rs = rsv[ai * 4 + m], c1 = -LOG2E * rs, k = frcp(rs * rs); float o[8];
#pragma unroll
                for (int n = 0; n < 2; ++n)
#pragma unroll
                    for (int j = 0; j < 4; j += 2) { const f32x2p r2 = silu_mul2((f32x2p){acc[ai][0][m][n][j], acc[ai][0][m][n][j + 1]}, (f32x2p){acc[ai][1][m][n][j], acc[ai][1][m][n][j + 1]}, c1, k); o[4 * n + j] = r2.x; o[4 * n + j + 1] = r2.y; }
                u32x4 w; w.x = cvt_pk_bf16(o[0], o[1]); w.y = cvt_pk_bf16(o[2], o[3]); w.z = cvt_pk_bf16(o[4], o[5]); w.w = cvt_pk_bf16(o[6], o[7]);
                *(u32x4*)(ACT + (size_t)row * DFF + col0) = w; }
    }
};
struct EpiRes {
    static constexpr bool PRELOAD = true;
    u16* HB; const float* bias; float* ssp; unsigned char* HB8; float ascale, iascale;
    __device__ __forceinline__ void pre_issue(u32x4 (&raw)[16], const Unit& u, const EpiCtx& c) const {
        const __amdgpu_buffer_rsrc_t rh = __builtin_amdgcn_make_buffer_rsrc((char*)(HB + (size_t)u.pm * 256 * D), 0, 256 * D * 2, 0x00020000);
        const int vo = ((c.wr * 64 + c.fr) * D + u.pn * 256 + c.wc * 32 + 8 * c.fq) * 2;
#pragma unroll
        for (int ai = 0; ai < 2; ++ai)
#pragma unroll
            for (int m = 0; m < 4; ++m)
#pragma unroll
                for (int bj = 0; bj < 2; ++bj) raw[(ai * 4 + m) * 2 + bj] = __builtin_amdgcn_raw_buffer_load_b128(rh, vo + bj * 256, (ai * 128 + m * 16) * D * 2, 0);
    }
    __device__ __forceinline__ void pre_unpack(f32x4 (&acc)[2][2][4][2], const u32x4 (&raw)[16]) const {
#pragma unroll
        for (int ai = 0; ai < 2; ++ai)
#pragma unroll
            for (int m = 0; m < 4; ++m)
#pragma unroll
                for (int bj = 0; bj < 2; ++bj) { const u32x4 hb = raw[(ai * 4 + m) * 2 + bj];
                    acc[ai][bj][m][0] = (f32x4){bf2f(hb.x & 0xffffu), bf2f(hb.x >> 16), bf2f(hb.y & 0xffffu), bf2f(hb.y >> 16)} * iascale;
                    acc[ai][bj][m][1] = (f32x4){bf2f(hb.z & 0xffffu), bf2f(hb.z >> 16), bf2f(hb.w & 0xffffu), bf2f(hb.w >> 16)} * iascale; }
    }
    __device__ __forceinline__ void operator()(ACC_T, const Unit& u, const EpiCtx& c) const {
        const int col0 = u.pn * 256 + c.wc * 32 + 8 * c.fq;
        const __amdgpu_buffer_rsrc_t rh = __builtin_amdgcn_make_buffer_rsrc((char*)(HB + (size_t)u.pm * 256 * D), 0, 256 * D * 2, 0x00020000);
        const int vo = ((c.wr * 64 + c.fr) * D + col0) * 2;
        f32x4 bv[2][2];
#pragma unroll
        for (int bj = 0; bj < 2; ++bj)
#pragma unroll
            for (int n = 0; n < 2; ++n) { bv[bj][n] = (f32x4){0.f, 0.f, 0.f, 0.f}; if (bias) bv[bj][n] = *(const f32x4*)(bias + col0 + bj * 128 + 4 * n); }
        LAS float* P = (LAS float*)(c.lds + LX_P);
#pragma unroll
        for (int ai = 0; ai < 2; ++ai)
#pragma unroll
            for (int m = 0; m < 4; ++m) { const int rl = ai * 128 + c.wr * 64 + m * 16 + c.fr; float s = 0.f;
#pragma unroll
                for (int bj = 0; bj < 2; ++bj) {
                    const f32x4 h0 = acc[ai][bj][m][0] * ascale + bv[bj][0], h1 = acc[ai][bj][m][1] * ascale + bv[bj][1];
                    u32x4 w; w.x = cvt_pk_bf16(h0[0], h0[1]); w.y = cvt_pk_bf16(h0[2], h0[3]); w.z = cvt_pk_bf16(h1[0], h1[1]); w.w = cvt_pk_bf16(h1[2], h1[3]);
                    __builtin_amdgcn_raw_buffer_store_b128(w, rh, vo + bj * 256, (ai * 128 + m * 16) * D * 2, 0);
                    if (HB8) { const float o8[8] = {h0[0], h0[1], h0[2], h0[3], h1[0], h1[1], h1[2], h1[3]};
                        const __amdgpu_buffer_rsrc_t r8 = __builtin_amdgcn_make_buffer_rsrc((char*)(HB8 + (size_t)u.pm * 256 * D), 0, 256 * D, 0x00020000);
                        __builtin_amdgcn_raw_buffer_store_b64(pk8_fp8(o8, S8_A), r8, (vo >> 1) + bj * 128, (ai * 128 + m * 16) * D, 0); }
                    s += ((h0[0] * h0[0] + h0[1] * h0[1]) + (h0[2] * h0[2] + h0[3] * h0[3])) + ((h1[0] * h1[0] + h1[1] * h1[1]) + (h1[2] * h1[2] + h1[3] * h1[3])); }
                s += __shfl_xor(s, 16); s += __shfl_xor(s, 32);
                if (c.fq == 0) P[rl * 4 + c.wc] = s; }
        asm volatile("s_waitcnt lgkmcnt(0)" ::: "memory"); __builtin_amdgcn_s_barrier(); asm volatile("" ::: "memory");
        if (c.tid < 256) { const f32x4 p = *(const LAS f32x4*)(P + 4 * c.tid); ssp[(size_t)(u.pm * 256 + c.tid) * 4 + u.pn] = (p[0] + p[1]) + (p[2] + p[3]); }
    }
};
struct EpiQKV {
    static constexpr bool PRELOAD = false;
    const float* ssp; const float* bias; const u16* rope; u16* Q; u16* Kb; u16* Vb; float ascale;
    __device__ __forceinline__ void operator()(ACC_T, const Unit& u, const EpiCtx& c) const {
        const int row0 = u.pm * 256 + c.wr * 64 + c.fr, bcol0 = u.pn * 256 + c.wc * 32 + 8 * c.fq;
        u16* base; int pitch, col0; float sc = 1.0f;
        if (u.pn < 4) { base = Q; pitch = D; col0 = bcol0; sc = 0.125f * LOG2E; } else if (u.pn == 4) { base = Kb; pitch = KVD; col0 = bcol0 - 1024; } else { base = Vb; pitch = KVD; col0 = bcol0 - 1280; }
        const bool rot = (u.pn < 5) && ((c.wc & 1) == 0);
        float rsv[8];
#pragma unroll
        for (int i = 0; i < 8; ++i) rsv[i] = rstd_of(ssp, row0 + (i >> 2) * 128 + (i & 3) * 16) * ascale;
#pragma unroll
        for (int bj = 0; bj < 2; ++bj) {
            const f32x4 bv0 = *(const f32x4*)(bias + bcol0 + bj * 128), bv1 = *(const f32x4*)(bias + bcol0 + bj * 128 + 4);
#pragma unroll
            for (int g = 0; g < 4; ++g) {
                u32x4 rpv[2][2];
                if (rot) {
#pragma unroll
                    for (int q2 = 0; q2 < 2; ++q2) { const u32x4* rp = (const u32x4*)(rope + (size_t)(row0 + (g >> 1) * 128 + ((g & 1) * 2 + q2) * 16) * 16); rpv[q2][0] = rp[0]; rpv[q2][1] = rp[1]; } }
#pragma unroll
                for (int q2 = 0; q2 < 2; ++q2) { const int ai = g >> 1, m = (g & 1) * 2 + q2; const int row = row0 + ai * 128 + m * 16; const float rs = rsv[ai * 4 + m];
                    f32x4 v0 = acc[ai][bj][m][0] * rs + bv0, v1 = acc[ai][bj][m][1] * rs + bv1;
                    if (rot) { const u32x4 cw = rpv[q2][0], sw = rpv[q2][1];
                        const f32x4 cs0 = (f32x4){bf2f(cw.x & 0xffffu), bf2f(cw.x >> 16), bf2f(cw.y & 0xffffu), bf2f(cw.y >> 16)}, cs1 = (f32x4){bf2f(cw.z & 0xffffu), bf2f(cw.z >> 16), bf2f(cw.w & 0xffffu), bf2f(cw.w >> 16)};
                        f32x4 sn0 = (f32x4){bf2f(sw.x & 0xffffu), bf2f(sw.x >> 16), bf2f(sw.y & 0xffffu), bf2f(sw.y >> 16)}, sn1 = (f32x4){bf2f(sw.z & 0xffffu), bf2f(sw.z >> 16), bf2f(sw.w & 0xffffu), bf2f(sw.w >> 16)};
                        if (c.fq == 0) { sn0 = -sn0; sn1 = -sn1; }
                        f32x4 p0, p1;
#pragma unroll
                        for (int j = 0; j < 4; ++j) { p0[j] = __shfl_xor(v0[j], 16); p1[j] = __shfl_xor(v1[j], 16); }
                        if (c.fq < 2) { v0 = v0 * cs0 + p0 * sn0; v1 = v1 * cs1 + p1 * sn1; } }
                    v0 = v0 * sc; v1 = v1 * sc;
                    u32x4 w; w.x = cvt_pk_bf16(v0[0], v0[1]); w.y = cvt_pk_bf16(v0[2], v0[3]); w.z = cvt_pk_bf16(v1[0], v1[1]); w.w = cvt_pk_bf16(v1[2], v1[3]);
                    *(u32x4*)(base + (size_t)row * pitch + col0 + bj * 128) = w; } } }
    }
};
struct EpiMoeUp {
    static constexpr bool PRELOAD = false;
    const float* ssp; const int* list; const float* gatew; const LAS int* tbl; u16* ACT2;
    __device__ __forceinline__ void operator()(ACC_T, const Unit& u, const EpiCtx& c) const {
        const int col0 = u.pn * 128 + c.wc * 32 + 8 * c.fq, n_e = tbl[u.e], pos0 = (u.pm - tbl[8 + u.e]) * 256;
        u32x4 rec[8];
#pragma unroll
        for (int i = 0; i < 8; ++i) { const int pos = pos0 + (i >> 2) * 128 + c.wr * 64 + (i & 3) * 16 + c.fr; rec[i] = *(const u32x4*)(list + ((size_t)u.e * M + (pos < n_e ? pos : 0)) * 4); }
#pragma unroll
        for (int ai = 0; ai < 2; ++ai)
#pragma unroll
            for (int m = 0; m < 4; ++m) { const int rl = ai * 128 + c.wr * 64 + m * 16 + c.fr;
                const bool valid = pos0 + rl < n_e; const unsigned gwu = rec[ai * 4 + m].y, rsu = rec[ai * 4 + m].z;
                const float gw = valid ? u2f(gwu) : 0.f; const float rs = u2f(rsu) * (MOE_FP8 ? 1.0f / (S8_A * S8_W) : 1.0f), c1 = -LOG2E * rs, k = valid ? __builtin_fminf(frcp(rs * rs * gw * (MOE_FP8 ? S8_ACT : 1.0f)), 1.0e30f) : 1.0e30f; float o[8];
#pragma unroll
                for (int n = 0; n < 2; ++n)
#pragma unroll
                    for (int j = 0; j < 4; j += 2) { const f32x2p r2 = silu_mul2((f32x2p){acc[ai][0][m][n][j], acc[ai][0][m][n][j + 1]}, (f32x2p){acc[ai][1][m][n][j], acc[ai][1][m][n][j + 1]}, c1, k); o[4 * n + j] = r2.x; o[4 * n + j + 1] = r2.y; }
                if (MOE_FP8) *(u32x2*)((unsigned char*)ACT2 + (size_t)(u.pm * 256 + rl) * DFF + col0) = pk8_fp8(o, 1.0f);
                else { u32x4 w; w.x = cvt_pk_bf16(o[0], o[1]); w.y = cvt_pk_bf16(o[2], o[3]); w.z = cvt_pk_bf16(o[4], o[5]); w.w = cvt_pk_bf16(o[6], o[7]);
                    *(u32x4*)(ACT2 + (size_t)(u.pm * 256 + rl) * DFF + col0) = w; } }
    }
};
struct EpiMoeDown {
    static constexpr bool PRELOAD = false;
    const int* list; const LAS int* tbl; u16* MO;
    __device__ __forceinline__ void operator()(ACC_T, const Unit& u, const EpiCtx& c) const {
        const int col0 = u.pn * 256 + c.wc * 32 + 8 * c.fq, n_e = tbl[u.e], pos0 = (u.pm - tbl[8 + u.e]) * 256;
        int tkv[8];
#pragma unroll
        for (int i = 0; i < 8; ++i) { const int pos = pos0 + (i >> 2) * 128 + c.wr * 64 + (i & 3) * 16 + c.fr; const int v = list[((size_t)u.e * M + (pos < n_e ? pos : 0)) * 4]; tkv[i] = pos < n_e ? v : -1; }
#pragma unroll
        for (int ai = 0; ai < 2; ++ai)
#pragma unroll
            for (int m = 0; m < 4; ++m) {
                if (tkv[ai * 4 + m] >= 0) { const int tk = tkv[ai * 4 + m]; u16* dst = MO + ((size_t)(tk & 1) * M + (tk >> 1)) * D + col0;
#pragma unroll
                    for (int bj = 0; bj < 2; ++bj) { const float us = MOE_FP8 ? 1.0f / (S8_ACT * S8_WD) : 1.0f; const f32x4 v0 = acc[ai][bj][m][0] * us, v1 = acc[ai][bj][m][1] * us;
                        u32x4 w; w.x = cvt_pk_bf16(v0[0], v0[1]); w.y = cvt_pk_bf16(v0[2], v0[3]); w.z = cvt_pk_bf16(v1[0], v1[1]); w.w = cvt_pk_bf16(v1[2], v1[3]);
                        *(u32x4*)(dst + bj * 128) = w; } } }
    }
};

template <class Epi, class Sched, bool GATHER, bool FP8 = false>
__device__ __forceinline__ void gemm_phase(LAS unsigned char* lds, const int K, const Sched& S, const Epi& E, const int wid  , volatile LAS unsigned* pacc = nullptr  , const int pmode = 0) {
    const int lane = lane_now(), tid = wid * 64 + lane, wr = wid >> 2, wc = wid & 3, fr = lane & 15, fq = lane >> 4;
    const int nt = K / BK;
    unsigned long long pl_ = 0ull;
    EpiCtx ctx; ctx.wr = wr; ctx.wc = wc; ctx.fr = fr; ctx.fq = fq; ctx.tid = tid; ctx.lds = lds;
    unsigned voffA[2], voffB[2]; int RA[2]; unsigned CA[2];
#pragma unroll
    for (int i = 0; i < 2; ++i) { int R, C; stage_rc(tid * 16 + i * 8192, R, C); const int Rb = (R & ~31) + perm32(R & 31);
        voffA[i] = (unsigned)(R * K + C) * 2u; voffB[i] = (unsigned)(Rb * K + C) * 2u; RA[i] = R; CA[i] = (unsigned)C * 2u; }
    const size_t kstep = (size_t)(BK * 2);
    const size_t hstep = (size_t)HALF * K * 2;
    const unsigned ldsw = (unsigned)wid * 1024u;
    const int aoff = lds_byte(wr * 64 + fr, fq * 8), boff = lds_byte(wc * 32 + fr, fq * 8);
#define PG8_SA(b, h) (((b) * 2 + (h)) * HTB)
#define PG8_SB(b, h) ((4 + (b) * 2 + (h)) * HTB)
#define PG8_GLDS(src, dstoff) __builtin_amdgcn_global_load_lds((const unsigned*)(src), (LAS unsigned*)(lds + (dstoff)), 16, 0, 0)
#define PG8_STAGE_B(bufoff, gbase) do { _Pragma("unroll") for (int _i = 0; _i < 2; ++_i) PG8_GLDS((const char*)(gbase) + voffB[_i], (bufoff) + ldsw + _i * 8192); } while (0)
#define PG8_STAGE_A(bufoff, gk, h, VA) do { _Pragma("unroll") for (int _i = 0; _i < 2; ++_i) { \
        if constexpr (GATHER) PG8_GLDS((const char*)(gk) + VA[h][_i], (bufoff) + ldsw + _i * 8192); else PG8_GLDS((const char*)(gk) + (size_t)(h) * hstep + voffA[_i], (bufoff) + ldsw + _i * 8192); } } while (0)
#define PG8_LDA(dst, b, h) do { _Pragma("unroll") for (int m = 0; m < 4; ++m) _Pragma("unroll") for (int k = 0; k < 2; ++k) dst[m][k] = *(const LAS bf16x8*)(lds + PG8_SA(b, h) + aoff + m * 2048 + k * 1024); } while (0)
#define PG8_LDB(dst, b, h) do { _Pragma("unroll") for (int n = 0; n < 2; ++n) _Pragma("unroll") for (int k = 0; k < 2; ++k) dst[n][k] = *(const LAS bf16x8*)(lds + PG8_SB(b, h) + boff + n * 2048 + k * 1024); } while (0)
#define PG8_MMA(ai, bj, At, Bt) do { __builtin_amdgcn_s_setprio(1); _Pragma("unroll") for (int m = 0; m < 4; ++m) _Pragma("unroll") for (int n = 0; n < 2; ++n) { \
        if constexpr (FP8) asm volatile("v_mfma_scale_f32_16x16x128_f8f6f4 %0, %1, %2, %0, %3, %3 op_sel_hi:[0,0,0]" : "+v"(acc[ai][bj][m][n]) : "v"(cat8(Bt[n][0], Bt[n][1])), "v"(cat8(At[m][0], At[m][1])), "v"(one_scale)); \
        else { _Pragma("unroll") for (int k = 0; k < 2; ++k) acc[ai][bj][m][n] = __builtin_amdgcn_mfma_f32_16x16x32_bf16(Bt[n][k], At[m][k], acc[ai][bj][m][n], 0, 0, 0); } } \
        __builtin_amdgcn_s_setprio(0); } while (0)
#define PG8_WAIT_V(n) asm volatile("s_waitcnt vmcnt(" #n ")" ::: "memory")
#define PG8_WAIT_L(n) asm volatile("s_waitcnt lgkmcnt(" #n ")" ::: "memory")
#define PG8_BAR __builtin_amdgcn_s_barrier()
#define PG8_SCHED __builtin_amdgcn_sched_barrier(0)
    const int one_scale = 0x7f7f7f7f;
    Unit cur, nxt; int ui = 0; cur.kb = 0; cur.ke = 0; nxt.kb = 0; nxt.ke = 0;
    bool flagdue = false;
    if (!S.next(0, cur)) return;
    f32x4 acc[2][2][4][2];
#pragma unroll
    for (int a = 0; a < 2; ++a)
#pragma unroll
        for (int b = 0; b < 2; ++b)
#pragma unroll
            for (int m = 0; m < 4; ++m)
#pragma unroll
                for (int n = 0; n < 2; ++n) acc[a][b][m][n] = (f32x4){0.f, 0.f, 0.f, 0.f};
    bf16x8 At[4][2], B0[2][2], B1[2][2];
    const char* cA = S.a_base(cur); const char* cB = S.b_base(cur);
    unsigned vaC[2][2], vaN[2][2];
#pragma unroll
    for (int h = 0; h < 2; ++h)
#pragma unroll
        for (int i = 0; i < 2; ++i) { vaC[h][i] = GATHER ? S.a_cvt(S.a_raw(cur, h * HALF + RA[i])) + CA[i] : 0u; vaN[h][i] = vaC[h][i]; }
    int rawN[2][2];
    if constexpr (GATHER) { Unit u1; const bool h1 = S.next(1, u1);
#pragma unroll
        for (int h = 0; h < 2; ++h)
#pragma unroll
            for (int i = 0; i < 2; ++i) rawN[h][i] = h1 ? S.a_raw(u1, h * HALF + RA[i]) : 0; }
    if constexpr (Epi::PRELOAD) { u32x4 praw[16]; E.pre_issue(praw, cur, ctx);
        PG8_STAGE_B(PG8_SB(0, 0), cB); PG8_STAGE_B(PG8_SB(0, 1), cB + hstep); PG8_STAGE_A(PG8_SA(0, 0), cA, 0, vaC); PG8_STAGE_A(PG8_SA(0, 1), cA, 1, vaC);
        E.pre_unpack(acc, praw); }
    else { PG8_STAGE_B(PG8_SB(0, 0), cB); PG8_STAGE_B(PG8_SB(0, 1), cB + hstep); PG8_STAGE_A(PG8_SA(0, 0), cA, 0, vaC); PG8_STAGE_A(PG8_SA(0, 1), cA, 1, vaC); }
    if (wr == 1) PG8_BAR;
    PG8_WAIT_V(2); PG8_BAR;
    PG8_STAGE_B(PG8_SB(1, 0), cB + kstep); PG8_STAGE_A(PG8_SA(1, 0), cA + kstep, 0, vaC); PG8_STAGE_B(PG8_SB(1, 1), cB + hstep + kstep);
    PG8_WAIT_V(6); PG8_BAR;
    for (;;) {
        const bool has_next = S.next(ui + 1, nxt);
        const char* nA = has_next ? S.a_base(nxt) : cA; const char* nB = has_next ? S.b_base(nxt) : cB;
        int ntu = nt; if constexpr (Sched::SK) ntu = 2 * (cur.ke - cur.kb);
#pragma unroll 1
        for (int t = 0; t < ntu; t += 2) {
            const bool last = (t == ntu - 2);
            const char* a1 = cA + (size_t)(t + 1) * kstep;
            const char* a2 = last ? nA : cA + (size_t)(t + 2) * kstep; const char* b2 = last ? nB : cB + (size_t)(t + 2) * kstep;
            const char* a3 = a2 + kstep; const char* b3 = b2 + kstep;
            unsigned v2[2][2];
#pragma unroll
            for (int h = 0; h < 2; ++h)
#pragma unroll
                for (int i = 0; i < 2; ++i) v2[h][i] = (GATHER && last) ? S.a_cvt(rawN[h][i]) + CA[i] : vaC[h][i];
            PG8_LDB(B0, 0, 0); PG8_LDB(B1, 0, 1); PG8_SCHED; PG8_LDA(At, 0, 0); PG8_STAGE_A(PG8_SA(1, 1), a1, 1, vaC);
            PG8_WAIT_V(8); PG8_WAIT_L(0); PG8_BAR; PG8_MMA(0, 0, At, B0); PG8_MMA(0, 1, At, B1); PG8_BAR; PG8_SCHED;
            PG8_LDA(At, 0, 1); PG8_STAGE_B(PG8_SB(0, 0), b2); PG8_STAGE_B(PG8_SB(0, 1), b2 + hstep); PG8_STAGE_A(PG8_SA(0, 0), a2, 0, v2);
            PG8_WAIT_V(8); PG8_WAIT_L(0); PG8_BAR; PG8_MMA(1, 0, At, B0); PG8_MMA(1, 1, At, B1); PG8_BAR; PG8_SCHED;
            PG8_LDB(B0, 1, 0); PG8_LDB(B1, 1, 1); PG8_SCHED; PG8_LDA(At, 1, 0); PG8_STAGE_A(PG8_SA(0, 1), a2, 1, v2);
            PG8_WAIT_V(8); PG8_WAIT_L(0); PG8_BAR; PG8_MMA(0, 0, At, B0); PG8_MMA(0, 1, At, B1); PG8_BAR; PG8_SCHED;
            PG8_LDA(At, 1, 1); PG8_STAGE_B(PG8_SB(1, 0), b3); PG8_STAGE_B(PG8_SB(1, 1), b3 + hstep); PG8_STAGE_A(PG8_SA(1, 0), a3, 0, v2);
            PG8_WAIT_V(8); PG8_WAIT_L(0); PG8_BAR; PG8_MMA(1, 0, At, B0); PG8_MMA(1, 1, At, B1); PG8_BAR; PG8_SCHED;
        }
        unsigned long long pt0 = 0ull; if (pacc && pmode == 0) pt0 = __builtin_amdgcn_s_memrealtime();
        if (wr == 0) PG8_BAR;
        if (pacc && pmode == 1) pt0 = __builtin_amdgcn_s_memrealtime();
        if constexpr (GATHER) {
#pragma unroll
            for (int h = 0; h < 2; ++h)
#pragma unroll
                for (int i = 0; i < 2; ++i) vaN[h][i] = S.a_cvt(rawN[h][i]) + CA[i]; }
        if constexpr (GATHER) { Unit u2; const bool h2 = S.next(ui + 2, u2);
#pragma unroll
            for (int h = 0; h < 2; ++h)
#pragma unroll
                for (int i = 0; i < 2; ++i) rawN[h][i] = h2 ? S.a_raw(u2, h * HALF + RA[i]) : 0; }
        bool dumped = false;
        if constexpr (Sched::SK) {
            if (flagdue && tid == 0) __hip_atomic_store(S.flags + S.slot, 1u, __ATOMIC_RELAXED, __HIP_MEMORY_SCOPE_AGENT);
            flagdue = false;
            if (cur.kb > 0) { dumped = true; flagdue = true;
                const __amdgpu_buffer_rsrc_t pr = __builtin_amdgcn_make_buffer_rsrc((char*)S.part + (size_t)S.slot * 131072, 0, 131072, 0x00020000); const int poff = wid * 16384 + lane * 16;
#pragma unroll
                for (int a = 0; a < 2; ++a)
#pragma unroll
                    for (int b = 0; b < 2; ++b)
#pragma unroll
                        for (int m = 0; m < 4; ++m) { const int q = (a * 2 + b) * 4 + m; const f32x4 v0 = acc[a][b][m][0], v1 = acc[a][b][m][1];
                            u32x4 w; w.x = cvt_pk_bf16(v0[0], v0[1]); w.y = cvt_pk_bf16(v0[2], v0[3]); w.z = cvt_pk_bf16(v1[0], v1[1]); w.w = cvt_pk_bf16(v1[2], v1[3]);
                            __builtin_amdgcn_raw_buffer_store_b128(w, pr, poff + (q & 3) * 1024, (q >> 2) * 4096, 16); } } }
        if (!dumped) E(acc, cur, ctx);
        if (pacc && pmode == 1) pl_ += __builtin_amdgcn_s_memrealtime() - pt0;
        if (!has_next) { if (pacc && pmode == 0) pl_ += __builtin_amdgcn_s_memrealtime() - pt0; break; }
        bool preload = false;
        if constexpr (Sched::SK) { if (nxt.ke < S.IT) { preload = true;
                unsigned* fl = S.flags + (S.slot + 1);
                while (__hip_atomic_load(fl, __ATOMIC_RELAXED, __HIP_MEMORY_SCOPE_AGENT) == 0u) __builtin_amdgcn_s_sleep(1);
                const __amdgpu_buffer_rsrc_t pr = __builtin_amdgcn_make_buffer_rsrc((char*)S.part + (size_t)(S.slot + 1) * 131072, 0, 131072, 0x00020000); const int poff = wid * 16384 + lane * 16;
                u32x4 raw[16];
#pragma unroll
                for (int q = 0; q < 16; ++q) raw[q] = __builtin_amdgcn_raw_buffer_load_b128(pr, poff + (q & 3) * 1024, (q >> 2) * 4096, 16);
#pragma unroll
                for (int a = 0; a < 2; ++a)
#pragma unroll
                    for (int b = 0; b < 2; ++b)
#pragma unroll
                        for (int m = 0; m < 4; ++m) { const u32x4 r = raw[(a * 2 + b) * 4 + m];
                            acc[a][b][m][0] = (f32x4){bf2f(r.x & 0xffffu), bf2f(r.x >> 16), bf2f(r.y & 0xffffu), bf2f(r.y >> 16)}; acc[a][b][m][1] = (f32x4){bf2f(r.z & 0xffffu), bf2f(r.z >> 16), bf2f(r.w & 0xffffu), bf2f(r.w >> 16)}; } } }
        if constexpr (Epi::PRELOAD) { u32x4 praw[16]; E.pre_issue(praw, nxt, ctx); E.pre_unpack(acc, praw); preload = true; }
        if (!preload) {
#pragma unroll
        for (int a = 0; a < 2; ++a)
#pragma unroll
            for (int b = 0; b < 2; ++b)
#pragma unroll
                for (int m = 0; m < 4; ++m)
#pragma unroll
                    for (int n = 0; n < 2; ++n) acc[a][b][m][n] = (f32x4){0.f, 0.f, 0.f, 0.f}; }
        cur = nxt; cA = nA; cB = nB; ++ui;
#pragma unroll
        for (int h = 0; h < 2; ++h)
#pragma unroll
            for (int i = 0; i < 2; ++i) vaC[h][i] = vaN[h][i];
        if (wr == 1) PG8_BAR;
        if (pacc && pmode == 0) pl_ += __builtin_amdgcn_s_memrealtime() - pt0;
    }
    PG8_WAIT_V(0);
    PG8_BAR;
    if constexpr (Sched::SK) { if (flagdue && tid == 0) __hip_atomic_store(S.flags + S.slot, 1u, __ATOMIC_RELAXED, __HIP_MEMORY_SCOPE_AGENT); }
    if (pacc && tid == 0) { pacc[0] = (unsigned)pl_; pacc[1] = (unsigned)(pl_ >> 32); }
#undef PG8_SA
#undef PG8_SB
#undef PG8_GLDS
#undef PG8_STAGE_A
#undef PG8_STAGE_B
#undef PG8_LDA
#undef PG8_LDB
#undef PG8_MMA
#undef PG8_WAIT_V
#undef PG8_WAIT_L
#undef PG8_BAR
#undef PG8_SCHED
}
}

#define XB_TMO      128
#define XB_XCNT(j)  (256  + 64 * (j))
#define XB_XSUB(j)  (1280 + 64 * (j))
#define XB_XGEN(j)  (2304 + 64 * (j))
#define XB_TOP      3328
#define XB_TOPGEN   3392
#define XB_ARR      3456
#define XCD_BAR_WORDS 4480
#define XB_SPIN_CAP (1u << 18)
__device__ __forceinline__ unsigned xb_ld(unsigned* p)              { return __hip_atomic_load(p, __ATOMIC_RELAXED, __HIP_MEMORY_SCOPE_AGENT); }
__device__ __forceinline__ unsigned xb_add(unsigned* p, unsigned v) { return __hip_atomic_fetch_add(p, v, __ATOMIC_RELAXED, __HIP_MEMORY_SCOPE_AGENT); }
__device__ __forceinline__ unsigned xb_xcc_id() { return (unsigned)__builtin_amdgcn_s_getreg((3 << 11) | 20) & 0xFu; }
#define XB_SPIN(cond, bar) do { unsigned _sp = 0; while (cond) { __builtin_amdgcn_s_sleep(1); \
    if ((++_sp & 255u) == 0u) { if (xb_ld(&(bar)[XB_TMO])) break; if (_sp > XB_SPIN_CAP) { atomicAdd(&(bar)[XB_TMO], 1u); break; } } } } while (0)
struct XcdBarrier { unsigned* bar; unsigned x; volatile LAS unsigned* st; };
__device__ __forceinline__ XcdBarrier xcd_barrier_post(unsigned* bar, volatile LAS unsigned* st, bool t0  ) {
    XcdBarrier b; b.bar = bar; b.x = xb_xcc_id(); b.st = st;
    if (t0) (void)xb_add(&bar[XB_XCNT(b.x)], 1u);
    return b;
}
__device__ __forceinline__ void xcd_barrier_complete(unsigned* bar, unsigned x, unsigned& nloc, unsigned& nx) {
    const unsigned G = gridDim.x * gridDim.y * gridDim.z;
    unsigned sum, cnt, mine, sp = 0u;
    for (;;) {
        sum = 0u; cnt = 0u; mine = 0u;
#pragma unroll
        for (unsigned j = 0; j < 16; ++j) { const unsigned c = xb_ld(&bar[XB_XCNT(j)]); sum += c; cnt += (c > 0u) ? 1u : 0u; mine = (j == x) ? c : mine; }
        if (sum == G) break;
        __builtin_amdgcn_s_sleep(1);
        if ((++sp & 255u) == 0u) { if (xb_ld(&bar[XB_TMO])) break; if (sp > XB_SPIN_CAP) { atomicAdd(&bar[XB_TMO], 1u); break; } }
    }
    nloc = mine > 0u ? mine : 1u; nx = cnt > 0u ? cnt : 1u;
}
__device__ __forceinline__ void xcd_barrier(const XcdBarrier& b) {
    asm volatile("s_waitcnt vmcnt(0)" ::: "memory");
    __syncthreads();
    if (threadIdx.x == 0) {
        unsigned* bar = b.bar;
        __builtin_amdgcn_s_waitcnt(0);
        unsigned nloc = b.st[0], nx = b.st[1];
        if (nloc == 0u) { xcd_barrier_complete(bar, b.x, nloc, nx); b.st[0] = nloc; b.st[1] = nx; }
        const unsigned old = xb_add(&bar[XB_XSUB(b.x)], 1u);
        const unsigned gen = old / nloc;
        if (old + 1u == (gen + 1u) * nloc) {
            __builtin_amdgcn_fence(__ATOMIC_RELEASE, "agent");
            asm volatile("s_waitcnt vmcnt(0)" ::: "memory");
            const unsigned og = xb_add(&bar[XB_TOP], 1u);
            const unsigned tg = og / nx;
            if (og + 1u == (tg + 1u) * nx) xb_add(&bar[XB_TOPGEN], 1u);
            else XB_SPIN(xb_ld(&bar[XB_TOPGEN]) == tg, bar);
            __builtin_amdgcn_fence(__ATOMIC_ACQUIRE, "agent");
            xb_add(&bar[XB_XGEN(b.x)], 1u);
            asm volatile("s_waitcnt vmcnt(0)" ::: "memory");
        } else {
            XB_SPIN(xb_ld(&bar[XB_XGEN(b.x)]) == gen, bar);
            __builtin_amdgcn_fence(__ATOMIC_ACQUIRE, "agent");
            asm volatile("s_waitcnt vmcnt(0)" ::: "memory");
        }
    }
    __syncthreads();
}
constexpr int CW_SKF = 16384;
constexpr int CW_BAR = 4096;
template <int DRAIN>
__device__ __forceinline__ void seam_sync(const XcdBarrier& b, volatile LAS unsigned* flag, unsigned seam_id, const Args& a, DeferState& st, int gw, int NGW, int wave) {
    const int lane = lane_now(); const bool t0 = (wave == 0) && (lane == 0);
    if (DRAIN > 0) { while (defer_step(a, st, gw, NGW, lane, DRAIN)) {} }
    asm volatile("s_waitcnt vmcnt(0)" ::: "memory");
    __syncthreads();
    unsigned* bar = b.bar; const unsigned G = gridDim.x;
    if (t0) {
        __builtin_amdgcn_fence(__ATOMIC_RELEASE, "agent");
        asm volatile("s_waitcnt vmcnt(0)" ::: "memory");
        __hip_atomic_store(&bar[XB_ARR + blockIdx.x], seam_id, __ATOMIC_RELAXED, __HIP_MEMORY_SCOPE_AGENT);
    }
    unsigned spins = 0u;
    for (;;) {
        if (wave == 0) {
            bool ok = true;
            for (unsigned i = (unsigned)lane; i < G; i += 64u) ok = ok && (xb_ld(&bar[XB_ARR + i]) >= seam_id);
            bool rel = __ballot(ok) == ~0ull;
            if (t0) {
                if (!rel && ((++spins & 63u) == 0u)) { if (xb_ld(&bar[XB_TMO])) rel = true; else if (spins > (1u << 17)) { atomicAdd(&bar[XB_TMO], 1u); rel = true; } }
                if (rel) { __builtin_amdgcn_fence(__ATOMIC_ACQUIRE, "agent"); asm volatile("s_waitcnt vmcnt(0)" ::: "memory"); *flag = seam_id; }
            }
        }
        __syncthreads();
        if (*flag == seam_id) break;
        if (!defer_step(a, st, gw, NGW, lane, N_DEFER)) __builtin_amdgcn_s_sleep(2);
    }
}

constexpr int XS_STRIDE = 272;
constexpr int LR_XS = 0, LR_XC = 35840, LR_HS = LR_XC + 34816, LR_CP = LR_HS + 34816, LR_HIN = LR_CP + 2560;
static_assert(LR_HIN + 512 <= RING_BYTES, "lru lds");
constexpr size_t WS_LAB = WS_ACT;
__device__ __forceinline__ void lru_segments(float Aseg, float Bseg, int fq, float& H, float& Ptot, float& my) {
    const float A1 = __shfl_xor(Aseg, 16), B1 = __shfl_xor(Bseg, 16);
    const bool odd = (fq & 1) != 0, hi2 = fq >= 2;
    const float Ap = Aseg * A1, Bp = odd ? __builtin_fmaf(Aseg, B1, Bseg) : __builtin_fmaf(A1, Bseg, B1);
    const float A2 = __shfl_xor(Ap, 32), B2 = __shfl_xor(Bp, 32);
    const float hpair = hi2 ? __builtin_fmaf(A2, H, B2) : H;
    my = odd ? __builtin_fmaf(A1, hpair, B1) : hpair;
    const float Alo = hi2 ? A2 : Ap, Blo = hi2 ? B2 : Bp, Ahi = hi2 ? Ap : A2, Bhi = hi2 ? Bp : B2;
    H = __builtin_fmaf(Ahi, __builtin_fmaf(Alo, H, Blo), Bhi); Ptot *= Alo * Ahi;
}
template <bool FINAL>
__device__ __forceinline__ void lru_phase(const Args& a, LAS unsigned char* lds, int G, int vcu, const int w  ) {
    const int lane = lane_now(), tid = w * 64 + lane, fr = lane & 15, fq = lane >> 4;
    const u16* XB = (const u16*)(a.ws + WS_XB); const u16* Y = (const u16*)(a.ws + WS_Y); u16* Gout = (u16*)(a.ws + WS_G);
    const u16* WAX = (const u16*)(a.ws + WS_WAX); float* CAR = (float*)(a.ws + WS_CAR); const float* spl = (const float*)(a.ws + WS_SPL);
    const float* cw = a.in[6]; const float* cb = a.in[7]; const float* b_a = a.in[9]; const float* b_x = a.in[11];
    LAS float* CP = (LAS float*)(lds + LR_CP); LAS float* HIN = (LAS float*)(lds + LR_HIN);
    for (int unit = vcu; unit < 256; unit += G) {
        const int n = unit & 7, chunk = unit >> 3, t0 = chunk * 512, ch0 = 128 * n;
        unsigned char* labu = a.ws + WS_LAB + (((size_t)unit * 4 * 8 + w) * 8) * 1024 + lane * 16;
        float H = 0.f, Ptot = 1.f;
        if constexpr (FINAL) {
            u32x4 pre[8];
#pragma unroll
            for (int p8 = 0; p8 < 8; ++p8) pre[p8] = *(const u32x4*)(labu + p8 * 1024);
            {
                const int hh = lane >> 5, jj = lane & 31;
#pragma unroll
                for (int it = 0; it < 8; ++it) { const int cl = 16 * w + 2 * it + hh; float A = 1.f, h = 0.f;
                    if (jj < chunk) { const f32x2v_t v = *(const f32x2v_t*)(CAR + (((size_t)n * 32 + jj) * 128 + cl) * 2); A = v.x; h = v.y; }
#pragma unroll
                    for (int d = 1; d < 32; d <<= 1) { const float Ap = __shfl_up(A, d, 32), hp = __shfl_up(h, d, 32); if (jj >= d) { h = A * hp + h; A = A * Ap; } }
                    if (jj == 31) HIN[cl] = h; }
            }
            __syncthreads();
            H = HIN[16 * w + fr];
            for (int s = 0; s < 4; ++s) {
                const int ts = t0 + 128 * s;
                u32x4 cur[8];
#pragma unroll
                for (int p8 = 0; p8 < 8; ++p8) cur[p8] = pre[p8];
                if (s < 3) {
#pragma unroll
                    for (int p8 = 0; p8 < 8; ++p8) pre[p8] = *(const u32x4*)(labu + (size_t)(s + 1) * 65536 + p8 * 1024); }
                u32x4 ypre[4];
#pragma unroll
                for (int i = 0; i < 4; ++i) { const int p = tid + 512 * i, row = p >> 4, pc = p & 15; ypre[i] = *(const u32x4*)(Y + (size_t)(ts + row) * D + ch0 + 8 * pc); }
#pragma unroll
                for (int m = 0; m < 8; ++m) {
                    const u32x2 lw = (m & 1) ? (u32x2){cur[m >> 1].z, cur[m >> 1].w} : (u32x2){cur[m >> 1].x, cur[m >> 1].y};
                    const u32x2 bw = (m & 1) ? (u32x2){cur[4 + (m >> 1)].z, cur[4 + (m >> 1)].w} : (u32x2){cur[4 + (m >> 1)].x, cur[4 + (m >> 1)].y};
                    const float la[4] = {bf2f(lw.x & 0xffffu), bf2f(lw.x >> 16), bf2f(lw.y & 0xffffu), bf2f(lw.y >> 16)}, bb[4] = {bf2f(bw.x & 0xffffu), bf2f(bw.x >> 16), bf2f(bw.y & 0xffffu), bf2f(bw.y >> 16)};
                    float av[4], hv[4]; float Aseg = 1.f, Bseg = 0.f;
#pragma unroll
                    for (int j = 0; j < 4; ++j) { const float a_ = fexp2(la[j]); Bseg = __builtin_fmaf(a_, Bseg, bb[j]); Aseg *= a_; av[j] = Aseg; hv[j] = Bseg; }
                    float my; lru_segments(Aseg, Bseg, fq, H, Ptot, my);
#pragma unroll
                    for (int j = 0; j < 4; ++j) { const int tl = 16 * m + 4 * fq + j; *(LAS u16*)(lds + LR_HS + tl * XS_STRIDE + (16 * w + fr) * 2) = (u16)f2bf(__builtin_fmaf(av[j], my, hv[j])); }
                }
                __syncthreads();
#pragma unroll
                for (int i = 0; i < 4; ++i) { const int p = tid + 512 * i, row = p >> 4, pc = p & 15; const size_t go = (size_t)(ts + row) * D + ch0 + 8 * pc;
                    const u32x4 hv = *(const LAS u32x4*)(lds + LR_HS + row * XS_STRIDE + pc * 16); const u32x4 yv = ypre[i]; u32x4 ov;
                    ov.x = cvt_pk_bf16(bf2f(hv.x & 0xffffu) * bf2f(yv.x & 0xffffu), bf2f(hv.x >> 16) * bf2f(yv.x >> 16)); ov.y = cvt_pk_bf16(bf2f(hv.y & 0xffffu) * bf2f(yv.y & 0xffffu), bf2f(hv.y >> 16) * bf2f(yv.y >> 16));
                    ov.z = cvt_pk_bf16(bf2f(hv.z & 0xffffu) * bf2f(yv.z & 0xffffu), bf2f(hv.z >> 16) * bf2f(yv.z >> 16)); ov.w = cvt_pk_bf16(bf2f(hv.w & 0xffffu) * bf2f(yv.w & 0xffffu), bf2f(hv.w >> 16) * bf2f(yv.w >> 16));
                    *(u32x4*)(Gout + go) = ov; }
                __syncthreads();
            }
        } else {
            u32x4 xpre[5];
#define LRU_XLOAD(ts_) do { _Pragma("unroll") for (int i = 0; i < 5; ++i) { const int p = tid + 512 * i, row = p >> 4, pc = p & 15, t = (ts_) - 3 + row; xpre[i] = (u32x4){0u, 0u, 0u, 0u}; \
            if (p < 131 * 16 && t >= 0) xpre[i] = *(const u32x4*)(XB + (size_t)t * D + ch0 + 8 * pc); } } while (0)
            LRU_XLOAD(t0);
            bf16x8 bfr[4], bfi[4];
            { const u16* wb = WAX + ((size_t)n * 256 + 16 * w + fr) * 128 + 8 * fq;
#pragma unroll
              for (int s = 0; s < 4; ++s) { bfr[s] = *(const bf16x8*)(wb + 32 * s); bfi[s] = *(const bf16x8*)(wb + 128 * 128 + 32 * s); } }
            const int ch = ch0 + 16 * w + fr; const float nba = -LOG2E * b_a[ch], nbx = -LOG2E * b_x[ch], c1 = -8.0f * LOG2E * spl[ch];
            { const int k = tid >> 7, c = tid & 127; CP[tid] = cw[k * D + ch0 + c]; if (tid < 128) CP[512 + tid] = cb[ch0 + tid]; }
            __syncthreads();
            for (int s = 0; s < 4; ++s) {
                const int ts = t0 + 128 * s;
#pragma unroll
                for (int i = 0; i < 5; ++i) { const int p = tid + 512 * i, row = p >> 4, pc = p & 15; if (p < 131 * 16) *(LAS u32x4*)(lds + LR_XS + row * XS_STRIDE + pc * 16) = xpre[i]; }
                __syncthreads();
                if (s < 3) LRU_XLOAD(ts + 128);
                { const int cg = tid & 15, tg = tid >> 4; float o[4][8], wk[4][8];
#pragma unroll
                  for (int k = 0; k < 4; ++k) { const f32x4 w0 = *(const LAS f32x4*)(CP + k * 128 + 8 * cg), w1 = *(const LAS f32x4*)(CP + k * 128 + 8 * cg + 4);
#pragma unroll
                      for (int i = 0; i < 4; ++i) { wk[k][i] = w0[i]; wk[k][4 + i] = w1[i]; } }
                  { const f32x4 b0 = *(const LAS f32x4*)(CP + 512 + 8 * cg), b1 = *(const LAS f32x4*)(CP + 512 + 8 * cg + 4);
#pragma unroll
                    for (int jt = 0; jt < 4; ++jt)
#pragma unroll
                        for (int i = 0; i < 4; ++i) { o[jt][i] = b0[i]; o[jt][4 + i] = b1[i]; } }
#pragma unroll
                  for (int rr = 0; rr < 7; ++rr) { const u32x4 xv = *(const LAS u32x4*)(lds + LR_XS + (4 * tg + rr) * XS_STRIDE + cg * 16); float xf[8];
                      xf[0] = bf2f(xv.x & 0xffffu); xf[1] = bf2f(xv.x >> 16); xf[2] = bf2f(xv.y & 0xffffu); xf[3] = bf2f(xv.y >> 16); xf[4] = bf2f(xv.z & 0xffffu); xf[5] = bf2f(xv.z >> 16); xf[6] = bf2f(xv.w & 0xffffu); xf[7] = bf2f(xv.w >> 16);
#pragma unroll
                      for (int jt = 0; jt < 4; ++jt) { const int k = rr - jt; if (k >= 0 && k <= 3) {
#pragma unroll
                          for (int i = 0; i < 8; ++i) o[jt][i] += xf[i] * wk[k][i]; } } }
#pragma unroll
                  for (int jt = 0; jt < 4; ++jt) { u32x4 wv; wv.x = cvt_pk_bf16(o[jt][0], o[jt][1]); wv.y = cvt_pk_bf16(o[jt][2], o[jt][3]); wv.z = cvt_pk_bf16(o[jt][4], o[jt][5]); wv.w = cvt_pk_bf16(o[jt][6], o[jt][7]);
                      *(LAS u32x4*)(lds + LR_XC + (4 * tg + jt) * XS_STRIDE + cg * 16) = wv; } }
                __syncthreads();
                f32x4 ar[8], ag[8];
#pragma unroll
                for (int m = 0; m < 8; ++m) { ar[m] = (f32x4){0.f, 0.f, 0.f, 0.f}; ag[m] = (f32x4){0.f, 0.f, 0.f, 0.f}; }
#pragma unroll
                for (int m = 0; m < 8; ++m)
#pragma unroll
                    for (int s2 = 0; s2 < 4; ++s2) { const bf16x8 af = *(const LAS bf16x8*)(lds + LR_XC + (16 * m + fr) * XS_STRIDE + (32 * s2 + 8 * fq) * 2);
                        ar[m] = __builtin_amdgcn_mfma_f32_16x16x32_bf16(af, bfr[s2], ar[m], 0, 0, 0); ag[m] = __builtin_amdgcn_mfma_f32_16x16x32_bf16(af, bfi[s2], ag[m], 0, 0, 0); }
                u32x4 keep[8];
#pragma unroll
                for (int m = 0; m < 8; ++m) {
                    float Aseg = 1.f, Bseg = 0.f; unsigned lw[2], bw[2];
#pragma unroll
                    for (int jp = 0; jp < 2; ++jp) {
                        const int tl = 16 * m + 4 * fq + 2 * jp;
                        const f32x2p er = (f32x2p){ar[m][2 * jp], ar[m][2 * jp + 1]} * (-LOG2E) + nba, ei = (f32x2p){ag[m][2 * jp], ag[m][2 * jp + 1]} * (-LOG2E) + nbx;
                        f32x2p dr, di; dr.x = fexp2(er.x); dr.y = fexp2(er.y); di.x = fexp2(ei.x); di.y = fexp2(ei.y); dr = dr + 1.0f; di = di + 1.0f;
                        f32x2p rg, ig; rg.x = frcp(dr.x); rg.y = frcp(dr.y); ig.x = frcp(di.x); ig.y = frcp(di.y);
                        const f32x2p l2 = rg * c1;
                        lw[jp] = cvt_pk_bf16(l2.x, l2.y);
                        const f32x2p lr = (f32x2p){bf2f(lw[jp] & 0xffffu), bf2f(lw[jp] >> 16)}; f32x2p a2; a2.x = fexp2(lr.x); a2.y = fexp2(lr.y);
                        const f32x2p xc = (f32x2p){bf2f(*(const LAS u16*)(lds + LR_XC + tl * XS_STRIDE + (16 * w + fr) * 2)), bf2f(*(const LAS u16*)(lds + LR_XC + (tl + 1) * XS_STRIDE + (16 * w + fr) * 2))};
                        const f32x2p om = a2 * (-a2) + 1.0f; f32x2p sq; sq.x = __builtin_amdgcn_sqrtf(om.x); sq.y = __builtin_amdgcn_sqrtf(om.y);
                        const f32x2p b2 = sq * (ig * xc);
                        bw[jp] = cvt_pk_bf16(b2.x, b2.y);
                        const float bb0 = bf2f(bw[jp] & 0xffffu), bb1 = bf2f(bw[jp] >> 16);
                        Bseg = __builtin_fmaf(a2.x, Bseg, bb0); Aseg *= a2.x; Bseg = __builtin_fmaf(a2.y, Bseg, bb1); Aseg *= a2.y; }
                    if (m & 1) { keep[m >> 1].z = lw[0]; keep[m >> 1].w = lw[1]; keep[4 + (m >> 1)].z = bw[0]; keep[4 + (m >> 1)].w = bw[1]; } else { keep[m >> 1].x = lw[0]; keep[m >> 1].y = lw[1]; keep[4 + (m >> 1)].x = bw[0]; keep[4 + (m >> 1)].y = bw[1]; }
                    float my; lru_segments(Aseg, Bseg, fq, H, Ptot, my);
                }
#pragma unroll
                for (int p8 = 0; p8 < 8; ++p8) *(u32x4*)(labu + (size_t)s * 65536 + p8 * 1024) = keep[p8];
            }
#undef LRU_XLOAD
            if (fq == 0) { f32x2v_t v; v.x = Ptot; v.y = H; *(f32x2v_t*)(CAR + (((size_t)n * 32 + chunk) * 128 + 16 * w + fr) * 2) = v; }
            __syncthreads();
        }
    }
}

constexpr int AT_KS = 144, AT_K = 0, AT_V = 256 * AT_KS;
__device__ __forceinline__ int crow(int r, int hi) { return (r & 3) + 8 * (r >> 2) + 4 * hi; }
__device__ __forceinline__ void attn_phase(const Args& a, LAS unsigned char* lds, int G, int vcu, const int w  ) {
    const int lane = lane_now(), tid = w * 64 + lane, r32 = lane & 31, hi = lane >> 5;
    const u16* Q = (const u16*)(a.ws + WS_Q); const u16* Kb = (const u16*)(a.ws + WS_K); const u16* Vb = (const u16*)(a.ws + WS_V); u16* ATT = (u16*)(a.ws + WS_ATT);
    const float* sinks = a.in[16];
    u32x4 kpre[4], vpre[4];
#define AT_KVLOAD(unit_) do { const int kvh_ = (unit_) & 3, b_ = (unit_) >> 2; _Pragma("unroll") for (int i = 0; i < 4; ++i) { const int p = tid + 512 * i, idx = p >> 3, pc = p & 7, t = 128 * (b_ - 1) + idx; \
        kpre[i] = (u32x4){0u, 0u, 0u, 0u}; vpre[i] = (u32x4){0u, 0u, 0u, 0u}; if (t >= 0) { kpre[i] = *(const u32x4*)(Kb + (size_t)t * KVD + 64 * kvh_ + 8 * pc); vpre[i] = *(const u32x4*)(Vb + (size_t)t * KVD + 64 * kvh_ + 8 * pc); } } } while (0)
    if (vcu < 512) AT_KVLOAD(vcu);
    for (int unit = vcu; unit < 512; unit += G) {
        const int kvh = unit & 3, b = unit >> 2;
#pragma unroll
        for (int i = 0; i < 4; ++i) { const int p = tid + 512 * i, idx = p >> 3, pc = p & 7; *(LAS u32x4*)(lds + AT_K + idx * AT_KS + pc * 16) = kpre[i]; *(LAS u32x4*)(lds + AT_V + idx * AT_KS + pc * 16) = vpre[i]; }
        __syncthreads();
        if (unit + G < 512) AT_KVLOAD(unit + G);
        const int head = 4 * kvh + (w >> 1), qh = w & 1; const float sink2 = sinks[head] * LOG2E;
        bf16x8 qfa[2][4];
#pragma unroll
        for (int qt = 0; qt < 2; ++qt)
#pragma unroll
            for (int s = 0; s < 4; ++s) qfa[qt][s] = *(const bf16x8*)(Q + (size_t)(128 * b + 64 * qh + 32 * qt + r32) * D + 64 * head + 16 * s + 8 * hi);
#pragma unroll
        for (int qt = 0; qt < 2; ++qt) {
            const int q0 = 64 * qh + 32 * qt, t = 128 * b + q0 + r32;
            bf16x8 qf[4];
#pragma unroll
            for (int s = 0; s < 4; ++s) qf[s] = qfa[qt][s];
            f32x16 o0, o1;
#pragma unroll
            for (int r = 0; r < 16; ++r) { o0[r] = 0.f; o1[r] = 0.f; }
            float mx = sink2, l = 1.0f; const int kt0 = q0 >> 5;
            for (int kk = 0; kk < 5; ++kk) { const int kt = kt0 + kk; if (b == 0 && kt < 4) continue;
                f32x16 sc;
#pragma unroll
                for (int r = 0; r < 16; ++r) sc[r] = 0.f;
#pragma unroll
                for (int s = 0; s < 4; ++s) { const bf16x8 kf = *(const LAS bf16x8*)(lds + AT_K + (32 * kt + r32) * AT_KS + (16 * s + 8 * hi) * 2); sc = __builtin_amdgcn_mfma_f32_32x32x16_bf16(kf, qf[s], sc, 0, 0, 0); }
                const int base = 32 * kt + 4 * hi - (128 + q0 + r32); float mt = -1.0e30f;
#pragma unroll
                for (int r = 0; r < 16; ++r) { const int rel = base + (r & 3) + 8 * (r >> 2); if (!(rel <= 0 && rel > -WIN)) sc[r] = -1.0e30f; mt = fmaxf(mt, sc[r]); }
                mt = fmaxf(mt, __shfl_xor(mt, 32));
                const float mn = fmaxf(mx, mt), al = fexp2(mx - mn); float ps = 0.f;
#pragma unroll
                for (int r = 0; r < 16; ++r) { const float p = fexp2(sc[r] - mn); sc[r] = p; ps += p; }
                ps += __shfl_xor(ps, 32); l = l * al + ps; mx = mn;
#pragma unroll
                for (int r = 0; r < 16; ++r) { o0[r] *= al; o1[r] *= al; }
                u32x4 pa, pb; pa.x = cvt_pk_bf16(sc[0], sc[1]); pa.y = cvt_pk_bf16(sc[2], sc[3]); pa.z = cvt_pk_bf16(sc[4], sc[5]); pa.w = cvt_pk_bf16(sc[6], sc[7]);
                pb.x = cvt_pk_bf16(sc[8], sc[9]); pb.y = cvt_pk_bf16(sc[10], sc[11]); pb.z = cvt_pk_bf16(sc[12], sc[13]); pb.w = cvt_pk_bf16(sc[14], sc[15]);
                const bf16x8 pf0 = __builtin_bit_cast(bf16x8, pa), pf1 = __builtin_bit_cast(bf16x8, pb);
#pragma unroll
                for (int s2 = 0; s2 < 2; ++s2)
#pragma unroll
                    for (int dt = 0; dt < 2; ++dt) {
                        const int va = AT_V + (32 * kt + 16 * s2 + 4 * hi + ((lane & 15) >> 2)) * AT_KS + (32 * dt + 16 * ((lane >> 4) & 1) + 4 * (lane & 3)) * 2;
                        const s16x4 lo = __builtin_bit_cast(s16x4, __builtin_amdgcn_ds_read_tr16_b64_v4i16((LAS s16x4*)(lds + va)));
                        const s16x4 hi4 = __builtin_bit_cast(s16x4, __builtin_amdgcn_ds_read_tr16_b64_v4i16((LAS s16x4*)(lds + va + 8 * AT_KS)));
                        const bf16x8 vf = (bf16x8){lo[0], lo[1], lo[2], lo[3], hi4[0], hi4[1], hi4[2], hi4[3]};
                        if (dt == 0) o0 = __builtin_amdgcn_mfma_f32_32x32x16_bf16(vf, s2 ? pf1 : pf0, o0, 0, 0, 0); else o1 = __builtin_amdgcn_mfma_f32_32x32x16_bf16(vf, s2 ? pf1 : pf0, o1, 0, 0, 0); }
            }
            const float il = 1.0f / l;
#pragma unroll
            for (int g4 = 0; g4 < 4; ++g4) { u32x2 w0, w1;
                w0.x = cvt_pk_bf16(o0[4 * g4] * il, o0[4 * g4 + 1] * il); w0.y = cvt_pk_bf16(o0[4 * g4 + 2] * il, o0[4 * g4 + 3] * il);
                w1.x = cvt_pk_bf16(o1[4 * g4] * il, o1[4 * g4 + 1] * il); w1.y = cvt_pk_bf16(o1[4 * g4 + 2] * il, o1[4 * g4 + 3] * il);
                if (ATTN_FP8) { const float so = il * S8_O; int b0 = 0, b1 = 0;
                    float c0[4], c1[4];
#pragma unroll
                    for (int i = 0; i < 4; ++i) { c0[i] = __builtin_fminf(__builtin_fmaxf(o0[4 * g4 + i] * so, -448.0f), 448.0f); c1[i] = __builtin_fminf(__builtin_fmaxf(o1[4 * g4 + i] * so, -448.0f), 448.0f); }
                    b0 = __builtin_amdgcn_cvt_pk_fp8_f32(c0[0], c0[1], b0, false); b0 = __builtin_amdgcn_cvt_pk_fp8_f32(c0[2], c0[3], b0, true);
                    b1 = __builtin_amdgcn_cvt_pk_fp8_f32(c1[0], c1[1], b1, false); b1 = __builtin_amdgcn_cvt_pk_fp8_f32(c1[2], c1[3], b1, true);
                    unsigned char* A8 = (unsigned char*)ATT; *(int*)(A8 + (size_t)t * D + 64 * head + 8 * g4 + 4 * hi) = b0; *(int*)(A8 + (size_t)t * D + 64 * head + 32 + 8 * g4 + 4 * hi) = b1; }
                else { *(u32x2*)(ATT + (size_t)t * D + 64 * head + 8 * g4 + 4 * hi) = w0; *(u32x2*)(ATT + (size_t)t * D + 64 * head + 32 + 8 * g4 + 4 * hi) = w1; } }
        }
        __syncthreads();
    }
}

#undef AT_KVLOAD
constexpr int NPHASE = 14;
#define M_CTL ((unsigned*)(a.ws + WS_CTL))
#define M_H (a.out)
#define M_HB ((u16*)(a.ws + WS_HB))
#define M_SSP0 ((float*)(a.ws + WS_SSP))
#define M_SSP1 (M_SSP0 + 65536)
#define M_SSP2 (M_SSP0 + 2 * 65536)
#define M_SSP3 (M_SSP0 + 3 * 65536)
#define M_CNT (M_CTL + CW_CNT)
#define M_LIST ((int*)(a.ws + WS_LIST))
#define M_GATEW ((float*)(a.ws + WS_GATEW))
#define M_GW (vcu * 8 + wave)
#define M_NGW (G * 8)
__global__ void __launch_bounds__(512, 2) mega(Args a) {
    extern __shared__ __attribute__((aligned(16))) unsigned char lds_raw[];
    LAS unsigned char* lds = (LAS unsigned char*)lds_raw;
    const int wave = __builtin_amdgcn_readfirstlane((int)(threadIdx.x >> 6));
#define TID_ (wave * 64 + lane_now())
    const int G = gridDim.x; const int bx = blockIdx.x; const int vcu = (G % 8 == 0) ? (bx % 8) * (G / 8) + bx / 8 : bx;
    volatile LAS unsigned* MISC = (volatile LAS unsigned*)(lds + LX_MISC);
    for (int u = TID_; u < 112; u += 512) ((LAS unsigned*)(lds + LX_MISC))[u] = 0u;
    __syncthreads();
    const int lo = a.ph_lo, hi = a.ph_hi;
    XcdBarrier bar; bar.bar = M_CTL + CW_BAR; bar.x = 0; bar.st = nullptr;
    if (hi - lo > 1) bar = xcd_barrier_post(M_CTL + CW_BAR, MISC + 8, TID_ == 0);
#define IN(k) (lo <= (k) && (k) < hi)
#ifndef REP_MASK
#define REP_MASK 0
#endif
#define REPS(k) for (int rep_ = 0; rep_ < 1 + ((REP_MASK >> (k)) & 1); ++rep_)
#ifndef PROBE_SEAMS
#define PROBE_SEAMS 0
#endif
#ifndef PROBE_BLK
#define PROBE_BLK 0
#endif
#ifndef PROBE_PH
#define PROBE_PH 0
#endif
#ifndef PROBE_UNIT
#define PROBE_UNIT 0
#endif
    unsigned long long probe_acc = 0ull;
    if (PROBE_PH && TID_ == 0) MISC[60] = (unsigned)__builtin_amdgcn_s_memrealtime();
    if (lane_now() == 0) { MISC[16 + 4 * wave] = 0u; MISC[17 + 4 * wave] = 0u; MISC[18 + 4 * wave] = 0xffffffffu; }
#define SEAM_DRAIN(k) ((k) == 1 ? 16 : (k) == 3 ? 17 : (k) == 4 ? 19 : (k) == 5 ? 20 : (k) == 6 ? 22 : (k) == 10 ? N_DEFER : 0)
#define SEAM(k) do { if (IN(k) && IN((k) + 1)) { if (PROBE_PH && TID_ == 0 && ((PROBE_PH >> (k)) & 1)) MISC[61] = MISC[61] + ((unsigned)__builtin_amdgcn_s_memrealtime() - MISC[60]); const unsigned long long t0_ = ((PROBE_SEAMS >> (k)) & 1) ? __builtin_amdgcn_s_memrealtime() : 0ull; \
        { DeferState dst; dst.d = __builtin_amdgcn_readfirstlane((int)MISC[16 + 4 * wave]); dst.base = __builtin_amdgcn_readfirstlane((int)MISC[17 + 4 * wave]); dst.it = __builtin_amdgcn_readfirstlane((int)MISC[18 + 4 * wave]); \
          seam_sync<SEAM_DRAIN(k)>(bar, MISC + 12, (unsigned)(k) + 1u, a, dst, M_GW, M_NGW, wave); \
          if (lane_now() == 0) { MISC[16 + 4 * wave] = (unsigned)dst.d; MISC[17 + 4 * wave] = (unsigned)dst.base; MISC[18 + 4 * wave] = (unsigned)dst.it; } } if ((PROBE_SEAMS >> (k)) & 1) probe_acc += __builtin_amdgcn_s_memrealtime() - t0_; if (PROBE_PH && TID_ == 0) MISC[60] = (unsigned)__builtin_amdgcn_s_memrealtime(); } } while (0)

    if (IN(0)) REPS(0) {
        tables_body(a, vcu * 512 + TID_, G * 512);
        convert_body(a, (float*)(lds_raw + wave * 16384), M_GW, M_NGW, lane_now(), !(IN(0) && IN(1)));
        rowprep_body(a.in[0], M_HB, M_SSP0, M_GW, M_NGW, lane_now());
    }
    SEAM(0);
    if (IN(1)) REPS(1) { pg8::DenseSched S; S.o.init(M / 256, 2048 / 256, G, bx); S.A = (const char*)M_HB; S.Bt = (const char*)(a.ws + WS_WIN); S.K = 1024;
        pg8::EpiProj E{M_SSP0, (u16*)(a.ws + WS_Y), (u16*)(a.ws + WS_XB)}; pg8::gemm_phase<pg8::EpiProj, pg8::DenseSched, false>(lds, 1024, S, E, wave); }
    SEAM(1);
    if (IN(2)) REPS(2) lru_phase<false>(a, lds, G, vcu, wave);
    SEAM(2);
    if (IN(3)) REPS(3) lru_phase<true>(a, lds, G, vcu, wave);
    SEAM(3);
    if (IN(4)) REPS(4) { pg8::DenseSched S; S.o.init(M / 256, 4, G, bx); S.A = (const char*)(a.ws + WS_G); S.Bt = (const char*)(a.ws + WS_WOUT); S.K = 1024;
        pg8::EpiRes E{M_HB, nullptr, M_SSP1, nullptr, 1.0f, 1.0f}; pg8::gemm_phase<pg8::EpiRes, pg8::DenseSched, false>(lds, 1024, S, E, wave); }
    SEAM(4);
    if (IN(5)) REPS(5) { pg8::DenseSched S; S.o.init(M / 256, 7168 / 256, G, bx); S.A = (const char*)M_HB; S.Bt = (const char*)(a.ws + WS_WGU); S.K = 1024;
        pg8::EpiGateUp E{M_SSP1, (u16*)(a.ws + WS_ACT)}; pg8::gemm_phase<pg8::EpiGateUp, pg8::DenseSched, false>(lds, 1024, S, E, wave); }
    SEAM(5);
    if (IN(6)) { pg8::DenseSched S; S.o.init(M / 256, 4, G, bx); S.A = (const char*)(a.ws + WS_ACT); S.Bt = (const char*)(a.ws + WS_WD); S.K = DFF;
        pg8::EpiRes E{M_HB, nullptr, M_SSP2, ATTN_FP8 ? (unsigned char*)(a.ws + WS_HB8) : nullptr, 1.0f, 1.0f}; pg8::gemm_phase<pg8::EpiRes, pg8::DenseSched, false>(lds, DFF, S, E, wave); }
    SEAM(6);
    if (IN(7)) REPS(7) { pg8::DenseSched S; S.o.init(M / 256, NQKV / 256, G, bx); S.A = ATTN_FP8 ? (const char*)(a.ws + WS_HB8) : (const char*)M_HB; S.Bt = (const char*)(a.ws + WS_WQKV); S.K = ATTN_FP8 ? 512 : 1024;
        pg8::EpiQKV E{M_SSP2, a.in[15], (const u16*)(a.ws + WS_ROPE), (u16*)(a.ws + WS_Q), (u16*)(a.ws + WS_K), (u16*)(a.ws + WS_V), ATTN_FP8 ? 1.0f / (S8_A * S8_W) : 1.0f}; pg8::gemm_phase<pg8::EpiQKV, pg8::DenseSched, false, ATTN_FP8 != 0>(lds, ATTN_FP8 ? 512 : 1024, S, E, wave); }
    SEAM(7);
    if (IN(8)) REPS(8) attn_phase(a, lds, G, vcu, wave);
    SEAM(8);
    if (IN(9)) { pg8::DenseSched S; S.o.init(M / 256, 4, G, bx); S.A = (const char*)(a.ws + WS_ATT); S.Bt = (const char*)(a.ws + WS_WO); S.K = ATTN_FP8 ? 512 : 1024;
        pg8::EpiRes E{M_HB, a.in[18], M_SSP3, MOE_FP8 ? (unsigned char*)(a.ws + WS_HB8) : nullptr, ATTN_FP8 ? 1.0f / (S8_O * S8_W) : 1.0f, ATTN_FP8 ? S8_O * S8_W : 1.0f}; pg8::gemm_phase<pg8::EpiRes, pg8::DenseSched, false, ATTN_FP8 != 0>(lds, ATTN_FP8 ? 512 : 1024, S, E, wave); }
    SEAM(9);
    if (IN(10)) { for (int g = vcu; g < M / 64; g += G) router_group(M_HB, (const float*)(a.ws + WS_WR), M_SSP3, M_CNT, M_LIST, M_GATEW, g, (float*)(lds_raw + LX_ROUT), wave); }
    SEAM(10);
    LAS int* tbl = (LAS int*)(lds + LX_TBL);
    if (IN(11) || IN(12)) { if (TID_ == 0) { int c8[8];
#pragma unroll
            for (int e = 0; e < 8; ++e) c8[e] = (int)__hip_atomic_load(M_CNT + e, __ATOMIC_RELAXED, __HIP_MEMORY_SCOPE_AGENT);
            int acc = 0;
#pragma unroll
            for (int e = 0; e < 8; ++e) { tbl[e] = c8[e]; tbl[8 + e] = acc; acc += (c8[e] + 255) >> 8; } tbl[16] = acc; } __syncthreads(); }
    if (IN(11)) REPS(11) { pg8::MoeSched S; S.o.init(__builtin_amdgcn_readfirstlane(tbl[16]), 7168 / 256, G, bx); S.A = MOE_FP8 ? (const char*)(a.ws + WS_HB8) : (const char*)M_HB; S.Bt = (const char*)(a.ws + WS_WGU2); S.K = MOE_FP8 ? 512 : 1024; S.bstride = (size_t)7168 * 1024 * (MOE_FP8 ? 1 : 2); S.list = M_LIST; S.tbl = tbl;
        pg8::EpiMoeUp E{M_SSP3, M_LIST, M_GATEW, tbl, (u16*)(a.ws + WS_ACT2)}; pg8::gemm_phase<pg8::EpiMoeUp, pg8::MoeSched, true, MOE_FP8 != 0>(lds, MOE_FP8 ? 512 : 1024, S, E, wave, (PROBE_UNIT && bx == PROBE_BLK) ? (MISC + 14) : nullptr, PROBE_UNIT - 1); if (PROBE_UNIT) { __syncthreads(); probe_acc += (unsigned long long)MISC[14] | ((unsigned long long)MISC[15] << 32); } }
    SEAM(11);
    if (IN(12) && MOE_FP8 && G == 256) REPS(12) { pg8::MoeSchedSK S; S.init(__builtin_amdgcn_readfirstlane(tbl[16]), bx, DFF / 2); S.A = (const char*)(a.ws + WS_ACT2); S.Bt = (const char*)(a.ws + WS_WD2); S.bstride = (size_t)1024 * DFF; S.tbl = tbl;
        S.part = (float*)(a.ws + WS_ACT); S.flags = M_CTL + CW_SKF;
        pg8::EpiMoeDown E{M_LIST, tbl, (u16*)(a.ws + WS_MO)}; pg8::gemm_phase<pg8::EpiMoeDown, pg8::MoeSchedSK, false, MOE_FP8 != 0>(lds, DFF / 2, S, E, wave); }
    else if (IN(12)) REPS(12) { pg8::MoeSched S; S.o.init(__builtin_amdgcn_readfirstlane(tbl[16]), 4, G, bx); S.A = (const char*)(a.ws + WS_ACT2); S.Bt = (const char*)(a.ws + WS_WD2); S.K = MOE_FP8 ? DFF / 2 : DFF; S.bstride = (size_t)1024 * DFF * (MOE_FP8 ? 1 : 2); S.list = nullptr; S.tbl = tbl;
        pg8::EpiMoeDown E{M_LIST, tbl, (u16*)(a.ws + WS_MO)}; pg8::gemm_phase<pg8::EpiMoeDown, pg8::MoeSched, false, MOE_FP8 != 0>(lds, MOE_FP8 ? DFF / 2 : DFF, S, E, wave); }
    SEAM(12);
#ifndef PROBE_P13
#define PROBE_P13 0
#endif
    const unsigned long long t13_ = PROBE_P13 ? __builtin_amdgcn_s_memrealtime() : 0ull;
    if (IN(13)) REPS(13) final_body(M_H, M_HB, (const u16*)(a.ws + WS_MO), a.in[4], M_GW, M_NGW, lane_now());
    if (PROBE_P13) { __syncthreads(); probe_acc += __builtin_amdgcn_s_memrealtime() - t13_; }
    if (PROBE_PH) __syncthreads();
    if (PROBE_PH && TID_ == 0) { if ((PROBE_PH >> 13) & 1) MISC[61] = MISC[61] + ((unsigned)__builtin_amdgcn_s_memrealtime() - MISC[60]); probe_acc += (unsigned long long)MISC[61]; }
    if ((PROBE_SEAMS != 0 || PROBE_P13 || PROBE_UNIT || PROBE_PH) && bx == PROBE_BLK && TID_ == 0) { const unsigned long long t1_ = __builtin_amdgcn_s_memrealtime() + 4ull * probe_acc; while (__builtin_amdgcn_s_memrealtime() < t1_) __builtin_amdgcn_s_sleep(8); }
#undef IN
#undef SEAM
#undef TID_
}
#ifndef MK_MODE
#define MK_MODE 1
#endif
#ifndef FASTMASK
#define FASTMASK 0x3fff
#endif
extern "C" void kernel_launch(void* const* d_in, const int* in_sizes, int n_in, void* d_out, int out_size, void* d_ws, size_t ws_size, hipStream_t stream) {
    if (n_in != 26 || out_size != M * D || ws_size < WS_END) { fprintf(stderr, "kernel_launch: unexpected shapes (n_in %d out %d ws %zu, need %zu)\n", n_in, out_size, ws_size, (size_t)WS_END); return; }
    static int grid = 0;
    if (grid == 0) {
        int dev = 0, cus = 0, per_cu = 0;
        if (hipGetDevice(&dev) != hipSuccess || hipDeviceGetAttribute(&cus, hipDeviceAttributeMultiprocessorCount, dev) != hipSuccess) { grid = -1; return; }
        if (hipFuncSetAttribute((const void*)mega, hipFuncAttributeMaxDynamicSharedMemorySize, LDS_BYTES) != hipSuccess) { fprintf(stderr, "kernel_launch: hipFuncSetAttribute failed\n"); grid = -1; return; }
        if (hipOccupancyMaxActiveBlocksPerMultiprocessor(&per_cu, (const void*)mega, 512, LDS_BYTES) != hipSuccess || per_cu < 1) { fprintf(stderr, "kernel_launch: occupancy query says %d\n", per_cu); per_cu = 1; }
        (void)hipGetLastError();
        grid = cus;
    }
    if (grid < 0) return;
    unsigned char* ws = (unsigned char*)d_ws;
    (void)hipMemsetAsync(ws + WS_CTL, 0, CTL_BYTES, stream);
    Args a{};
    for (int i = 0; i < 26; ++i) a.in[i] = (const float*)d_in[i];
    a.pos = (const int*)d_in[1]; a.out = (float*)d_out; a.ws = ws; a.ph_lo = 0; a.ph_hi = NPHASE;
#if MK_MODE == 1
    hipLaunchKernelGGL(mega, dim3(grid), dim3(512), LDS_BYTES, stream, a);
#else
    float* H = (float*)d_out; u16* HB = (u16*)(ws + WS_HB);
    float* SSP0 = (float*)(ws + WS_SSP), *SSP1 = SSP0 + 65536, *SSP2 = SSP1 + 65536, *SSP3 = SSP2 + 65536;
    const unsigned* cnt = (const unsigned*)(ws + WS_CTL) + CW_CNT; const int* list = (const int*)(ws + WS_LIST); const float* gatew = (const float*)(ws + WS_GATEW);
    for (int p = 0; p < NPHASE; ++p) {
        if ((FASTMASK >> p) & 1) { a.ph_lo = p; a.ph_hi = p + 1; hipLaunchKernelGGL(mega, dim3(grid), dim3(512), LDS_BYTES, stream, a); continue; }
        switch (p) {
        case 0: k_tables<<<256, 256, 0, stream>>>(a); k_convert<<<2048, 256, 0, stream>>>(a); k_rowprep<<<1024, 256, 0, stream>>>(a.in[0], HB, SSP0); break;
        case 1: { NE_Proj e{HB, (const u16*)(ws + WS_WIN), SSP0, (u16*)(ws + WS_Y), (u16*)(ws + WS_XB)}; k_ngemm<<<dim3(2048 / 64, M / 64), 256, 0, stream>>>(e, 1024); } break;
        case 2: k_conv1d<<<(M * D) / 256, 256, 0, stream>>>((const u16*)(ws + WS_XB), a.in[6], a.in[7], (u16*)(ws + WS_XC));
                { NE_Gates e{(const u16*)(ws + WS_XC), (const u16*)(ws + WS_WAX), a.in[9], a.in[11], (const float*)(ws + WS_SPL), (float*)d_out, (float*)(ws + WS_BX)}; k_ngemm<<<dim3(128 / 64, M / 64, 8), 256, 0, stream>>>(e, 128); } break;
        case 3: k_scan_seq<<<16, 64, 0, stream>>>((const float*)d_out, (const float*)(ws + WS_BX), (const u16*)(ws + WS_Y), (u16*)(ws + WS_G)); break;
        case 4: { NE_Res e{(const u16*)(ws + WS_G), (const u16*)(ws + WS_WOUT), 1024, a.in[0], H, HB, nullptr}; k_ngemm<<<dim3(1024 / 64, M / 64), 256, 0, stream>>>(e, 1024); } k_ssp<<<1024, 256, 0, stream>>>(H, SSP1); break;
        case 5: { NE_GateUp e{HB, (const u16*)(ws + WS_WGU), SSP1, (u16*)(ws + WS_ACT)}; k_ngemm<<<dim3(DFF / 64, M / 64), 256, 0, stream>>>(e, 1024); } break;
        case 6: { NE_Res e{(const u16*)(ws + WS_ACT), (const u16*)(ws + WS_WD), DFF, nullptr, H, HB, nullptr}; k_ngemm<<<dim3(1024 / 64, M / 64), 256, 0, stream>>>(e, DFF); } k_ssp<<<1024, 256, 0, stream>>>(H, SSP2); break;
        case 7: { NE_QKV e{HB, (const u16*)(ws + WS_WQKV), SSP2, a.in[15], (const u16*)(ws + WS_ROPE), (u16*)(ws + WS_Q), (u16*)(ws + WS_K), (u16*)(ws + WS_V)}; k_ngemm<<<dim3(NQKV / 64, M / 64), 256, 0, stream>>>(e, 1024); } break;
        case 8: k_attn_ref<<<(M * NH) / 64, 64, 0, stream>>>((const u16*)(ws + WS_Q), (const u16*)(ws + WS_K), (const u16*)(ws + WS_V), a.in[16], (u16*)(ws + WS_ATT)); break;
        case 9: { NE_Res e{(const u16*)(ws + WS_ATT), (const u16*)(ws + WS_WO), 1024, nullptr, H, HB, a.in[18]}; k_ngemm<<<dim3(1024 / 64, M / 64), 256, 0, stream>>>(e, 1024); } k_ssp<<<1024, 256, 0, stream>>>(H, SSP3); break;
        case 10: k_router<<<256, 512, 0, stream>>>(a); break;
        case 11: { NE_MoeUp e{HB, (const u16*)(ws + WS_WGU2), SSP3, cnt, list, gatew, (u16*)(ws + WS_ACT2)}; k_ngemm<<<dim3(DFF / 64, MAXSLOT / 64), 256, 0, stream>>>(e, 1024); } break;
        case 12: { NE_MoeDown e{(const u16*)(ws + WS_ACT2), (const u16*)(ws + WS_WD2), cnt, list, (u16*)(ws + WS_MO)}; k_ngemm<<<dim3(1024 / 64, MAXSLOT / 64), 256, 0, stream>>>(e, DFF); } break;
        case 13: k_final<<<1024, 256, 0, stream>>>(H, HB, (const u16*)(ws + WS_MO), a.in[4]); break;
        }
    }
#endif
}
```

```cpp
#include <hip/hip_runtime.h>
#include <stdint.h>
#include <stdio.h>

typedef unsigned short u16;
typedef short bf16x8 __attribute__((ext_vector_type(8)));
typedef float f32x4 __attribute__((ext_vector_type(4)));
typedef unsigned u32x4 __attribute__((ext_vector_type(4)));
typedef unsigned u32x2 __attribute__((ext_vector_type(2)));

constexpr int M = 16384, D = 1024, DFF = 3584, NE = 8, NBLK = 8, RB = 128;
constexpr int NH = 16, NKV = 4, HD = 64, KVD = 256, NQKV = 1536, WIN = 128;
constexpr int MAXSLOT = 34816;
constexpr float EPS = 1e-6f;
#ifndef MOE_FP8
#define MOE_FP8 1
#endif
constexpr float S8_A = 16.0f, S8_W = 256.0f, S8_ACT = 8.0f, S8_WD = 512.0f;
#ifndef ATTN_FP8
#define ATTN_FP8 1
#endif
constexpr float S8_O = 32.0f;
constexpr float LOG2E = 1.4426950408889634f;

constexpr size_t MiB = 1u << 20;
constexpr size_t WS_CTL = 0, CTL_BYTES = 1 * MiB;
constexpr size_t WS_ROPE = 1 * MiB;
constexpr size_t WS_SSP = 2 * MiB;
constexpr size_t WS_SPL = 3 * MiB;
constexpr size_t WS_WR = 3 * MiB + 64 * 1024;
constexpr size_t WS_CAR = 3 * MiB + 128 * 1024;
constexpr size_t WS_LIST = 4 * MiB;
constexpr size_t WS_GATEW = WS_LIST;
constexpr size_t WS_WGU2 = 6 * MiB;
constexpr size_t WS_HB8 = 70 * MiB;
constexpr size_t WS_WD2 = 118 * MiB;
constexpr size_t WS_HB = 174 * MiB;
constexpr size_t WS_X = 206 * MiB;
constexpr size_t WS_WIN = WS_X;
constexpr size_t WS_WAX = WS_X + 4 * MiB;
constexpr size_t WS_WOUT = WS_X + 5 * MiB;
constexpr size_t WS_WGU = WS_X + 7 * MiB;
constexpr size_t WS_WD = WS_X + 21 * MiB;
constexpr size_t WS_WQKV = WS_X + 28 * MiB;
constexpr size_t WS_WO = WS_X + 31 * MiB;
constexpr size_t WS_Y = WS_X + 33 * MiB;
constexpr size_t WS_XB = WS_Y + 32 * MiB;
constexpr size_t WS_G = WS_XB + 32 * MiB;
constexpr size_t WS_ACT = WS_G + 32 * MiB;
constexpr size_t WS_XC = WS_ACT;
constexpr size_t WS_BX = WS_ACT + 32 * MiB;
constexpr size_t WS_Q = WS_Y;
constexpr size_t WS_K = WS_Y + 32 * MiB;
constexpr size_t WS_V = WS_K + 8 * MiB;
constexpr size_t WS_ATT = WS_V + 8 * MiB;
constexpr size_t WS_ACT2 = WS_X;
constexpr size_t WS_MO = WS_WGU2;
constexpr size_t WS_END = 447 * MiB;
static_assert(WS_ACT + (size_t)M * DFF * 2 <= WS_END && WS_ACT2 + (size_t)MAXSLOT * DFF * 2 <= WS_END, "ws map");
constexpr int CW_CNT = 64;

__device__ __forceinline__ unsigned f2bf(float f) { unsigned u = __builtin_bit_cast(unsigned, f); return (u + 0x7fffu + ((u >> 16) & 1u)) >> 16; }
__device__ __forceinline__ float bf2f(unsigned b) { return __builtin_bit_cast(float, b << 16); }
__device__ __forceinline__ float u2f(unsigned b) { return __builtin_bit_cast(float, b); }
__device__ __forceinline__ int lane_now() { int l; asm volatile("v_mbcnt_lo_u32_b32 %0, -1, 0\n\tv_mbcnt_hi_u32_b32 %0, -1, %0" : "=v"(l)); return l; }
__device__ __forceinline__ unsigned pk2(float lo, float hi) { return f2bf(lo) | (f2bf(hi) << 16); }
__device__ __forceinline__ float wave_sum(float v) {
#pragma unroll
    for (int o = 1; o < 64; o <<= 1) v += __shfl_xor(v, o);
    return v;
}
__device__ __forceinline__ float sigmoidf_(float x) { return 1.0f / (1.0f + __expf(-x)); }
__device__ __forceinline__ float gelu_tanh(float x) { const float z = 0.7978845608028654f * (x + 0.044715f * x * x * x); return x / (1.0f + __expf(-2.0f * z)); }
__device__ __forceinline__ float silu_(float x) { return x / (1.0f + __expf(-x)); }
__device__ __forceinline__ float one_minus_exp(float x) {
    if (x > -0.3f) { float p = 1.0f / 720.0f; p = p * x + 1.0f / 120.0f; p = p * x + 1.0f / 24.0f; p = p * x + 1.0f / 6.0f; p = p * x + 0.5f; p = p * x + 1.0f; return -x * p; }
    return 1.0f - __expf(x);
}
__device__ __forceinline__ float rstd_of(const float* ssp, int row) { const f32x4 p = *(const f32x4*)(ssp + 4 * (size_t)row); return rsqrtf(((p[0] + p[1]) + (p[2] + p[3])) * (1.0f / D) + EPS); }

struct Args {
    const float* in[26]; const int* pos; float* out; unsigned char* ws; int ph_lo, ph_hi;
};

__device__ __forceinline__ void tables_body(const Args& a, int gt, int NT) {
    u16* rope = (u16*)(a.ws + WS_ROPE);
    for (int i = gt; i < M * 8; i += NT) { const int t = i >> 3, f = i & 7;
        const double inv = f == 0 ? 1.0 : f == 1 ? 0.19392274474868576 : f == 2 ? 0.03760603093086393 : f == 3 ? 0.007292664737217109 : f == 4 ? 0.001414213562373095 : f == 5 ? 0.0002742481756762073 : f == 6 ? 5.318295896944988e-05 : 1.031338537721246e-05;
        const double ang = (double)a.pos[t] * inv; const double kq = __builtin_rint(ang * 0.6366197723675814); const double r = ang - kq * 1.5707963267948966, r2 = r * r;
        double s = -1.0 / 39916800.0; s = s * r2 + 1.0 / 362880.0; s = s * r2 - 1.0 / 5040.0; s = s * r2 + 1.0 / 120.0; s = s * r2 - 1.0 / 6.0; s = s * r2 + 1.0; s *= r;
        double c = 1.0 / 479001600.0; c = c * r2 - 1.0 / 3628800.0; c = c * r2 + 1.0 / 40320.0; c = c * r2 - 1.0 / 720.0; c = c * r2 + 1.0 / 24.0; c = c * r2 - 0.5; c = c * r2 + 1.0;
        const int q = (int)((long long)kq & 3); const double cs = q == 0 ? c : q == 1 ? -s : q == 2 ? -c : s, sn = q == 0 ? s : q == 1 ? c : q == 2 ? -s : -c;
        rope[t * 16 + f] = (u16)f2bf((float)cs); rope[t * 16 + 8 + f] = (u16)f2bf((float)sn); }
    float* spl = (float*)(a.ws + WS_SPL);
    for (int i = gt; i < 1024; i += NT) { const float z = __expf(-a.in[12][i]);
        float p = 0.2f; p = p * z - 0.25f; p = p * z + 1.0f / 3.0f; p = p * z - 0.5f; p = p * z + 1.0f; spl[i] = z < 0.05f ? z * p : __logf(1.0f + z); }
    float* wr = (float*)(a.ws + WS_WR);
    for (int i = gt; i < 8 * 1024; i += NT) { const int e = i >> 10, k = i & 1023; wr[i] = a.in[3][1024 + k] * a.in[22][k * 8 + e]; }
}
__global__ void k_tables(Args a) { tables_body(a, blockIdx.x * blockDim.x + threadIdx.x, gridDim.x * blockDim.x); }

struct ConvJob { const float* W; const float* g; u16* WT; int K, N, mode, row_off; float s8; };
__device__ __forceinline__ bool conv_job(const Args& a, int j, ConvJob& c) {
    unsigned char* ws = a.ws;
    c.g = nullptr; c.mode = 0; c.row_off = 0; c.s8 = 0.f;
    if (j == 0) { c.W = a.in[5]; c.g = a.in[2]; c.WT = (u16*)(ws + WS_WIN); c.K = 1024; c.N = 2048; return true; }
    if (j == 1) { c.W = a.in[13]; c.WT = (u16*)(ws + WS_WOUT); c.K = 1024; c.N = 1024; return true; }
    if (j == 2) { c.W = a.in[19]; c.g = a.in[3]; c.WT = (u16*)(ws + WS_WGU); c.K = 1024; c.N = DFF; c.mode = 1; return true; }
    if (j == 3) { c.W = a.in[20]; c.g = a.in[3]; c.WT = (u16*)(ws + WS_WGU); c.K = 1024; c.N = DFF; c.mode = 2; return true; }
    if (j == 4) { c.W = a.in[21]; c.WT = (u16*)(ws + WS_WD); c.K = DFF; c.N = 1024; return true; }
    if (j == 5) { c.W = a.in[14]; c.g = a.in[2] + 1024; c.WT = (u16*)(ws + WS_WQKV); c.K = 1024; c.N = NQKV; c.s8 = ATTN_FP8 ? S8_W : 0.f; return true; }
    if (j == 6) { c.W = a.in[17]; c.WT = (u16*)(ws + WS_WO); c.K = 1024; c.N = 1024; c.s8 = ATTN_FP8 ? S8_W : 0.f; return true; }
    j -= 7;
    if (j < 16) { const int n = j >> 1, x = j & 1; c.W = a.in[x ? 10 : 8] + (size_t)n * 128 * 128; c.WT = (u16*)(ws + WS_WAX) + (size_t)n * 256 * 128; c.K = 128; c.N = 128; c.row_off = x * 128; return true; }
    j -= 16;
    if (j < 16) { const int e = j >> 1, x = j & 1; c.W = a.in[x ? 24 : 23] + (size_t)e * 1024 * DFF; c.g = a.in[3] + 1024; c.WT = (u16*)(ws + WS_WGU2 + (size_t)e * 7168 * 1024 * (MOE_FP8 ? 1 : 2)); c.K = 1024; c.N = DFF; c.mode = 1 + x; c.s8 = MOE_FP8 ? S8_W : 0.f; return true; }
    j -= 16;
    if (j < 8) { c.W = a.in[25] + (size_t)j * DFF * 1024; c.WT = (u16*)(ws + WS_WD2 + (size_t)j * 1024 * DFF * (MOE_FP8 ? 1 : 2)); c.K = DFF; c.N = 1024; c.s8 = MOE_FP8 ? S8_WD : 0.f; return true; }
    return false;
}
constexpr int NJOBS = 7 + 16 + 16 + 8;
__device__ __forceinline__ void conv_item(const ConvJob& c, float*, int item, int lane) {
    const int nblk = c.N / 64, kb = item / nblk, nb = item % nblk, r4 = lane >> 4, cc = lane & 15, k0 = 64 * kb + 16 * r4, n0 = 64 * nb + 4 * cc;
    f32x4 v[16];
    const float* src = c.W + (size_t)k0 * c.N + n0;
#pragma unroll
    for (int i = 0; i < 16; ++i) v[i] = __builtin_nontemporal_load((const f32x4*)(src + (size_t)i * c.N));
    if (c.g) { const f32x4 g0 = *(const f32x4*)(c.g + k0), g1 = *(const f32x4*)(c.g + k0 + 4), g2 = *(const f32x4*)(c.g + k0 + 8), g3 = *(const f32x4*)(c.g + k0 + 12);
#pragma unroll
        for (int i = 0; i < 4; ++i) { v[i] = v[i] * g0[i]; v[4 + i] = v[4 + i] * g1[i]; v[8 + i] = v[8 + i] * g2[i]; v[12 + i] = v[12 + i] * g3[i]; } }
    if (c.s8 != 0.f) {
#pragma unroll
        for (int j = 0; j < 4; ++j) { const int nn = n0 + j; const int r = c.mode == 0 ? c.row_off + nn : 256 * (nn >> 7) + (nn & 127) + (c.mode == 2 ? 128 : 0);
            u32x4 o;
#pragma unroll
            for (int q = 0; q < 4; ++q) { float t[4];
#pragma unroll
                for (int i = 0; i < 4; ++i) t[i] = __builtin_fminf(__builtin_fmaxf(v[4 * q + i][j] * c.s8, -448.0f), 448.0f);
                int w = 0; w = __builtin_amdgcn_cvt_pk_fp8_f32(t[0], t[1], w, false); w = __builtin_amdgcn_cvt_pk_fp8_f32(t[2], t[3], w, true); o[q] = (unsigned)w; }
            *(u32x4*)((unsigned char*)c.WT + (size_t)r * c.K + k0) = o; }
        return; }
#pragma unroll
    for (int j = 0; j < 4; ++j) { const int nn = n0 + j; const int r = c.mode == 0 ? c.row_off + nn : 256 * (nn >> 7) + (nn & 127) + (c.mode == 2 ? 128 : 0);
        u32x4 o0, o1; o0.x = pk2(v[0][j], v[1][j]); o0.y = pk2(v[2][j], v[3][j]); o0.z = pk2(v[4][j], v[5][j]); o0.w = pk2(v[6][j], v[7][j]);
        o1.x = pk2(v[8][j], v[9][j]); o1.y = pk2(v[10][j], v[11][j]); o1.z = pk2(v[12][j], v[13][j]); o1.w = pk2(v[14][j], v[15][j]);
        u32x4* dst = (u32x4*)(c.WT + (size_t)r * c.K + k0); dst[0] = o0; dst[1] = o1; }
}
constexpr int N_EARLY = 1, N_DEFER = 46;
__device__ __forceinline__ int early_job(int e) { return e; }
__device__ __forceinline__ int defer_job(int d) { return d < 16 ? 7 + d : d == 16 ? 1 : d < 19 ? d - 15 : d == 19 ? 4 : d < 22 ? d - 15 : d + 1; }
__device__ __forceinline__ void convert_body(const Args& a, float* scr, int gw, int NGW, int lane, bool all) {
    int base = 0;
    const int nj = all ? NJOBS : N_EARLY;
    for (int e = 0; e < nj; ++e) { ConvJob c; if (!conv_job(a, all ? e : early_job(e), c)) break; const int items = (c.K / 64) * (c.N / 64);
        int first = (gw - base) % NGW; if (first < 0) first += NGW;
        for (int it = first; it < items; it += NGW) conv_item(c, scr, it, lane);
        base = (base + items) % NGW; }
}
struct DeferState { int d, base, it; };
__device__ __forceinline__ bool defer_step(const Args& a, DeferState& st, int gw, int NGW, int lane, int dlimit) {
    while (st.d < dlimit) {
        ConvJob c; conv_job(a, defer_job(st.d), c); const int items = (c.K / 64) * (c.N / 64);
        if (st.it < 0) { int first = (gw - st.base) % NGW; if (first < 0) first += NGW; st.it = first; }
        if (st.it < items) { conv_item(c, nullptr, st.it, lane); st.it += NGW; return true; }
        st.base = (st.base + items) % NGW; ++st.d; st.it = -1;
    }
    return false;
}
__global__ __launch_bounds__(256) void k_convert(Args a) {
    __shared__ float scr_all[4][64 * 33];
    const int lane = threadIdx.x & 63, w = threadIdx.x >> 6;
    convert_body(a, scr_all[w], blockIdx.x * 4 + w, gridDim.x * 4, lane, true);
}

__device__ __forceinline__ void rowprep_body(const float* x, u16* hb, float* ssp, int gw, int NGW, int lane) {
    for (int r0 = gw; r0 < M; r0 += 2 * NGW) {
        f32x4 v[2][4];
#pragma unroll
        for (int q = 0; q < 2; ++q) { const int r = r0 + q * NGW; const f32x4* xr = (const f32x4*)(x + (size_t)(r < M ? r : r0) * D) + lane;
#pragma unroll
            for (int i = 0; i < 4; ++i) v[q][i] = xr[64 * i]; }
#pragma unroll
        for (int q = 0; q < 2; ++q) { const int r = r0 + q * NGW; if (r >= M) break;
            u32x2* orow = (u32x2*)(hb + (size_t)r * D) + lane; float sq[4];
#pragma unroll
            for (int i = 0; i < 4; ++i) { const f32x4 t = v[q][i]; u32x2 o; o.x = pk2(t[0], t[1]); o.y = pk2(t[2], t[3]); orow[64 * i] = o; sq[i] = wave_sum((t[0] * t[0] + t[1] * t[1]) + (t[2] * t[2] + t[3] * t[3])); }
            if (lane == 0) { f32x4 p; p[0] = sq[0]; p[1] = sq[1]; p[2] = sq[2]; p[3] = sq[3]; *(f32x4*)(ssp + 4 * (size_t)r) = p; } }
    }
}
__global__ __launch_bounds__(256) void k_rowprep(const float* x, u16* hb, float* ssp) { rowprep_body(x, hb, ssp, blockIdx.x * 4 + (threadIdx.x >> 6), gridDim.x * 4, threadIdx.x & 63); }
__global__ __launch_bounds__(256) void k_ssp(const float* h, float* ssp) {
    const int lane = threadIdx.x & 63, gw = blockIdx.x * 4 + (threadIdx.x >> 6), NGW = gridDim.x * 4;
    for (int r = gw; r < M; r += NGW) {
        const f32x4* xr = (const f32x4*)(h + (size_t)r * D) + lane * 4; float s = 0.f;
#pragma unroll
        for (int j = 0; j < 4; ++j) { const f32x4 v = xr[j]; s += (v[0] * v[0] + v[1] * v[1]) + (v[2] * v[2] + v[3] * v[3]); }
        s += __shfl_xor(s, 1); s += __shfl_xor(s, 2); s += __shfl_xor(s, 4); s += __shfl_xor(s, 8);
        if ((lane & 15) == 0) ssp[4 * (size_t)r + (lane >> 4)] = s;
    }
}

__device__ __forceinline__ void slot_info(const unsigned* cnt, int slot, int& e, int& pos, int& n) {
    int base = 0; e = -1; pos = 0; n = 0;
#pragma unroll
    for (int i = 0; i < NE; ++i) { const int c = (int)cnt[i], rows = ((c + 255) >> 8) << 8; if (e < 0 && slot < base + rows) { e = i; pos = slot - base; n = c; } base += rows; }
}

template <class E> __global__ __launch_bounds__(256) void k_ngemm(E e, int K) {
    const int lane = threadIdx.x & 63, w = threadIdx.x >> 6, fr = lane & 15, fq = lane >> 4;
    const int rb = blockIdx.y * 64, r0 = rb + (w >> 1) * 32, c0 = blockIdx.x * 64 + (w & 1) * 32;
    if (!e.tile_ok(rb)) return;
    constexpr int NP = E::PAIR ? 2 : 1;
    const u16* ap[2]; const u16* bp[2][NP];
#pragma unroll
    for (int i = 0; i < 2; ++i) ap[i] = e.a_row(r0 + 16 * i + fr) + 8 * fq;
#pragma unroll
    for (int j = 0; j < 2; ++j)
#pragma unroll
        for (int p = 0; p < NP; ++p) bp[j][p] = e.b_row(c0 + 16 * j + fr, p, rb) + 8 * fq;
    f32x4 acc[2][2][NP];
#pragma unroll
    for (int i = 0; i < 2; ++i)
#pragma unroll
        for (int j = 0; j < 2; ++j)
#pragma unroll
            for (int p = 0; p < NP; ++p) acc[i][j][p] = (f32x4){0.f, 0.f, 0.f, 0.f};
    for (int k = 0; k < K; k += 32) {
        bf16x8 av[2], bv[2][NP];
#pragma unroll
        for (int i = 0; i < 2; ++i) av[i] = *(const bf16x8*)(ap[i] + k);
#pragma unroll
        for (int j = 0; j < 2; ++j)
#pragma unroll
            for (int p = 0; p < NP; ++p) bv[j][p] = *(const bf16x8*)(bp[j][p] + k);
#pragma unroll
        for (int i = 0; i < 2; ++i)
#pragma unroll
            for (int j = 0; j < 2; ++j)
#pragma unroll
                for (int p = 0; p < NP; ++p) acc[i][j][p] = __builtin_amdgcn_mfma_f32_16x16x32_bf16(av[i], bv[j][p], acc[i][j][p], 0, 0, 0);
    }
#pragma unroll
    for (int i = 0; i < 2; ++i)
#pragma unroll
        for (int j = 0; j < 2; ++j)
#pragma unroll
            for (int q = 0; q < 4; ++q) { const float v0 = acc[i][j][0][q], v1 = E::PAIR ? acc[i][j][NP - 1][q] : 0.f; const float pv = __shfl_xor(v0, 8);
                e.store(r0 + 16 * i + 4 * fq + q, c0 + 16 * j + fr, v0, v1, pv); }
}

struct NE_Proj {
    static constexpr bool PAIR = false;
    const u16* A; const u16* Bt; const float* ssp; u16* Y; u16* XB;
    __device__ bool tile_ok(int) const { return true; }
    __device__ const u16* a_row(int r) const { return A + (size_t)r * D; }
    __device__ const u16* b_row(int c, int, int) const { return Bt + (size_t)c * D; }
    __device__ void store(int r, int c, float v, float, float) const { v *= rstd_of(ssp, r); if (c < 1024) Y[(size_t)r * D + c] = (u16)f2bf(gelu_tanh(v)); else XB[(size_t)r * D + c - 1024] = (u16)f2bf(v); }
};
struct NE_Gates {
    static constexpr bool PAIR = true;
    const u16* XC; const u16* WAX; const float* b_a; const float* b_x; const float* spl; float* LA; float* BX;
    __device__ bool tile_ok(int) const { return true; }
    __device__ const u16* a_row(int r) const { return XC + (size_t)r * D + 128 * blockIdx.z; }
    __device__ const u16* b_row(int c, int p, int) const { return WAX + ((size_t)blockIdx.z * 256 + c + 128 * p) * 128; }
    __device__ void store(int r, int c, float vr, float vi, float) const { const int ch = 128 * blockIdx.z + c;
        const float rg = sigmoidf_(vr + b_a[ch]), ig = sigmoidf_(vi + b_x[ch]), la = -8.0f * rg * spl[ch], xc = bf2f(XC[(size_t)r * D + ch]);
        LA[(size_t)r * D + ch] = la; BX[(size_t)r * D + ch] = sqrtf(one_minus_exp(2.0f * la)) * (ig * xc); }
};
struct NE_Res {
    static constexpr bool PAIR = false;
    const u16* A; const u16* Bt; int K; const float* Hin; float* Hout; u16* HB; const float* bias;
    __device__ bool tile_ok(int) const { return true; }
    __device__ const u16* a_row(int r) const { return A + (size_t)r * K; }
    __device__ const u16* b_row(int c, int, int) const { return Bt + (size_t)c * K; }
    __device__ void store(int r, int c, float v, float, float) const { const float h = (Hin ? Hin[(size_t)r * D + c] : bf2f(HB[(size_t)r * D + c])) + v + (bias ? bias[c] : 0.f); Hout[(size_t)r * D + c] = h; HB[(size_t)r * D + c] = (u16)f2bf(h); }
};
struct NE_GateUp {
    static constexpr bool PAIR = true;
    const u16* A; const u16* Bt; const float* ssp; u16* ACT;
    __device__ bool tile_ok(int) const { return true; }
    __device__ const u16* a_row(int r) const { return A + (size_t)r * D; }
    __device__ const u16* b_row(int c, int p, int) const { return Bt + (size_t)(256 * (c >> 7) + (c & 127) + 128 * p) * D; }
    __device__ void store(int r, int c, float g, float u, float) const { const float rs = rstd_of(ssp, r); ACT[(size_t)r * DFF + c] = (u16)f2bf(silu_(rs * g) * (rs * u)); }
};
struct NE_QKV {
    static constexpr bool PAIR = false;
    const u16* A; const u16* Bt; const float* ssp; const float* bias; const u16* rope; u16* Q; u16* Kb; u16* Vb;
    __device__ bool tile_ok(int) const { return true; }
    __device__ const u16* a_row(int r) const { return A + (size_t)r * D; }
    __device__ const u16* b_row(int c, int, int) const { return Bt + (size_t)c * D; }
    __device__ void store(int r, int c, float v, float, float pv) const {
        const float rs = rstd_of(ssp, r); v = rs * v + bias[c]; pv = rs * pv + bias[c ^ 8];
        const int d = c & 63;
        if (c < 1280 && d < 16) { const float cs = bf2f(rope[(size_t)r * 16 + (d & 7)]), sn = bf2f(rope[(size_t)r * 16 + 8 + (d & 7)]); v = d < 8 ? v * cs - pv * sn : v * cs + pv * sn; }
        if (c < 1024) Q[(size_t)r * D + c] = (u16)f2bf(v * (0.125f * LOG2E));
        else if (c < 1280) Kb[(size_t)r * KVD + c - 1024] = (u16)f2bf(v);
        else Vb[(size_t)r * KVD + c - 1280] = (u16)f2bf(v);
    }
};
struct NE_MoeUp {
    static constexpr bool PAIR = true;
    const u16* HB; const u16* WGU2; const float* ssp; const unsigned* cnt; const int* list; const float* gatew; u16* ACT2;
    __device__ bool tile_ok(int rb) const { int e, pos, n; slot_info(cnt, rb, e, pos, n); return e >= 0; }
    __device__ const u16* a_row(int r) const { int e, pos, n; slot_info(cnt, r, e, pos, n); const int tok = (e >= 0 && pos < n) ? (list[((size_t)e * M + pos) * 4] >> 1) : 0; return HB + (size_t)tok * D; }
    __device__ const u16* b_row(int c, int p, int rb) const { int e, pos, n; slot_info(cnt, rb, e, pos, n); return WGU2 + ((size_t)e * 7168 + 256 * (c >> 7) + (c & 127) + 128 * p) * D; }
    __device__ void store(int r, int c, float g, float u, float) const { int e, pos, n; slot_info(cnt, r, e, pos, n); float o = 0.f;
        if (e >= 0 && pos < n) { const int tok = list[((size_t)e * M + pos) * 4] >> 1; const float rs = rstd_of(ssp, tok); o = silu_(rs * g) * (rs * u) * gatew[((size_t)e * M + pos) * 4 + 1]; }
        ACT2[(size_t)r * DFF + c] = (u16)f2bf(o); }
};
struct NE_MoeDown {
    static constexpr bool PAIR = false;
    const u16* ACT2; const u16* WD2; const unsigned* cnt; const int* list; u16* MO;
    __device__ bool tile_ok(int rb) const { int e, pos, n; slot_info(cnt, rb, e, pos, n); return e >= 0; }
    __device__ const u16* a_row(int r) const { return ACT2 + (size_t)r * DFF; }
    __device__ const u16* b_row(int c, int, int rb) const { int e, pos, n; slot_info(cnt, rb, e, pos, n); return WD2 + ((size_t)e * 1024 + c) * DFF; }
    __device__ void store(int r, int c, float v, float, float) const { int e, pos, n; slot_info(cnt, r, e, pos, n);
        if (e >= 0 && pos < n) { const int tk = list[((size_t)e * M + pos) * 4]; MO[((size_t)(tk & 1) * M + (tk >> 1)) * D + c] = (u16)f2bf(v); } }
};

__global__ void k_conv1d(const u16* XB, const float* cw, const float* cb, u16* XC) {
    const size_t i = (size_t)blockIdx.x * blockDim.x + threadIdx.x; if (i >= (size_t)M * D) return;
    const int t = (int)(i >> 10), c = (int)(i & 1023); float s = cb[c];
#pragma unroll
    for (int k = 0; k < 4; ++k) { const int tt = t - 3 + k; if (tt >= 0) s += bf2f(XB[(size_t)tt * D + c]) * cw[k * D + c]; }
    XC[i] = (u16)f2bf(s);
}
__global__ __launch_bounds__(64) void k_scan_seq(const float* LA, const float* BX, const u16* Y, u16* G) {
    const int c = blockIdx.x * 64 + threadIdx.x; float h = 0.f;
    for (int t0 = 0; t0 < M; t0 += 8) {
        float la[8], bx[8], y[8];
#pragma unroll
        for (int j = 0; j < 8; ++j) { la[j] = LA[(size_t)(t0 + j) * D + c]; bx[j] = BX[(size_t)(t0 + j) * D + c]; y[j] = bf2f(Y[(size_t)(t0 + j) * D + c]); }
#pragma unroll
        for (int j = 0; j < 8; ++j) { h = __expf(la[j]) * h + bx[j]; G[(size_t)(t0 + j) * D + c] = (u16)f2bf(h * y[j]); }
    }
}

__global__ __launch_bounds__(64) void k_attn_ref(const u16* Q, const u16* Kb, const u16* Vb, const float* sinks, u16* ATT) {
    const int i = blockIdx.x * 64 + threadIdx.x; const int h = i / M, t = i % M, kvh = h >> 2;
    float q[64], o[64];
#pragma unroll
    for (int d = 0; d < 64; d += 2) { const unsigned w = *(const unsigned*)(Q + (size_t)t * D + 64 * h + d); q[d] = bf2f(w & 0xffffu); q[d + 1] = bf2f(w >> 16); o[d] = 0.f; o[d + 1] = 0.f; }
    float m = sinks[h] * LOG2E, l = 1.0f;
    const int j0 = t - (WIN - 1) > 0 ? t - (WIN - 1) : 0;
    for (int j = j0; j <= t; ++j) {
        const u16* kr = Kb + (size_t)j * KVD + 64 * kvh; const u16* vr = Vb + (size_t)j * KVD + 64 * kvh; float s = 0.f;
#pragma unroll
        for (int d = 0; d < 64; d += 2) { const unsigned w = *(const unsigned*)(kr + d); s += q[d] * bf2f(w & 0xffffu) + q[d + 1] * bf2f(w >> 16); }
        const float mn = fmaxf(m, s), al = exp2f(m - mn), p = exp2f(s - mn); l = l * al + p; m = mn;
#pragma unroll
        for (int d = 0; d < 64; d += 2) { const unsigned w = *(const unsigned*)(vr + d); o[d] = o[d] * al + p * bf2f(w & 0xffffu); o[d + 1] = o[d + 1] * al + p * bf2f(w >> 16); }
    }
    const float il = 1.0f / l;
#pragma unroll
    for (int d = 0; d < 64; d += 2) *(unsigned*)(ATT + (size_t)t * D + 64 * h + d) = pk2(o[d] * il, o[d + 1] * il);
}

__device__ __forceinline__ void router_group(const u16* HB, const float* WR, const float* ssp, unsigned* cnt, int* list, float* gatew, int grp, float* lds  , int w  ) {
    const int lane = lane_now();
    float v[64];
    {   u32x4 h[8][2];
#pragma unroll
        for (int tt = 0; tt < 8; ++tt) { const u32x4* hr = (const u32x4*)(HB + (size_t)(64 * grp + 8 * w + tt) * D + 16 * lane); h[tt][0] = hr[0]; h[tt][1] = hr[1]; }
#pragma unroll
        for (int e = 0; e < 8; ++e) { const f32x4* wr = (const f32x4*)(WR + e * 1024 + 16 * lane); const f32x4 w0 = wr[0], w1 = wr[1], w2 = wr[2], w3 = wr[3];
#pragma unroll
            for (int tt = 0; tt < 8; ++tt) { const u32x4 a = h[tt][0], b = h[tt][1]; float s = 0.f;
                s += bf2f(a.x & 0xffffu) * w0[0]; s += bf2f(a.x >> 16) * w0[1]; s += bf2f(a.y & 0xffffu) * w0[2]; s += bf2f(a.y >> 16) * w0[3];
                s += bf2f(a.z & 0xffffu) * w1[0]; s += bf2f(a.z >> 16) * w1[1]; s += bf2f(a.w & 0xffffu) * w1[2]; s += bf2f(a.w >> 16) * w1[3];
                s += bf2f(b.x & 0xffffu) * w2[0]; s += bf2f(b.x >> 16) * w2[1]; s += bf2f(b.y & 0xffffu) * w2[2]; s += bf2f(b.y >> 16) * w2[3];
                s += bf2f(b.z & 0xffffu) * w3[0]; s += bf2f(b.z >> 16) * w3[1]; s += bf2f(b.w & 0xffffu) * w3[2]; s += bf2f(b.w >> 16) * w3[3];
                v[tt * 8 + e] = s; } }
    }
#pragma unroll
    for (int b = 5; b >= 0; --b) { const int half = 1 << b; const bool up = ((lane >> b) & 1) != 0;
#pragma unroll
        for (int i = 0; i < half; ++i) { const float lo_ = v[i], hi_ = v[i + half]; const float send = up ? lo_ : hi_, keep = up ? hi_ : lo_; v[i] = keep + __shfl_xor(send, half); } }
    float* lgt = lds + 256 + 64 * w; lgt[lane] = v[0];
    __syncthreads();
    if (lane < 8) {
        const int tl = 8 * w + lane, t = 64 * grp + tl;
        const float rs = rstd_of(ssp, t);
        float lg[8];
#pragma unroll
        for (int e = 0; e < 8; ++e) lg[e] = lgt[lane * 8 + e];
        int e1 = 0; float v1 = lg[0];
#pragma unroll
        for (int e = 1; e < 8; ++e) if (lg[e] > v1) { v1 = lg[e]; e1 = e; }
        int e2 = -1; float v2 = -3.0e38f;
#pragma unroll
        for (int e = 0; e < 8; ++e) if (e != e1 && lg[e] > v2) { v2 = lg[e]; e2 = e; }
        const float g1 = 1.0f / (1.0f + __expf((v2 - v1) * rs));
        lds[tl * 4 + 0] = __builtin_bit_cast(float, e1); lds[tl * 4 + 1] = __builtin_bit_cast(float, e2); lds[tl * 4 + 2] = g1; lds[tl * 4 + 3] = 1.0f - g1;
    }
    __syncthreads();
    if (w == 0) {
        const int e1 = __builtin_bit_cast(int, lds[lane * 4 + 0]), e2 = __builtin_bit_cast(int, lds[lane * 4 + 1]); const float g1 = lds[lane * 4 + 2], g2 = lds[lane * 4 + 3];
        const int t = 64 * grp + lane; const unsigned long long lt = (1ull << lane) - 1ull; const float rsl = rstd_of(ssp, t);
        unsigned mycnt = 0u, off1 = 0u, off2 = 0u;
#pragma unroll
        for (int e = 0; e < 8; ++e) {
            const unsigned long long m1 = __ballot(e1 == e), m2 = __ballot(e2 == e); const unsigned n1 = (unsigned)__popcll(m1), n2 = (unsigned)__popcll(m2);
            if (lane == e) mycnt = n1 + n2;
            if (e1 == e) off1 = (unsigned)__popcll(m1 & lt);
            if (e2 == e) off2 = n1 + (unsigned)__popcll(m2 & lt);
        }
        unsigned base = 0u; if (lane < 8 && mycnt > 0u) base = atomicAdd(cnt + lane, mycnt);
        const unsigned b1 = (unsigned)__shfl((int)base, e1), b2 = (unsigned)__shfl((int)base, e2);
        { u32x4 r; r.x = (unsigned)(2 * t); r.y = __builtin_bit_cast(unsigned, g1); r.z = __builtin_bit_cast(unsigned, rsl); r.w = 0u; *(u32x4*)(list + ((size_t)e1 * M + b1 + off1) * 4) = r; }
        { u32x4 r; r.x = (unsigned)(2 * t + 1); r.y = __builtin_bit_cast(unsigned, g2); r.z = __builtin_bit_cast(unsigned, rsl); r.w = 0u; *(u32x4*)(list + ((size_t)e2 * M + b2 + off2) * 4) = r; }
    }
    __syncthreads();
}
__global__ __launch_bounds__(512) void k_router(Args a) {
    __shared__ float lds[64 * 4 + 512];
    unsigned* cnt = (unsigned*)(a.ws + WS_CTL) + CW_CNT;
    for (int g = blockIdx.x; g < M / 64; g += gridDim.x)
        router_group((const u16*)(a.ws + WS_HB), (const float*)(a.ws + WS_WR), (const float*)(a.ws + WS_SSP + 3 * 256 * 1024), cnt, (int*)(a.ws + WS_LIST), (float*)(a.ws + WS_GATEW), g, lds, (int)(threadIdx.x >> 6));
}

__device__ __forceinline__ void final_body(float* H, const u16* HBr, const u16* MO, const float* g, int gw, int NGW, int lane) {
    const f32x4 g00 = *(const f32x4*)(g + 8 * lane), g01 = *(const f32x4*)(g + 8 * lane + 4), g10 = *(const f32x4*)(g + 512 + 8 * lane), g11 = *(const f32x4*)(g + 512 + 8 * lane + 4);
    for (int r0 = gw; r0 < M; r0 += 2 * NGW) {
        u32x4 hb[2][2], m0[2][2], m1[2][2];
#pragma unroll
        for (int q = 0; q < 2; ++q) { const int r = r0 + q * NGW; const int rr = r < M ? r : r0;
#pragma unroll
            for (int j = 0; j < 2; ++j) { const size_t o = (size_t)rr * D + 512 * j + 8 * lane;
                hb[q][j] = *(const u32x4*)(HBr + o); m0[q][j] = *(const u32x4*)(MO + o); m1[q][j] = *(const u32x4*)(MO + (size_t)M * D + o); } }
#pragma unroll
        for (int q = 0; q < 2; ++q) { const int r = r0 + q * NGW; if (r >= M) break;
            f32x4 v[2][2]; float s = 0.f;
#pragma unroll
            for (int j = 0; j < 2; ++j) { const u32x4 a = hb[q][j], b = m0[q][j], c = m1[q][j];
                v[j][0] = (f32x4){bf2f(a.x & 0xffffu) + (bf2f(b.x & 0xffffu) + bf2f(c.x & 0xffffu)), bf2f(a.x >> 16) + (bf2f(b.x >> 16) + bf2f(c.x >> 16)), bf2f(a.y & 0xffffu) + (bf2f(b.y & 0xffffu) + bf2f(c.y & 0xffffu)), bf2f(a.y >> 16) + (bf2f(b.y >> 16) + bf2f(c.y >> 16))};
                v[j][1] = (f32x4){bf2f(a.z & 0xffffu) + (bf2f(b.z & 0xffffu) + bf2f(c.z & 0xffffu)), bf2f(a.z >> 16) + (bf2f(b.z >> 16) + bf2f(c.z >> 16)), bf2f(a.w & 0xffffu) + (bf2f(b.w & 0xffffu) + bf2f(c.w & 0xffffu)), bf2f(a.w >> 16) + (bf2f(b.w >> 16) + bf2f(c.w >> 16))};
                s += ((v[j][0][0] * v[j][0][0] + v[j][0][1] * v[j][0][1]) + (v[j][0][2] * v[j][0][2] + v[j][0][3] * v[j][0][3])) + ((v[j][1][0] * v[j][1][0] + v[j][1][1] * v[j][1][1]) + (v[j][1][2] * v[j][1][2] + v[j][1][3] * v[j][1][3])); }
            const float rs = rsqrtf(wave_sum(s) * (1.0f / D) + EPS);
            float* orow = H + (size_t)r * D + 8 * lane;
            *(f32x4*)(orow) = v[0][0] * rs * g00; *(f32x4*)(orow + 4) = v[0][1] * rs * g01; *(f32x4*)(orow + 512) = v[1][0] * rs * g10; *(f32x4*)(orow + 516) = v[1][1] * rs * g11; }
    }
}
__global__ __launch_bounds__(256) void k_final(float* H, const u16* HBr, const u16* MO, const float* g) { final_body(H, HBr, MO, g, blockIdx.x * 4 + (threadIdx.x >> 6), gridDim.x * 4, threadIdx.x & 63); }

#define LAS __attribute__((address_space(3)))
typedef float f32x16 __attribute__((ext_vector_type(16)));
typedef short s16x4 __attribute__((ext_vector_type(4)));
typedef float f32x2v_t __attribute__((ext_vector_type(2)));
__device__ __forceinline__ unsigned cvt_pk_bf16(float lo, float hi) { unsigned r; asm volatile("v_cvt_pk_bf16_f32 %0, %1, %2" : "=v"(r) : "v"(lo), "v"(hi)); return r; }
__device__ __forceinline__ float fexp2(float x) { return __builtin_amdgcn_exp2f(x); }
__device__ __forceinline__ float frcp(float x) { return __builtin_amdgcn_rcpf(x); }
__device__ __forceinline__ float fsigmoid(float x) { return frcp(1.0f + fexp2(-LOG2E * x)); }
__device__ __forceinline__ float fsilu(float x) { return x * frcp(1.0f + fexp2(-LOG2E * x)); }
__device__ __forceinline__ float fgelu_tanh(float x) { const float z = 0.7978845608028654f * (x + 0.044715f * x * x * x); return x * frcp(1.0f + fexp2(-2.0f * LOG2E * z)); }

__device__ __forceinline__ u32x2 pk8_fp8(const float (&o)[8], float sc) {
    float t[8];
#pragma unroll
    for (int i = 0; i < 8; ++i) t[i] = __builtin_fminf(__builtin_fmaxf(o[i] * sc, -448.0f), 448.0f);
    int w0 = 0, w1 = 0; w0 = __builtin_amdgcn_cvt_pk_fp8_f32(t[0], t[1], w0, false); w0 = __builtin_amdgcn_cvt_pk_fp8_f32(t[2], t[3], w0, true);
    w1 = __builtin_amdgcn_cvt_pk_fp8_f32(t[4], t[5], w1, false); w1 = __builtin_amdgcn_cvt_pk_fp8_f32(t[6], t[7], w1, true);
    u32x2 r; r.x = (unsigned)w0; r.y = (unsigned)w1; return r;
}
typedef float f32x2p __attribute__((ext_vector_type(2)));
__device__ __forceinline__ f32x2p silu_mul2(f32x2p g, f32x2p u, float c1, float k) {
    const f32x2p ea = g * c1; f32x2p e; e.x = fexp2(ea.x); e.y = fexp2(ea.y);
    const f32x2p d = e * k + k; f32x2p r; r.x = frcp(d.x); r.y = frcp(d.y);
    return (g * u) * r;
}
__device__ __forceinline__ f32x2p gelu_tanh2(f32x2p x) {
    const f32x2p x2 = x * x, inner = x * (x2 * 0.044715f + 1.0f), ea = inner * (-2.0f * LOG2E * 0.7978845608028654f);
    f32x2p e; e.x = fexp2(ea.x); e.y = fexp2(ea.y); const f32x2p d = e + 1.0f; f32x2p r; r.x = frcp(d.x); r.y = frcp(d.y);
    return x * r;
}
constexpr int RING_BYTES = 131072;
constexpr int LX_P = RING_BYTES;
constexpr int LX_TBL = RING_BYTES + 4096;
constexpr int LX_ROUT = RING_BYTES + 8192;
constexpr int LX_MISC = RING_BYTES + 12288;
constexpr int LDS_BYTES = 147456;

namespace pg8 {
constexpr int BM = 256, BK = 64, HALF = 128, HTB = HALF * BK * 2, STAGE_BYTES = 8 * HTB, NXCD = 8;
__device__ __forceinline__ int lds_byte(int r, int c) { const int st = (r >> 4) * 2 + (c >> 5), rr = r & 15, cc = c & 31, ob = rr * 64 + cc * 2; return st * 1024 + (ob ^ (((ob >> 9) & 1) << 5)); }
__device__ __forceinline__ void stage_rc(int b, int& R, int& C) { const int st = b / 1024, sb = b % 1024, swz = sb ^ (((sb >> 9) & 1) << 5); R = (st >> 1) * 16 + swz / 64; C = (st & 1) * 32 + (swz % 64) / 2; }
__device__ __forceinline__ int perm32(int rho) { const int n = rho >> 4, i = rho & 15; return 8 * (i >> 2) + 4 * n + (i & 3); }

struct Unit { int pm, pn, e, kb, ke; };
struct TileOrder {
    int nM, nN, nwg, G, c, WGM;
    int wst, wsz;
    __device__ __forceinline__ void init(int nM_, int nN_, int G_, int c_, int wgm = 4) { nM = nM_; nN = nN_; nwg = nM * nN; G = G_; c = c_; WGM = wgm; wst = 0; wsz = -1; }
    __device__ __forceinline__ void init_weighted(unsigned fastmask) {
        if (G != 256) return;
        const int lo = (nwg / 256) * 32; int extra = nwg - 8 * lo; const int nfast = __popc(fastmask & 0xffu), nslow = 8 - nfast;
        int fx = 0, sx = 0;
        if (nfast > 0 && extra <= 32 * nfast) { fx = (extra + nfast - 1) / nfast; sx = 0; } else { fx = nfast > 0 ? 32 : 0; const int rem = extra - fx * nfast; sx = nslow > 0 ? (rem + nslow - 1) / nslow : 0; }
        int start = 0, left_f = nfast > 0 && extra <= 32 * nfast ? extra : fx * nfast, left_s = extra - left_f; const int x = c & 7;
        for (int k = 0; k < 8; ++k) { const bool f = (fastmask >> k) & 1u; int e = f ? (fx < left_f ? fx : left_f) : (sx < left_s ? sx : left_s); if (f) left_f -= e; else left_s -= e;
            if (k == x) { wst = start; wsz = lo + e; } start += lo + e; }
    }
    __device__ __forceinline__ bool next_tile(int i, int& pm, int& pn) const {
        int wgid;
        if (wsz >= 0) { const int off = i * 32 + (c >> 3); if (off >= wsz) return false; wgid = wst + off; }
        else { const long L = (long)i * G + c; if (L >= nwg) return false;
            wgid = (int)L; { const int q = nwg / NXCD, r = nwg % NXCD, xcd = wgid % NXCD, off = wgid / NXCD; wgid = (xcd < r ? xcd * (q + 1) : r * (q + 1) + (xcd - r) * q) + off; } }
        const int nig = WGM * nN, gid = wgid / nig, fm = gid * WGM, gsz = (nM - fm) < WGM ? (nM - fm) : WGM;
        const int w2 = wgid % nig; if (gsz == WGM) { pm = fm + (w2 & (WGM - 1)); pn = w2 / WGM; } else { pm = fm + (w2 % gsz); pn = w2 / gsz; }
        return true;
    }
};
struct DenseSched {
    static constexpr bool SK = false;
    TileOrder o; const char* A; const char* Bt; int K;
    __device__ __forceinline__ bool next(int i, Unit& u) const { u.e = 0; return o.next_tile(i, u.pm, u.pn); }
    __device__ __forceinline__ const char* a_base(const Unit& u) const { return A + (size_t)u.pm * 256 * K * 2; }
    __device__ __forceinline__ const char* b_base(const Unit& u) const { return Bt + (size_t)u.pn * 256 * K * 2; }
    __device__ __forceinline__ int a_raw(const Unit&, int) const { return 0; }
    __device__ __forceinline__ unsigned a_cvt(int) const { return 0u; }
};
struct MoeSched {
    static constexpr bool SK = false;
    TileOrder o; const char* A; const char* Bt; int K; size_t bstride; const int* list; const LAS int* tbl;
    __device__ __forceinline__ bool next(int i, Unit& u) const {
        if (!o.next_tile(i, u.pm, u.pn)) return false;
        int e = 0;
#pragma unroll
        for (int j = 1; j < 8; ++j) e += (u.pm >= tbl[8 + j]) ? 1 : 0;
        u.e = __builtin_amdgcn_readfirstlane(e); return true;
    }
    __device__ __forceinline__ const char* a_base(const Unit& u) const { return list ? A : A + (size_t)u.pm * 256 * K * 2; }
    __device__ __forceinline__ const char* b_base(const Unit& u) const { return Bt + (size_t)u.e * bstride + (size_t)u.pn * 256 * K * 2; }
    __device__ __forceinline__ int a_raw(const Unit& u, int rl) const {
        const int pos = (u.pm - tbl[8 + u.e]) * 256 + rl; return list[((size_t)u.e * M + (pos < tbl[u.e] ? pos : 0)) * 4]; }
    __device__ __forceinline__ unsigned a_cvt(int raw) const { return (unsigned)(raw >> 1) * (unsigned)(K * 2); }
};
struct MoeSchedSK {
    static constexpr bool SK = true;
    const char* A; const char* Bt; int K; size_t bstride; const LAS int* tbl; int nM, j, s0, s1, IT, slot; float* part; unsigned* flags;
    __device__ __forceinline__ void init(int nM_, int bx, int K_) { nM = nM_; K = K_; IT = K_ >> 7; j = bx >> 3; const int x = bx & 7, T = ((nM_ + 7) >> 3) * IT; s0 = x * T / 8; s1 = (x + 1) * T / 8; slot = bx; }
    __device__ __forceinline__ bool next(int i, Unit& u) const {
        const int su0 = s0 / IT, su = su0 + i;
        if (su * IT >= s1) return false;
        u.pm = 8 * su + (j & 7); u.pn = j >> 3;
        if (u.pm >= nM) return false;
        u.kb = i == 0 ? s0 - su0 * IT : 0; const int rem = s1 - su * IT; u.ke = rem < IT ? rem : IT;
        int e = 0;
#pragma unroll
        for (int q = 1; q < 8; ++q) e += (u.pm >= tbl[8 + q]) ? 1 : 0;
        u.e = __builtin_amdgcn_readfirstlane(e); return true;
    }
    __device__ __forceinline__ const char* a_base(const Unit& u) const { return A + (size_t)u.pm * 256 * K * 2 + (size_t)u.kb * 256; }
    __device__ __forceinline__ const char* b_base(const Unit& u) const { return Bt + (size_t)u.e * bstride + (size_t)u.pn * 256 * K * 2 + (size_t)u.kb * 256; }
    __device__ __forceinline__ int a_raw(const Unit&, int) const { return 0; }
    __device__ __forceinline__ unsigned a_cvt(int) const { return 0u; }
};
struct EpiCtx { int wr, wc, fr, fq, tid; LAS unsigned char* lds; };
typedef int i32x4 __attribute__((ext_vector_type(4)));
typedef int i32x8 __attribute__((ext_vector_type(8)));
__device__ __forceinline__ i32x8 cat8(bf16x8 lo, bf16x8 hi) { return __builtin_shufflevector(__builtin_bit_cast(i32x4, lo), __builtin_bit_cast(i32x4, hi), 0, 1, 2, 3, 4, 5, 6, 7); }
#define ACC_T const f32x4 (&acc)[2][2][4][2]

struct EpiProj {
    static constexpr bool PRELOAD = false;
    const float* ssp; u16* Y; u16* XB;
    __device__ __forceinline__ void operator()(ACC_T, const Unit& u, const EpiCtx& c) const {
        const int row0 = u.pm * 256 + c.wr * 64 + c.fr; const bool isY = u.pn < 4; u16* base = isY ? Y : XB; const int col0 = (u.pn & 3) * 256 + c.wc * 32 + 8 * c.fq;
        float rsv[8];
#pragma unroll
        for (int i = 0; i < 8; ++i) rsv[i] = rstd_of(ssp, row0 + (i >> 2) * 128 + (i & 3) * 16);
#pragma unroll
        for (int ai = 0; ai < 2; ++ai)
#pragma unroll
            for (int m = 0; m < 4; ++m) { const int row = row0 + ai * 128 + m * 16; const float rs = rsv[ai * 4 + m]; u16* rowp = base + (size_t)row * D + col0;
#pragma unroll
                for (int bj = 0; bj < 2; ++bj) { f32x4 v0 = acc[ai][bj][m][0] * rs, v1 = acc[ai][bj][m][1] * rs;
                    if (isY) { const f32x2p a0 = gelu_tanh2((f32x2p){v0[0], v0[1]}), a1 = gelu_tanh2((f32x2p){v0[2], v0[3]}), b0 = gelu_tanh2((f32x2p){v1[0], v1[1]}), b1 = gelu_tanh2((f32x2p){v1[2], v1[3]});
                        v0 = (f32x4){a0.x, a0.y, a1.x, a1.y}; v1 = (f32x4){b0.x, b0.y, b1.x, b1.y}; }
                    u32x4 w; w.x = cvt_pk_bf16(v0[0], v0[1]); w.y = cvt_pk_bf16(v0[2], v0[3]); w.z = cvt_pk_bf16(v1[0], v1[1]); w.w = cvt_pk_bf16(v1[2], v1[3]);
                    *(u32x4*)(rowp + bj * 128) = w; } }
    }
};
struct EpiGateUp {
    static constexpr bool PRELOAD = false;
    const float* ssp; u16* ACT;
    __device__ __forceinline__ void operator()(ACC_T, const Unit& u, const EpiCtx& c) const {
        const int row0 = u.pm * 256 + c.wr * 64 + c.fr, col0 = u.pn * 128 + c.wc * 32 + 8 * c.fq;
        float rsv[8];
#pragma unroll
        for (int i = 0; i < 8; ++i) rsv[i] = rstd_of(ssp, row0 + (i >> 2) * 128 + (i & 3) * 16);
#pragma unroll
        for (int ai = 0; ai < 2; ++ai)
#pragma unroll
            for (int m = 0; m < 4; ++m) { const int row = row0 + ai * 128 + m * 16; const float rs = rsv[ai * 4 + m], c1 = -LOG2E * rs, k = frcp(rs * rs); float o[8];
#pragma unroll
                for (int n = 0; n < 2; ++n)
#pragma unroll
                    for (int j = 0; j < 4; j += 2) { const f32x2p r2 = silu_mul2((f32x2p){acc[ai][0][m][n][j], acc[ai][0][m][n][j + 1]}, (f32x2p){acc[ai][1][m][n][j], acc[ai][1][m][n][j + 1]}, c1, k); o[4 * n + j] = r2.x; o[4 * n + j + 1] = r2.y; }
                u32x4 w; w.x = cvt_pk_bf16(o[0], o[1]); w.y = cvt_pk_bf16(o[2], o[3]); w.z = cvt_pk_bf16(o[4], o[5]); w.w = cvt_pk_bf16(o[6], o[7]);
                *(u32x4*)(ACT + (size_t)row * DFF + col0) = w; }
    }
};
struct EpiRes {
    static constexpr bool PRELOAD = true;
    u16* HB; const float* bias; float* ssp; unsigned char* HB8; float ascale, iascale;
    __device__ __forceinline__ void pre_issue(u32x4 (&raw)[16], const Unit& u, const EpiCtx& c) const {
        const __amdgpu_buffer_rsrc_t rh = __builtin_amdgcn_make_buffer_rsrc((char*)(HB + (size_t)u.pm * 256 * D), 0, 256 * D * 2, 0x00020000);
        const int vo = ((c.wr * 64 + c.fr) * D + u.pn * 256 + c.wc * 32 + 8 * c.fq) * 2;
#pragma unroll
        for (int ai = 0; ai < 2; ++ai)
#pragma unroll
            for (int m = 0; m < 4; ++m)
#pragma unroll
                for (int bj = 0; bj < 2; ++bj) raw[(ai * 4 + m) * 2 + bj] = __builtin_amdgcn_raw_buffer_load_b128(rh, vo + bj * 256, (ai * 128 + m * 16) * D * 2, 0);
    }
    __device__ __forceinline__ void pre_unpack(f32x4 (&acc)[2][2][4][2], const u32x4 (&raw)[16]) const {
#pragma unroll
        for (int ai = 0; ai < 2; ++ai)
#pragma unroll
            for (int m = 0; m < 4; ++m)
#pragma unroll
                for (int bj = 0; bj < 2; ++bj) { const u32x4 hb = raw[(ai * 4 + m) * 2 + bj];
                    acc[ai][bj][m][0] = (f32x4){bf2f(hb.x & 0xffffu), bf2f(hb.x >> 16), bf2f(hb.y & 0xffffu), bf2f(hb.y >> 16)} * iascale;
                    acc[ai][bj][m][1] = (f32x4){bf2f(hb.z & 0xffffu), bf2f(hb.z >> 16), bf2f(hb.w & 0xffffu), bf2f(hb.w >> 16)} * iascale; }
    }
    __device__ __forceinline__ void operator()(ACC_T, const Unit& u, const EpiCtx& c) const {
        const int col0 = u.pn * 256 + c.wc * 32 + 8 * c.fq;
        const __amdgpu_buffer_rsrc_t rh = __builtin_amdgcn_make_buffer_rsrc((char*)(HB + (size_t)u.pm * 256 * D), 0, 256 * D * 2, 0x00020000);
        const int vo = ((c.wr * 64 + c.fr) * D + col0) * 2;
        f32x4 bv[2][2];
#pragma unroll
        for (int bj = 0; bj < 2; ++bj)
#pragma unroll
            for (int n = 0; n < 2; ++n) { bv[bj][n] = (f32x4){0.f, 0.f, 0.f, 0.f}; if (bias) bv[bj][n] = *(const f32x4*)(bias + col0 + bj * 128 + 4 * n); }
        LAS float* P = (LAS float*)(c.lds + LX_P);
#pragma unroll
        for (int ai = 0; ai < 2; ++ai)
#pragma unroll
            for (int m = 0; m < 4; ++m) { const int rl = ai * 128 + c.wr * 64 + m * 16 + c.fr; float s = 0.f;
#pragma unroll
                for (int bj = 0; bj < 2; ++bj) {
                    const f32x4 h0 = acc[ai][bj][m][0] * ascale + bv[bj][0], h1 = acc[ai][bj][m][1] * ascale + bv[bj][1];
                    u32x4 w; w.x = cvt_pk_bf16(h0[0], h0[1]); w.y = cvt_pk_bf16(h0[2], h0[3]); w.z = cvt_pk_bf16(h1[0], h1[1]); w.w = cvt_pk_bf16(h1[2], h1[3]);
                    __builtin_amdgcn_raw_buffer_store_b128(w, rh, vo + bj * 256, (ai * 128 + m * 16) * D * 2, 0);
                    if (HB8) { const float o8[8] = {h0[0], h0[1], h0[2], h0[3], h1[0], h1[1], h1[2], h1[3]};
                        const __amdgpu_buffer_rsrc_t r8 = __builtin_amdgcn_make_buffer_rsrc((char*)(HB8 + (size_t)u.pm * 256 * D), 0, 256 * D, 0x00020000);
                        __builtin_amdgcn_raw_buffer_store_b64(pk8_fp8(o8, S8_A), r8, (vo >> 1) + bj * 128, (ai * 128 + m * 16) * D, 0); }
                    s += ((h0[0] * h0[0] + h0[1] * h0[1]) + (h0[2] * h0[2] + h0[3] * h0[3])) + ((h1[0] * h1[0] + h1[1] * h1[1]) + (h1[2] * h1[2] + h1[3] * h1[3])); }
                s += __shfl_xor(s, 16); s += __shfl_xor(s, 32);
                if (c.fq == 0) P[rl * 4 + c.wc] = s; }
        asm volatile("s_waitcnt lgkmcnt(0)" ::: "memory"); __builtin_amdgcn_s_barrier(); asm volatile("" ::: "memory");
        if (c.tid < 256) { const f32x4 p = *(const LAS f32x4*)(P + 4 * c.tid); ssp[(size_t)(u.pm * 256 + c.tid) * 4 + u.pn] = (p[0] + p[1]) + (p[2] + p[3]); }
    }
};
struct EpiQKV {
    static constexpr bool PRELOAD = false;
    const float* ssp; const float* bias; const u16* rope; u16* Q; u16* Kb; u16* Vb; float ascale;
    __device__ __forceinline__ void operator()(ACC_T, const Unit& u, const EpiCtx& c) const {
        const int row0 = u.pm * 256 + c.wr * 64 + c.fr, bcol0 = u.pn * 256 + c.wc * 32 + 8 * c.fq;
        u16* base; int pitch, col0; float sc = 1.0f;
        if (u.pn < 4) { base = Q; pitch = D; col0 = bcol0; sc = 0.125f * LOG2E; } else if (u.pn == 4) { base = Kb; pitch = KVD; col0 = bcol0 - 1024; } else { base = Vb; pitch = KVD; col0 = bcol0 - 1280; }
        const bool rot = (u.pn < 5) && ((c.wc & 1) == 0);
        float rsv[8];
#pragma unroll
        for (int i = 0; i < 8; ++i) rsv[i] = rstd_of(ssp, row0 + (i >> 2) * 128 + (i & 3) * 16) * ascale;
#pragma unroll
        for (int bj = 0; bj < 2; ++bj) {
            const f32x4 bv0 = *(const f32x4*)(bias + bcol0 + bj * 128), bv1 = *(const f32x4*)(bias + bcol0 + bj * 128 + 4);
#pragma unroll
            for (int g = 0; g < 4; ++g) {
                u32x4 rpv[2][2];
                if (rot) {
#pragma unroll
                    for (int q2 = 0; q2 < 2; ++q2) { const u32x4* rp = (const u32x4*)(rope + (size_t)(row0 + (g >> 1) * 128 + ((g & 1) * 2 + q2) * 16) * 16); rpv[q2][0] = rp[0]; rpv[q2][1] = rp[1]; } }
#pragma unroll
                for (int q2 = 0; q2 < 2; ++q2) { const int ai = g >> 1, m = (g & 1) * 2 + q2; const int row = row0 + ai * 128 + m * 16; const float rs = rsv[ai * 4 + m];
                    f32x4 v0 = acc[ai][bj][m][0] * rs + bv0, v1 = acc[ai][bj][m][1] * rs + bv1;
                    if (rot) { const u32x4 cw = rpv[q2][0], sw = rpv[q2][1];
                        const f32x4 cs0 = (f32x4){bf2f(cw.x & 0xffffu), bf2f(cw.x >> 16), bf2f(cw.y & 0xffffu), bf2f(cw.y >> 16)}, cs1 = (f32x4){bf2f(cw.z & 0xffffu), bf2f(cw.z >> 16), bf2f(cw.w & 0xffffu), bf2f(cw.w >> 16)};
                        f32x4 sn0 = (f32x4){bf2f(sw.x & 0xffffu), bf2f(sw.x >> 16), bf2f(sw.y & 0xffffu), bf2f(sw.y >> 16)}, sn1 = (f32x4){bf2f(sw.z & 0xffffu), bf2f(sw.z >> 16), bf2f(sw.w & 0xffffu), bf2f(sw.w >> 16)};
                        if (c.fq == 0) { sn0 = -sn0; sn1 = -sn1; }
                        f32x4 p0, p1;
#pragma unroll
                        for (int j = 0; j < 4; ++j) { p0[j] = __shfl_xor(v0[j], 16); p1[j] = __shfl_xor(v1[j], 16); }
                        if (c.fq < 2) { v0 = v0 * cs0 + p0 * sn0; v1 = v1 * cs1 + p1 * sn1; } }
                    v0 = v0 * sc; v1 = v1 * sc;
                    u32x4 w; w.x = cvt_pk_bf16(v0[0], v0[1]); w.y = cvt_pk_bf16(v0[2], v0[3]); w.z = cvt_pk_bf16(v1[0], v1[1]); w.w = cvt_pk_bf16(v1[2], v1[3]);
                    *(u32x4*)(base + (size_t)row * pitch + col0 + bj * 128) = w; } } }
    }
};
struct EpiMoeUp {
    static constexpr bool PRELOAD = false;
    const float* ssp; const int* list; const float* gatew; const LAS int* tbl; u16* ACT2;
    __device__ __forceinline__ void operator()(ACC_T, const Unit& u, const EpiCtx& c) const {
        const int col0 = u.pn * 128 + c.wc * 32 + 8 * c.fq, n_e = tbl[u.e], pos0 = (u.pm - tbl[8 + u.e]) * 256;
        u32x4 rec[8];
#pragma unroll
        for (int i = 0; i < 8; ++i) { const int pos = pos0 + (i >> 2) * 128 + c.wr * 64 + (i & 3) * 16 + c.fr; rec[i] = *(const u32x4*)(list + ((size_t)u.e * M + (pos < n_e ? pos : 0)) * 4); }
#pragma unroll
        for (int ai = 0; ai < 2; ++ai)
#pragma unroll
            for (int m = 0; m < 4; ++m) { const int rl = ai * 128 + c.wr * 64 + m * 16 + c.fr;
                const bool valid = pos0 + rl < n_e; const unsigned gwu = rec[ai * 4 + m].y, rsu = rec[ai * 4 + m].z;
                const float gw = valid ? u2f(gwu) : 0.f; const float rs = u2f(rsu) * (MOE_FP8 ? 1.0f / (S8_A * S8_W) : 1.0f), c1 = -LOG2E * rs, k = valid ? __builtin_fminf(frcp(rs * rs * gw * (MOE_FP8 ? S8_ACT : 1.0f)), 1.0e30f) : 1.0e30f; float o[8];
#pragma unroll
                for (int n = 0; n < 2; ++n)
#pragma unroll
                    for (int j = 0; j < 4; j += 2) { const f32x2p r2 = silu_mul2((f32x2p){acc[ai][0][m][n][j], acc[ai][0][m][n][j + 1]}, (f32x2p){acc[ai][1][m][n][j], acc[ai][1][m][n][j + 1]}, c1, k); o[4 * n + j] = r2.x; o[4 * n + j + 1] = r2.y; }
                if (MOE_FP8) *(u32x2*)((unsigned char*)ACT2 + (size_t)(u.pm * 256 + rl) * DFF + col0) = pk8_fp8(o, 1.0f);
                else { u32x4 w; w.x = cvt_pk_bf16(o[0], o[1]); w.y = cvt_pk_bf16(o[2], o[3]); w.z = cvt_pk_bf16(o[4], o[5]); w.w = cvt_pk_bf16(o[6], o[7]);
                    *(u32x4*)(ACT2 + (size_t)(u.pm * 256 + rl) * DFF + col0) = w; } }
    }
};
struct EpiMoeDown {
    static constexpr bool PRELOAD = false;
    const int* list; const LAS int* tbl; u16* MO;
    __device__ __forceinline__ void operator()(ACC_T, const Unit& u, const EpiCtx& c) const {
        const int col0 = u.pn * 256 + c.wc * 32 + 8 * c.fq, n_e = tbl[u.e], pos0 = (u.pm - tbl[8 + u.e]) * 256;
        int tkv[8];
#pragma unroll
        for (int i = 0; i < 8; ++i) { const int pos = pos0 + (i >> 2) * 128 + c.wr * 64 + (i & 3) * 16 + c.fr; const int v = list[((size_t)u.e * M + (pos < n_e ? pos : 0)) * 4]; tkv[i] = pos < n_e ? v : -1; }
#pragma unroll
        for (int ai = 0; ai < 2; ++ai)
#pragma unroll
            for (int m = 0; m < 4; ++m) {
                if (tkv[ai * 4 + m] >= 0) { const int tk = tkv[ai * 4 + m]; u16* dst = MO + ((size_t)(tk & 1) * M + (tk >> 1)) * D + col0;
#pragma unroll
                    for (int bj = 0; bj < 2; ++bj) { const float us = MOE_FP8 ? 1.0f / (S8_ACT * S8_WD) : 1.0f; const f32x4 v0 = acc[ai][bj][m][0] * us, v1 = acc[ai][bj][m][1] * us;
                        u32x4 w; w.x = cvt_pk_bf16(v0[0], v0[1]); w.y = cvt_pk_bf16(v0[2], v0[3]); w.z = cvt_pk_bf16(v1[0], v1[1]); w.w = cvt_pk_bf16(v1[2], v1[3]);
                        *(u32x4*)(dst + bj * 128) = w; } } }
    }
};

template <class Epi, class Sched, bool GATHER, bool FP8 = false>
__device__ __forceinline__ void gemm_phase(LAS unsigned char* lds, const int K, const Sched& S, const Epi& E, const int wid  , volatile LAS unsigned* pacc = nullptr  , const int pmode = 0) {
    const int lane = lane_now(), tid = wid * 64 + lane, wr = wid >> 2, wc = wid & 3, fr = lane & 15, fq = lane >> 4;
    const int nt = K / BK;
    unsigned long long pl_ = 0ull;
    EpiCtx ctx; ctx.wr = wr; ctx.wc = wc; ctx.fr = fr; ctx.fq = fq; ctx.tid = tid; ctx.lds = lds;
    unsigned voffA[2], voffB[2]; int RA[2]; unsigned CA[2];
#pragma unroll
    for (int i = 0; i < 2; ++i) { int R, C; stage_rc(tid * 16 + i * 8192, R, C); const int Rb = (R & ~31) + perm32(R & 31);
        voffA[i] = (unsigned)(R * K + C) * 2u; voffB[i] = (unsigned)(Rb * K + C) * 2u; RA[i] = R; CA[i] = (unsigned)C * 2u; }
    const size_t kstep = (size_t)(BK * 2);
    const size_t hstep = (size_t)HALF * K * 2;
    const unsigned ldsw = (unsigned)wid * 1024u;
    const int aoff = lds_byte(wr * 64 + fr, fq * 8), boff = lds_byte(wc * 32 + fr, fq * 8);
#define PG8_SA(b, h) (((b) * 2 + (h)) * HTB)
#define PG8_SB(b, h) ((4 + (b) * 2 + (h)) * HTB)
#define PG8_GLDS(src, dstoff) __builtin_amdgcn_global_load_lds((const unsigned*)(src), (LAS unsigned*)(lds + (dstoff)), 16, 0, 0)
#define PG8_STAGE_B(bufoff, gbase) do { _Pragma("unroll") for (int _i = 0; _i < 2; ++_i) PG8_GLDS((const char*)(gbase) + voffB[_i], (bufoff) + ldsw + _i * 8192); } while (0)
#define PG8_STAGE_A(bufoff, gk, h, VA) do { _Pragma("unroll") for (int _i = 0; _i < 2; ++_i) { \
        if constexpr (GATHER) PG8_GLDS((const char*)(gk) + VA[h][_i], (bufoff) + ldsw + _i * 8192); else PG8_GLDS((const char*)(gk) + (size_t)(h) * hstep + voffA[_i], (bufoff) + ldsw + _i * 8192); } } while (0)
#define PG8_LDA(dst, b, h) do { _Pragma("unroll") for (int m = 0; m < 4; ++m) _Pragma("unroll") for (int k = 0; k < 2; ++k) dst[m][k] = *(const LAS bf16x8*)(lds + PG8_SA(b, h) + aoff + m * 2048 + k * 1024); } while (0)
#define PG8_LDB(dst, b, h) do { _Pragma("unroll") for (int n = 0; n < 2; ++n) _Pragma("unroll") for (int k = 0; k < 2; ++k) dst[n][k] = *(const LAS bf16x8*)(lds + PG8_SB(b, h) + boff + n * 2048 + k * 1024); } while (0)
#define PG8_MMA(ai, bj, At, Bt) do { __builtin_amdgcn_s_setprio(1); _Pragma("unroll") for (int m = 0; m < 4; ++m) _Pragma("unroll") for (int n = 0; n < 2; ++n) { \
        if constexpr (FP8) asm volatile("v_mfma_scale_f32_16x16x128_f8f6f4 %0, %1, %2, %0, %3, %3 op_sel_hi:[0,0,0]" : "+v"(acc[ai][bj][m][n]) : "v"(cat8(Bt[n][0], Bt[n][1])), "v"(cat8(At[m][0], At[m][1])), "v"(one_scale)); \
        else { _Pragma("unroll") for (int k = 0; k < 2; ++k) acc[ai][bj][m][n] = __builtin_amdgcn_mfma_f32_16x16x32_bf16(Bt[n][k], At[m][k], acc[ai][bj][m][n], 0, 0, 0); } } \
        __builtin_amdgcn_s_setprio(0); } while (0)
#define PG8_WAIT_V(n) asm volatile("s_waitcnt vmcnt(" #n ")" ::: "memory")
#define PG8_WAIT_L(n) asm volatile("s_waitcnt lgkmcnt(" #n ")" ::: "memory")
#define PG8_BAR __builtin_amdgcn_s_barrier()
#define PG8_SCHED __builtin_amdgcn_sched_barrier(0)
    const int one_scale = 0x7f7f7f7f;
    Unit cur, nxt; int ui = 0; cur.kb = 0; cur.ke = 0; nxt.kb = 0; nxt.ke = 0;
    bool flagdue = false;
    if (!S.next(0, cur)) return;
    f32x4 acc[2][2][4][2];
#pragma unroll
    for (int a = 0; a < 2; ++a)
#pragma unroll
        for (int b = 0; b < 2; ++b)
#pragma unroll
            for (int m = 0; m < 4; ++m)
#pragma unroll
                for (int n = 0; n < 2; ++n) acc[a][b][m][n] = (f32x4){0.f, 0.f, 0.f, 0.f};
    bf16x8 At[4][2], B0[2][2], B1[2][2];
    const char* cA = S.a_base(cur); const char* cB = S.b_base(cur);
    unsigned vaC[2][2], vaN[2][2];
#pragma unroll
    for (int h = 0; h < 2; ++h)
#pragma unroll
        for (int i = 0; i < 2; ++i) { vaC[h][i] = GATHER ? S.a_cvt(S.a_raw(cur, h * HALF + RA[i])) + CA[i] : 0u; vaN[h][i] = vaC[h][i]; }
    int rawN[2][2];
    if constexpr (GATHER) { Unit u1; const bool h1 = S.next(1, u1);
#pragma unroll
        for (int h = 0; h < 2; ++h)
#pragma unroll
            for (int i = 0; i < 2; ++i) rawN[h][i] = h1 ? S.a_raw(u1, h * HALF + RA[i]) : 0; }
    if constexpr (Epi::PRELOAD) { u32x4 praw[16]; E.pre_issue(praw, cur, ctx);
        PG8_STAGE_B(PG8_SB(0, 0), cB); PG8_STAGE_B(PG8_SB(0, 1), cB + hstep); PG8_STAGE_A(PG8_SA(0, 0), cA, 0, vaC); PG8_STAGE_A(PG8_SA(0, 1), cA, 1, vaC);
        E.pre_unpack(acc, praw); }
    else { PG8_STAGE_B(PG8_SB(0, 0), cB); PG8_STAGE_B(PG8_SB(0, 1), cB + hstep); PG8_STAGE_A(PG8_SA(0, 0), cA, 0, vaC); PG8_STAGE_A(PG8_SA(0, 1), cA, 1, vaC); }
    if (wr == 1) PG8_BAR;
    PG8_WAIT_V(2); PG8_BAR;
    PG8_STAGE_B(PG8_SB(1, 0), cB + kstep); PG8_STAGE_A(PG8_SA(1, 0), cA + kstep, 0, vaC); PG8_STAGE_B(PG8_SB(1, 1), cB + hstep + kstep);
    PG8_WAIT_V(6); PG8_BAR;
    for (;;) {
        const bool has_next = S.next(ui + 1, nxt);
        const char* nA = has_next ? S.a_base(nxt) : cA; const char* nB = has_next ? S.b_base(nxt) : cB;
        int ntu = nt; if constexpr (Sched::SK) ntu = 2 * (cur.ke - cur.kb);
#pragma unroll 1
        for (int t = 0; t < ntu; t += 2) {
            const bool last = (t == ntu - 2);
            const char* a1 = cA + (size_t)(t + 1) * kstep;
            const char* a2 = last ? nA : cA + (size_t)(t + 2) * kstep; const char* b2 = last ? nB : cB + (size_t)(t + 2) * kstep;
            const char* a3 = a2 + kstep; const char* b3 = b2 + kstep;
            unsigned v2[2][2];
#pragma unroll
            for (int h = 0; h < 2; ++h)
#pragma unroll
                for (int i = 0; i < 2; ++i) v2[h][i] = (GATHER && last) ? S.a_cvt(rawN[h][i]) + CA[i] : vaC[h][i];
            PG8_LDB(B0, 0, 0); PG8_LDB(B1, 0, 1); PG8_SCHED; PG8_LDA(At, 0, 0); PG8_STAGE_A(PG8_SA(1, 1), a1, 1, vaC);
            PG8_WAIT_V(8); PG8_WAIT_L(0); PG8_BAR; PG8_MMA(0, 0, At, B0); PG8_MMA(0, 1, At, B1); PG8_BAR; PG8_SCHED;
            PG8_LDA(At, 0, 1); PG8_STAGE_B(PG8_SB(0, 0), b2); PG8_STAGE_B(PG8_SB(0, 1), b2 + hstep); PG8_STAGE_A(PG8_SA(0, 0), a2, 0, v2);
            PG8_WAIT_V(8); PG8_WAIT_L(0); PG8_BAR; PG8_MMA(1, 0, At, B0); PG8_MMA(1, 1, At, B1); PG8_BAR; PG8_SCHED;
            PG8_LDB(B0, 1, 0); PG8_LDB(B1, 1, 1); PG8_SCHED; PG8_LDA(At, 1, 0); PG8_STAGE_A(PG8_SA(0, 1), a2, 1, v2);
            PG8_WAIT_V(8); PG8_WAIT_L(0); PG8_BAR; PG8_MMA(0, 0, At, B0); PG8_MMA(0, 1, At, B1); PG8_BAR; PG8_SCHED;
            PG8_LDA(At, 1, 1); PG8_STAGE_B(PG8_SB(1, 0), b3); PG8_STAGE_B(PG8_SB(1, 1), b3 + hstep); PG8_STAGE_A(PG8_SA(1, 0), a3, 0, v2);
            PG8_WAIT_V(8); PG8_WAIT_L(0); PG8_BAR; PG8_MMA(1, 0, At, B0); PG8_MMA(1, 1, At, B1); PG8_BAR; PG8_SCHED;
        }
        unsigned long long pt0 = 0ull; if (pacc && pmode == 0) pt0 = __builtin_amdgcn_s_memrealtime();
        if (wr == 0) PG8_BAR;
        if (pacc && pmode == 1) pt0 = __builtin_amdgcn_s_memrealtime();
        if constexpr (GATHER) {
#pragma unroll
            for (int h = 0; h < 2; ++h)
#pragma unroll
                for (int i = 0; i < 2; ++i) vaN[h][i] = S.a_cvt(rawN[h][i]) + CA[i]; }
        if constexpr (GATHER) { Unit u2; const bool h2 = S.next(ui + 2, u2);
#pragma unroll
            for (int h = 0; h < 2; ++h)
#pragma unroll
                for (int i = 0; i < 2; ++i) rawN[h][i] = h2 ? S.a_raw(u2, h * HALF + RA[i]) : 0; }
        bool dumped = false;
        if constexpr (Sched::SK) {
            if (flagdue && tid == 0) __hip_atomic_store(S.flags + S.slot, 1u, __ATOMIC_RELAXED, __HIP_MEMORY_SCOPE_AGENT);
            flagdue = false;
            if (cur.kb > 0) { dumped = true; flagdue = true;
                const __amdgpu_buffer_rsrc_t pr = __builtin_amdgcn_make_buffer_rsrc((char*)S.part + (size_t)S.slot * 131072, 0, 131072, 0x00020000); const int poff = wid * 16384 + lane * 16;
#pragma unroll
                for (int a = 0; a < 2; ++a)
#pragma unroll
                    for (int b = 0; b < 2; ++b)
#pragma unroll
                        for (int m = 0; m < 4; ++m) { const int q = (a * 2 + b) * 4 + m; const f32x4 v0 = acc[a][b][m][0], v1 = acc[a][b][m][1];
                            u32x4 w; w.x = cvt_pk_bf16(v0[0], v0[1]); w.y = cvt_pk_bf16(v0[2], v0[3]); w.z = cvt_pk_bf16(v1[0], v1[1]); w.w = cvt_pk_bf16(v1[2], v1[3]);
                            __builtin_amdgcn_raw_buffer_store_b128(w, pr, poff + (q & 3) * 1024, (q >> 2) * 4096, 16); } } }
        if (!dumped) E(acc, cur, ctx);
        if (pacc && pmode == 1) pl_ += __builtin_amdgcn_s_memrealtime() - pt0;
        if (!has_next) { if (pacc && pmode == 0) pl_ += __builtin_amdgcn_s_memrealtime() - pt0; break; }
        bool preload = false;
        if constexpr (Sched::SK) { if (nxt.ke < S.IT) { preload = true;
                unsigned* fl = S.flags + (S.slot + 1);
                while (__hip_atomic_load(fl, __ATOMIC_RELAXED, __HIP_MEMORY_SCOPE_AGENT) == 0u) __builtin_amdgcn_s_sleep(1);
                const __amdgpu_buffer_rsrc_t pr = __builtin_amdgcn_make_buffer_rsrc((char*)S.part + (size_t)(S.slot + 1) * 131072, 0, 131072, 0x00020000); const int poff = wid * 16384 + lane * 16;
                u32x4 raw[16];
#pragma unroll
                for (int q = 0; q < 16; ++q) raw[q] = __builtin_amdgcn_raw_buffer_load_b128(pr, poff + (q & 3) * 1024, (q >> 2) * 4096, 16);
#pragma unroll
                for (int a = 0; a < 2; ++a)
#pragma unroll
                    for (int b = 0; b < 2; ++b)
#pragma unroll
                        for (int m = 0; m < 4; ++m) { const u32x4 r = raw[(a * 2 + b) * 4 + m];
                            acc[a][b][m][0] = (f32x4){bf2f(r.x & 0xffffu), bf2f(r.x >> 16), bf2f(r.y & 0xffffu), bf2f(r.y >> 16)}; acc[a][b][m][1] = (f32x4){bf2f(r.z & 0xffffu), bf2f(r.z >> 16), bf2f(r.w & 0xffffu), bf2f(r.w >> 16)}; } } }
        if constexpr (Epi::PRELOAD) { u32x4 praw[16]; E.pre_issue(praw, nxt, ctx); E.pre_unpack(acc, praw); preload = true; }
        if (!preload) {
#pragma unroll
        for (int a = 0; a < 2; ++a)
#pragma unroll
            for (int b = 0; b < 2; ++b)
#pragma unroll
                for (int m = 0; m < 4; ++m)
#pragma unroll
                    for (int n = 0; n < 2; ++n) acc[a][b][m][n] = (f32x4){0.f, 0.f, 0.f, 0.f}; }
        cur = nxt; cA = nA; cB = nB; ++ui;
#pragma unroll
        for (int h = 0; h < 2; ++h)
#pragma unroll
            for (int i = 0; i < 2; ++i) vaC[h][i] = vaN[h][i];
        if (wr == 1) PG8_BAR;
        if (pacc && pmode == 0) pl_ += __builtin_amdgcn_s_memrealtime() - pt0;
    }
    PG8_WAIT_V(0);
    PG8_BAR;
    if constexpr (Sched::SK) { if (flagdue && tid == 0) __hip_atomic_store(S.flags + S.slot, 1u, __ATOMIC_RELAXED, __HIP_MEMORY_SCOPE_AGENT); }
    if (pacc && tid == 0) { pacc[0] = (unsigned)pl_; pacc[1] = (unsigned)(pl_ >> 32); }
#undef PG8_SA
#undef PG8_SB
#undef PG8_GLDS
#undef PG8_STAGE_A
#undef PG8_STAGE_B
#undef PG8_LDA
#undef PG8_LDB
#undef PG8_MMA
#undef PG8_WAIT_V
#undef PG8_WAIT_L
#undef PG8_BAR
#undef PG8_SCHED
}
}

#define XB_TMO      128
#define XB_XCNT(j)  (256  + 64 * (j))
#define XB_XSUB(j)  (1280 + 64 * (j))
#define XB_XGEN(j)  (2304 + 64 * (j))
#define XB_TOP      3328
#define XB_TOPGEN   3392
#define XB_ARR      3456
#define XCD_BAR_WORDS 3520
#define XB_SPIN_CAP (1u << 18)
__device__ __forceinline__ unsigned xb_ld(unsigned* p)              { return __hip_atomic_load(p, __ATOMIC_RELAXED, __HIP_MEMORY_SCOPE_AGENT); }
__device__ __forceinline__ unsigned xb_add(unsigned* p, unsigned v) { return __hip_atomic_fetch_add(p, v, __ATOMIC_RELAXED, __HIP_MEMORY_SCOPE_AGENT); }
__device__ __forceinline__ unsigned xb_xcc_id() { return (unsigned)__builtin_amdgcn_s_getreg((3 << 11) | 20) & 0xFu; }
#define XB_SPIN(cond, bar) do { unsigned _sp = 0; while (cond) { __builtin_amdgcn_s_sleep(1); \
    if ((++_sp & 255u) == 0u) { if (xb_ld(&(bar)[XB_TMO])) break; if (_sp > XB_SPIN_CAP) { atomicAdd(&(bar)[XB_TMO], 1u); break; } } } } while (0)
struct XcdBarrier { unsigned* bar; unsigned x; volatile LAS unsigned* st; };
__device__ __forceinline__ XcdBarrier xcd_barrier_post(unsigned* bar, volatile LAS unsigned* st, bool t0  ) {
    XcdBarrier b; b.bar = bar; b.x = xb_xcc_id(); b.st = st;
    if (t0) (void)xb_add(&bar[XB_XCNT(b.x)], 1u);
    return b;
}
__device__ __forceinline__ void xcd_barrier_complete(unsigned* bar, unsigned x, unsigned& nloc, unsigned& nx) {
    const unsigned G = gridDim.x * gridDim.y * gridDim.z;
    unsigned sum, cnt, mine, sp = 0u;
    for (;;) {
        sum = 0u; cnt = 0u; mine = 0u;
#pragma unroll
        for (unsigned j = 0; j < 16; ++j) { const unsigned c = xb_ld(&bar[XB_XCNT(j)]); sum += c; cnt += (c > 0u) ? 1u : 0u; mine = (j == x) ? c : mine; }
        if (sum == G) break;
        __builtin_amdgcn_s_sleep(1);
        if ((++sp & 255u) == 0u) { if (xb_ld(&bar[XB_TMO])) break; if (sp > XB_SPIN_CAP) { atomicAdd(&bar[XB_TMO], 1u); break; } }
    }
    nloc = mine > 0u ? mine : 1u; nx = cnt > 0u ? cnt : 1u;
}
__device__ __forceinline__ void xcd_barrier(const XcdBarrier& b) {
    asm volatile("s_waitcnt vmcnt(0)" ::: "memory");
    __syncthreads();
    if (threadIdx.x == 0) {
        unsigned* bar = b.bar;
        __builtin_amdgcn_s_waitcnt(0);
        unsigned nloc = b.st[0], nx = b.st[1];
        if (nloc == 0u) { xcd_barrier_complete(bar, b.x, nloc, nx); b.st[0] = nloc; b.st[1] = nx; }
        const unsigned old = xb_add(&bar[XB_XSUB(b.x)], 1u);
        const unsigned gen = old / nloc;
        if (old + 1u == (gen + 1u) * nloc) {
            __builtin_amdgcn_fence(__ATOMIC_RELEASE, "agent");
            asm volatile("s_waitcnt vmcnt(0)" ::: "memory");
            const unsigned og = xb_add(&bar[XB_TOP], 1u);
            const unsigned tg = og / nx;
            if (og + 1u == (tg + 1u) * nx) xb_add(&bar[XB_TOPGEN], 1u);
            else XB_SPIN(xb_ld(&bar[XB_TOPGEN]) == tg, bar);
            __builtin_amdgcn_fence(__ATOMIC_ACQUIRE, "agent");
            xb_add(&bar[XB_XGEN(b.x)], 1u);
            asm volatile("s_waitcnt vmcnt(0)" ::: "memory");
        } else {
            XB_SPIN(xb_ld(&bar[XB_XGEN(b.x)]) == gen, bar);
            __builtin_amdgcn_fence(__ATOMIC_ACQUIRE, "agent");
            asm volatile("s_waitcnt vmcnt(0)" ::: "memory");
        }
    }
    __syncthreads();
}
constexpr int CW_SKF = 16384;
constexpr int CW_BAR = 4096;
template <int DRAIN>
__device__ __forceinline__ void seam_sync(const XcdBarrier& b, volatile LAS unsigned* flag, unsigned seam_id, const Args& a, DeferState& st, int gw, int NGW, int wave) {
    const int lane = lane_now(); const bool t0 = (wave == 0) && (lane == 0);
    if (DRAIN > 0) { while (defer_step(a, st, gw, NGW, lane, DRAIN)) {} }
    asm volatile("s_waitcnt vmcnt(0)" ::: "memory");
    __syncthreads();
    unsigned* bar = b.bar;
    if (t0) {
        __builtin_amdgcn_s_waitcnt(0);
        unsigned nloc = b.st[0], nx = b.st[1];
        if (nloc == 0u) { xcd_barrier_complete(bar, b.x, nloc, nx); unsigned mk = 0u;
#pragma unroll
            for (unsigned j = 0; j < 16; ++j) mk |= (xb_ld(&bar[XB_XCNT(j)]) > 0u ? 1u : 0u) << j;
            b.st[0] = nloc; b.st[1] = nx; b.st[2] = mk; }
        const unsigned old = xb_add(&bar[XB_XSUB(b.x)], 1u);
        const unsigned gen = old / nloc;
        if (old + 1u == (gen + 1u) * nloc) {
            __builtin_amdgcn_fence(__ATOMIC_RELEASE, "agent");
            asm volatile("s_waitcnt vmcnt(0)" ::: "memory");
            __hip_atomic_store(&bar[XB_ARR + b.x], seam_id, __ATOMIC_RELAXED, __HIP_MEMORY_SCOPE_AGENT);
        }
    }
    unsigned spins = 0u;
    for (;;) {
        if (wave == 0) {
            const unsigned mk = b.st[2];
            unsigned v = seam_id; if (lane < 16) v = xb_ld(&bar[XB_ARR + lane]);
            const bool ok = lane >= 16 || ((mk >> lane) & 1u) == 0u || v >= seam_id;
            bool rel = __ballot(ok) == ~0ull;
            if (t0) {
                if (!rel && ((++spins & 63u) == 0u)) { if (xb_ld(&bar[XB_TMO])) rel = true; else if (spins > (1u << 17)) { atomicAdd(&bar[XB_TMO], 1u); rel = true; } }
                if (rel) { __builtin_amdgcn_fence(__ATOMIC_ACQUIRE, "agent"); asm volatile("s_waitcnt vmcnt(0)" ::: "memory"); *flag = seam_id; }
            }
        }
        __syncthreads();
        if (*flag == seam_id) break;
        if (!defer_step(a, st, gw, NGW, lane, N_DEFER)) __builtin_amdgcn_s_sleep(2);
    }
}

constexpr int XS_STRIDE = 272;
constexpr int LR_XS = 0, LR_XC = 35840, LR_HS = LR_XC + 34816, LR_CP = LR_HS + 34816, LR_HIN = LR_CP + 2560;
static_assert(LR_HIN + 512 <= RING_BYTES, "lru lds");
constexpr size_t WS_LAB = WS_ACT;
__device__ __forceinline__ void lru_segments(float Aseg, float Bseg, int fq, float& H, float& Ptot, float& my) {
    const float A1 = __shfl_xor(Aseg, 16), B1 = __shfl_xor(Bseg, 16);
    const bool odd = (fq & 1) != 0, hi2 = fq >= 2;
    const float Ap = Aseg * A1, Bp = odd ? __builtin_fmaf(Aseg, B1, Bseg) : __builtin_fmaf(A1, Bseg, B1);
    const float A2 = __shfl_xor(Ap, 32), B2 = __shfl_xor(Bp, 32);
    const float hpair = hi2 ? __builtin_fmaf(A2, H, B2) : H;
    my = odd ? __builtin_fmaf(A1, hpair, B1) : hpair;
    const float Alo = hi2 ? A2 : Ap, Blo = hi2 ? B2 : Bp, Ahi = hi2 ? Ap : A2, Bhi = hi2 ? Bp : B2;
    H = __builtin_fmaf(Ahi, __builtin_fmaf(Alo, H, Blo), Bhi); Ptot *= Alo * Ahi;
}
template <bool FINAL>
__device__ __forceinline__ void lru_phase(const Args& a, LAS unsigned char* lds, int G, int vcu, const int w  ) {
    const int lane = lane_now(), tid = w * 64 + lane, fr = lane & 15, fq = lane >> 4;
    const u16* XB = (const u16*)(a.ws + WS_XB); const u16* Y = (const u16*)(a.ws + WS_Y); u16* Gout = (u16*)(a.ws + WS_G);
    const u16* WAX = (const u16*)(a.ws + WS_WAX); float* CAR = (float*)(a.ws + WS_CAR); const float* spl = (const float*)(a.ws + WS_SPL);
    const float* cw = a.in[6]; const float* cb = a.in[7]; const float* b_a = a.in[9]; const float* b_x = a.in[11];
    LAS float* CP = (LAS float*)(lds + LR_CP); LAS float* HIN = (LAS float*)(lds + LR_HIN);
    for (int unit = vcu; unit < 256; unit += G) {
        const int n = unit & 7, chunk = unit >> 3, t0 = chunk * 512, ch0 = 128 * n;
        unsigned char* labu = a.ws + WS_LAB + (((size_t)unit * 4 * 8 + w) * 8) * 1024 + lane * 16;
        float H = 0.f, Ptot = 1.f;
        if constexpr (FINAL) {
            u32x4 pre[8];
#pragma unroll
            for (int p8 = 0; p8 < 8; ++p8) pre[p8] = *(const u32x4*)(labu + p8 * 1024);
            {
                const int hh = lane >> 5, jj = lane & 31;
#pragma unroll
                for (int it = 0; it < 8; ++it) { const int cl = 16 * w + 2 * it + hh; float A = 1.f, h = 0.f;
                    if (jj < chunk) { const f32x2v_t v = *(const f32x2v_t*)(CAR + (((size_t)n * 32 + jj) * 128 + cl) * 2); A = v.x; h = v.y; }
#pragma unroll
                    for (int d = 1; d < 32; d <<= 1) { const float Ap = __shfl_up(A, d, 32), hp = __shfl_up(h, d, 32); if (jj >= d) { h = A * hp + h; A = A * Ap; } }
                    if (jj == 31) HIN[cl] = h; }
            }
            __syncthreads();
            H = HIN[16 * w + fr];
            for (int s = 0; s < 4; ++s) {
                const int ts = t0 + 128 * s;
                u32x4 cur[8];
#pragma unroll
                for (int p8 = 0; p8 < 8; ++p8) cur[p8] = pre[p8];
                if (s < 3) {
#pragma unroll
                    for (int p8 = 0; p8 < 8; ++p8) pre[p8] = *(const u32x4*)(labu + (size_t)(s + 1) * 65536 + p8 * 1024); }
                u32x4 ypre[4];
#pragma unroll
                for (int i = 0; i < 4; ++i) { const int p = tid + 512 * i, row = p >> 4, pc = p & 15; ypre[i] = *(const u32x4*)(Y + (size_t)(ts + row) * D + ch0 + 8 * pc); }
#pragma unroll
                for (int m = 0; m < 8; ++m) {
                    const u32x2 lw = (m & 1) ? (u32x2){cur[m >> 1].z, cur[m >> 1].w} : (u32x2){cur[m >> 1].x, cur[m >> 1].y};
                    const u32x2 bw = (m & 1) ? (u32x2){cur[4 + (m >> 1)].z, cur[4 + (m >> 1)].w} : (u32x2){cur[4 + (m >> 1)].x, cur[4 + (m >> 1)].y};
                    const float la[4] = {bf2f(lw.x & 0xffffu), bf2f(lw.x >> 16), bf2f(lw.y & 0xffffu), bf2f(lw.y >> 16)}, bb[4] = {bf2f(bw.x & 0xffffu), bf2f(bw.x >> 16), bf2f(bw.y & 0xffffu), bf2f(bw.y >> 16)};
                    float av[4], hv[4]; float Aseg = 1.f, Bseg = 0.f;
#pragma unroll
                    for (int j = 0; j < 4; ++j) { const float a_ = fexp2(la[j]); Bseg = __builtin_fmaf(a_, Bseg, bb[j]); Aseg *= a_; av[j] = Aseg; hv[j] = Bseg; }
                    float my; lru_segments(Aseg, Bseg, fq, H, Ptot, my);
#pragma unroll
                    for (int j = 0; j < 4; ++j) { const int tl = 16 * m + 4 * fq + j; *(LAS u16*)(lds + LR_HS + tl * XS_STRIDE + (16 * w + fr) * 2) = (u16)f2bf(__builtin_fmaf(av[j], my, hv[j])); }
                }
                __syncthreads();
#pragma unroll
                for (int i = 0; i < 4; ++i) { const int p = tid + 512 * i, row = p >> 4, pc = p & 15; const size_t go = (size_t)(ts + row) * D + ch0 + 8 * pc;
                    const u32x4 hv = *(const LAS u32x4*)(lds + LR_HS + row * XS_STRIDE + pc * 16); const u32x4 yv = ypre[i]; u32x4 ov;
                    ov.x = cvt_pk_bf16(bf2f(hv.x & 0xffffu) * bf2f(yv.x & 0xffffu), bf2f(hv.x >> 16) * bf2f(yv.x >> 16)); ov.y = cvt_pk_bf16(bf2f(hv.y & 0xffffu) * bf2f(yv.y & 0xffffu), bf2f(hv.y >> 16) * bf2f(yv.y >> 16));
                    ov.z = cvt_pk_bf16(bf2f(hv.z & 0xffffu) * bf2f(yv.z & 0xffffu), bf2f(hv.z >> 16) * bf2f(yv.z >> 16)); ov.w = cvt_pk_bf16(bf2f(hv.w & 0xffffu) * bf2f(yv.w & 0xffffu), bf2f(hv.w >> 16) * bf2f(yv.w >> 16));
                    *(u32x4*)(Gout + go) = ov; }
                __syncthreads();
            }
        } else {
            u32x4 xpre[5];
#define LRU_XLOAD(ts_) do { _Pragma("unroll") for (int i = 0; i < 5; ++i) { const int p = tid + 512 * i, row = p >> 4, pc = p & 15, t = (ts_) - 3 + row; xpre[i] = (u32x4){0u, 0u, 0u, 0u}; \
            if (p < 131 * 16 && t >= 0) xpre[i] = *(const u32x4*)(XB + (size_t)t * D + ch0 + 8 * pc); } } while (0)
            LRU_XLOAD(t0);
            bf16x8 bfr[4], bfi[4];
            { const u16* wb = WAX + ((size_t)n * 256 + 16 * w + fr) * 128 + 8 * fq;
#pragma unroll
              for (int s = 0; s < 4; ++s) { bfr[s] = *(const bf16x8*)(wb + 32 * s); bfi[s] = *(const bf16x8*)(wb + 128 * 128 + 32 * s); } }
            const int ch = ch0 + 16 * w + fr; const float nba = -LOG2E * b_a[ch], nbx = -LOG2E * b_x[ch], c1 = -8.0f * LOG2E * spl[ch];
            { const int k = tid >> 7, c = tid & 127; CP[tid] = cw[k * D + ch0 + c]; if (tid < 128) CP[512 + tid] = cb[ch0 + tid]; }
            __syncthreads();
            for (int s = 0; s < 4; ++s) {
                const int ts = t0 + 128 * s;
#pragma unroll
                for (int i = 0; i < 5; ++i) { const int p = tid + 512 * i, row = p >> 4, pc = p & 15; if (p < 131 * 16) *(LAS u32x4*)(lds + LR_XS + row * XS_STRIDE + pc * 16) = xpre[i]; }
                __syncthreads();
                if (s < 3) LRU_XLOAD(ts + 128);
                { const int cg = tid & 15, tg = tid >> 4; float o[4][8], wk[4][8];
#pragma unroll
                  for (int k = 0; k < 4; ++k) { const f32x4 w0 = *(const LAS f32x4*)(CP + k * 128 + 8 * cg), w1 = *(const LAS f32x4*)(CP + k * 128 + 8 * cg + 4);
#pragma unroll
                      for (int i = 0; i < 4; ++i) { wk[k][i] = w0[i]; wk[k][4 + i] = w1[i]; } }
                  { const f32x4 b0 = *(const LAS f32x4*)(CP + 512 + 8 * cg), b1 = *(const LAS f32x4*)(CP + 512 + 8 * cg + 4);
#pragma unroll
                    for (int jt = 0; jt < 4; ++jt)
#pragma unroll
                        for (int i = 0; i < 4; ++i) { o[jt][i] = b0[i]; o[jt][4 + i] = b1[i]; } }
#pragma unroll
                  for (int rr = 0; rr < 7; ++rr) { const u32x4 xv = *(const LAS u32x4*)(lds + LR_XS + (4 * tg + rr) * XS_STRIDE + cg * 16); float xf[8];
                      xf[0] = bf2f(xv.x & 0xffffu); xf[1] = bf2f(xv.x >> 16); xf[2] = bf2f(xv.y & 0xffffu); xf[3] = bf2f(xv.y >> 16); xf[4] = bf2f(xv.z & 0xffffu); xf[5] = bf2f(xv.z >> 16); xf[6] = bf2f(xv.w & 0xffffu); xf[7] = bf2f(xv.w >> 16);
#pragma unroll
                      for (int jt = 0; jt < 4; ++jt) { const int k = rr - jt; if (k >= 0 && k <= 3) {
#pragma unroll
                          for (int i = 0; i < 8; ++i) o[jt][i] += xf[i] * wk[k][i]; } } }
#pragma unroll
                  for (int jt = 0; jt < 4; ++jt) { u32x4 wv; wv.x = cvt_pk_bf16(o[jt][0], o[jt][1]); wv.y = cvt_pk_bf16(o[jt][2], o[jt][3]); wv.z = cvt_pk_bf16(o[jt][4], o[jt][5]); wv.w = cvt_pk_bf16(o[jt][6], o[jt][7]);
                      *(LAS u32x4*)(lds + LR_XC + (4 * tg + jt) * XS_STRIDE + cg * 16) = wv; } }
                __syncthreads();
                f32x4 ar[8], ag[8];
#pragma unroll
                for (int m = 0; m < 8; ++m) { ar[m] = (f32x4){0.f, 0.f, 0.f, 0.f}; ag[m] = (f32x4){0.f, 0.f, 0.f, 0.f}; }
#pragma unroll
                for (int m = 0; m < 8; ++m)
#pragma unroll
                    for (int s2 = 0; s2 < 4; ++s2) { const bf16x8 af = *(const LAS bf16x8*)(lds + LR_XC + (16 * m + fr) * XS_STRIDE + (32 * s2 + 8 * fq) * 2);
                        ar[m] = __builtin_amdgcn_mfma_f32_16x16x32_bf16(af, bfr[s2], ar[m], 0, 0, 0); ag[m] = __builtin_amdgcn_mfma_f32_16x16x32_bf16(af, bfi[s2], ag[m], 0, 0, 0); }
                u32x4 keep[8];
#pragma unroll
                for (int m = 0; m < 8; ++m) {
                    float Aseg = 1.f, Bseg = 0.f; unsigned lw[2], bw[2];
#pragma unroll
                    for (int jp = 0; jp < 2; ++jp) {
                        const int tl = 16 * m + 4 * fq + 2 * jp;
                        const f32x2p er = (f32x2p){ar[m][2 * jp], ar[m][2 * jp + 1]} * (-LOG2E) + nba, ei = (f32x2p){ag[m][2 * jp], ag[m][2 * jp + 1]} * (-LOG2E) + nbx;
                        f32x2p dr, di; dr.x = fexp2(er.x); dr.y = fexp2(er.y); di.x = fexp2(ei.x); di.y = fexp2(ei.y); dr = dr + 1.0f; di = di + 1.0f;
                        f32x2p rg, ig; rg.x = frcp(dr.x); rg.y = frcp(dr.y); ig.x = frcp(di.x); ig.y = frcp(di.y);
                        const f32x2p l2 = rg * c1;
                        lw[jp] = cvt_pk_bf16(l2.x, l2.y);
                        const f32x2p lr = (f32x2p){bf2f(lw[jp] & 0xffffu), bf2f(lw[jp] >> 16)}; f32x2p a2; a2.x = fexp2(lr.x); a2.y = fexp2(lr.y);
                        const f32x2p xc = (f32x2p){bf2f(*(const LAS u16*)(lds + LR_XC + tl * XS_STRIDE + (16 * w + fr) * 2)), bf2f(*(const LAS u16*)(lds + LR_XC + (tl + 1) * XS_STRIDE + (16 * w + fr) * 2))};
                        const f32x2p om = a2 * (-a2) + 1.0f; f32x2p sq; sq.x = __builtin_amdgcn_sqrtf(om.x); sq.y = __builtin_amdgcn_sqrtf(om.y);
                        const f32x2p b2 = sq * (ig * xc);
                        bw[jp] = cvt_pk_bf16(b2.x, b2.y);
                        const float bb0 = bf2f(bw[jp] & 0xffffu), bb1 = bf2f(bw[jp] >> 16);
                        Bseg = __builtin_fmaf(a2.x, Bseg, bb0); Aseg *= a2.x; Bseg = __builtin_fmaf(a2.y, Bseg, bb1); Aseg *= a2.y; }
                    if (m & 1) { keep[m >> 1].z = lw[0]; keep[m >> 1].w = lw[1]; keep[4 + (m >> 1)].z = bw[0]; keep[4 + (m >> 1)].w = bw[1]; } else { keep[m >> 1].x = lw[0]; keep[m >> 1].y = lw[1]; keep[4 + (m >> 1)].x = bw[0]; keep[4 + (m >> 1)].y = bw[1]; }
                    float my; lru_segments(Aseg, Bseg, fq, H, Ptot, my);
                }
#pragma unroll
                for (int p8 = 0; p8 < 8; ++p8) *(u32x4*)(labu + (size_t)s * 65536 + p8 * 1024) = keep[p8];
            }
#undef LRU_XLOAD
            if (fq == 0) { f32x2v_t v; v.x = Ptot; v.y = H; *(f32x2v_t*)(CAR + (((size_t)n * 32 + chunk) * 128 + 16 * w + fr) * 2) = v; }
            __syncthreads();
        }
    }
}

constexpr int AT_KS = 144, AT_K = 0, AT_V = 256 * AT_KS;
__device__ __forceinline__ int crow(int r, int hi) { return (r & 3) + 8 * (r >> 2) + 4 * hi; }
__device__ __forceinline__ void attn_phase(const Args& a, LAS unsigned char* lds, int G, int vcu, const int w  ) {
    const int lane = lane_now(), tid = w * 64 + lane, r32 = lane & 31, hi = lane >> 5;
    const u16* Q = (const u16*)(a.ws + WS_Q); const u16* Kb = (const u16*)(a.ws + WS_K); const u16* Vb = (const u16*)(a.ws + WS_V); u16* ATT = (u16*)(a.ws + WS_ATT);
    const float* sinks = a.in[16];
    u32x4 kpre[4], vpre[4];
#define AT_KVLOAD(unit_) do { const int kvh_ = (unit_) & 3, b_ = (unit_) >> 2; _Pragma("unroll") for (int i = 0; i < 4; ++i) { const int p = tid + 512 * i, idx = p >> 3, pc = p & 7, t = 128 * (b_ - 1) + idx; \
        kpre[i] = (u32x4){0u, 0u, 0u, 0u}; vpre[i] = (u32x4){0u, 0u, 0u, 0u}; if (t >= 0) { kpre[i] = *(const u32x4*)(Kb + (size_t)t * KVD + 64 * kvh_ + 8 * pc); vpre[i] = *(const u32x4*)(Vb + (size_t)t * KVD + 64 * kvh_ + 8 * pc); } } } while (0)
    if (vcu < 512) AT_KVLOAD(vcu);
    for (int unit = vcu; unit < 512; unit += G) {
        const int kvh = unit & 3, b = unit >> 2;
#pragma unroll
        for (int i = 0; i < 4; ++i) { const int p = tid + 512 * i, idx = p >> 3, pc = p & 7; *(LAS u32x4*)(lds + AT_K + idx * AT_KS + pc * 16) = kpre[i]; *(LAS u32x4*)(lds + AT_V + idx * AT_KS + pc * 16) = vpre[i]; }
        __syncthreads();
        if (unit + G < 512) AT_KVLOAD(unit + G);
        const int head = 4 * kvh + (w >> 1), qh = w & 1; const float sink2 = sinks[head] * LOG2E;
        bf16x8 qfa[2][4];
#pragma unroll
        for (int qt = 0; qt < 2; ++qt)
#pragma unroll
            for (int s = 0; s < 4; ++s) qfa[qt][s] = *(const bf16x8*)(Q + (size_t)(128 * b + 64 * qh + 32 * qt + r32) * D + 64 * head + 16 * s + 8 * hi);
#pragma unroll
        for (int qt = 0; qt < 2; ++qt) {
            const int q0 = 64 * qh + 32 * qt, t = 128 * b + q0 + r32;
            bf16x8 qf[4];
#pragma unroll
            for (int s = 0; s < 4; ++s) qf[s] = qfa[qt][s];
            f32x16 o0, o1;
#pragma unroll
            for (int r = 0; r < 16; ++r) { o0[r] = 0.f; o1[r] = 0.f; }
            float mx = sink2, l = 1.0f; const int kt0 = q0 >> 5;
            for (int kk = 0; kk < 5; ++kk) { const int kt = kt0 + kk; if (b == 0 && kt < 4) continue;
                f32x16 sc;
#pragma unroll
                for (int r = 0; r < 16; ++r) sc[r] = 0.f;
#pragma unroll
                for (int s = 0; s < 4; ++s) { const bf16x8 kf = *(const LAS bf16x8*)(lds + AT_K + (32 * kt + r32) * AT_KS + (16 * s + 8 * hi) * 2); sc = __builtin_amdgcn_mfma_f32_32x32x16_bf16(kf, qf[s], sc, 0, 0, 0); }
                const int base = 32 * kt + 4 * hi - (128 + q0 + r32); float mt = -1.0e30f;
#pragma unroll
                for (int r = 0; r < 16; ++r) { const int rel = base + (r & 3) + 8 * (r >> 2); if (!(rel <= 0 && rel > -WIN)) sc[r] = -1.0e30f; mt = fmaxf(mt, sc[r]); }
                mt = fmaxf(mt, __shfl_xor(mt, 32));
                const float mn = fmaxf(mx, mt), al = fexp2(mx - mn); float ps = 0.f;
#pragma unroll
                for (int r = 0; r < 16; ++r) { const float p = fexp2(sc[r] - mn); sc[r] = p; ps += p; }
                ps += __shfl_xor(ps, 32); l = l * al + ps; mx = mn;
#pragma unroll
                for (int r = 0; r < 16; ++r) { o0[r] *= al; o1[r] *= al; }
                u32x4 pa, pb; pa.x = cvt_pk_bf16(sc[0], sc[1]); pa.y = cvt_pk_bf16(sc[2], sc[3]); pa.z = cvt_pk_bf16(sc[4], sc[5]); pa.w = cvt_pk_bf16(sc[6], sc[7]);
                pb.x = cvt_pk_bf16(sc[8], sc[9]); pb.y = cvt_pk_bf16(sc[10], sc[11]); pb.z = cvt_pk_bf16(sc[12], sc[13]); pb.w = cvt_pk_bf16(sc[14], sc[15]);
                const bf16x8 pf0 = __builtin_bit_cast(bf16x8, pa), pf1 = __builtin_bit_cast(bf16x8, pb);
#pragma unroll
                for (int s2 = 0; s2 < 2; ++s2)
#pragma unroll
                    for (int dt = 0; dt < 2; ++dt) {
                        const int va = AT_V + (32 * kt + 16 * s2 + 4 * hi + ((lane & 15) >> 2)) * AT_KS + (32 * dt + 16 * ((lane >> 4) & 1) + 4 * (lane & 3)) * 2;
                        const s16x4 lo = __builtin_bit_cast(s16x4, __builtin_amdgcn_ds_read_tr16_b64_v4i16((LAS s16x4*)(lds + va)));
                        const s16x4 hi4 = __builtin_bit_cast(s16x4, __builtin_amdgcn_ds_read_tr16_b64_v4i16((LAS s16x4*)(lds + va + 8 * AT_KS)));
                        const bf16x8 vf = (bf16x8){lo[0], lo[1], lo[2], lo[3], hi4[0], hi4[1], hi4[2], hi4[3]};
                        if (dt == 0) o0 = __builtin_amdgcn_mfma_f32_32x32x16_bf16(vf, s2 ? pf1 : pf0, o0, 0, 0, 0); else o1 = __builtin_amdgcn_mfma_f32_32x32x16_bf16(vf, s2 ? pf1 : pf0, o1, 0, 0, 0); }
            }
            const float il = 1.0f / l;
#pragma unroll
            for (int g4 = 0; g4 < 4; ++g4) { u32x2 w0, w1;
                w0.x = cvt_pk_bf16(o0[4 * g4] * il, o0[4 * g4 + 1] * il); w0.y = cvt_pk_bf16(o0[4 * g4 + 2] * il, o0[4 * g4 + 3] * il);
                w1.x = cvt_pk_bf16(o1[4 * g4] * il, o1[4 * g4 + 1] * il); w1.y = cvt_pk_bf16(o1[4 * g4 + 2] * il, o1[4 * g4 + 3] * il);
                if (ATTN_FP8) { const float so = il * S8_O; int b0 = 0, b1 = 0;
                    float c0[4], c1[4];
#pragma unroll
                    for (int i = 0; i < 4; ++i) { c0[i] = __builtin_fminf(__builtin_fmaxf(o0[4 * g4 + i] * so, -448.0f), 448.0f); c1[i] = __builtin_fminf(__builtin_fmaxf(o1[4 * g4 + i] * so, -448.0f), 448.0f); }
                    b0 = __builtin_amdgcn_cvt_pk_fp8_f32(c0[0], c0[1], b0, false); b0 = __builtin_amdgcn_cvt_pk_fp8_f32(c0[2], c0[3], b0, true);
                    b1 = __builtin_amdgcn_cvt_pk_fp8_f32(c1[0], c1[1], b1, false); b1 = __builtin_amdgcn_cvt_pk_fp8_f32(c1[2], c1[3], b1, true);
                    unsigned char* A8 = (unsigned char*)ATT; *(int*)(A8 + (size_t)t * D + 64 * head + 8 * g4 + 4 * hi) = b0; *(int*)(A8 + (size_t)t * D + 64 * head + 32 + 8 * g4 + 4 * hi) = b1; }
                else { *(u32x2*)(ATT + (size_t)t * D + 64 * head + 8 * g4 + 4 * hi) = w0; *(u32x2*)(ATT + (size_t)t * D + 64 * head + 32 + 8 * g4 + 4 * hi) = w1; } }
        }
        __syncthreads();
    }
}

#undef AT_KVLOAD
#ifndef XCD_FAST_MASK
#define XCD_FAST_MASK 0x53u
#endif
constexpr int NPHASE = 14;
#define M_CTL ((unsigned*)(a.ws + WS_CTL))
#define M_H (a.out)
#define M_HB ((u16*)(a.ws + WS_HB))
#define M_SSP0 ((float*)(a.ws + WS_SSP))
#define M_SSP1 (M_SSP0 + 65536)
#define M_SSP2 (M_SSP0 + 2 * 65536)
#define M_SSP3 (M_SSP0 + 3 * 65536)
#define M_CNT (M_CTL + CW_CNT)
#define M_LIST ((int*)(a.ws + WS_LIST))
#define M_GATEW ((float*)(a.ws + WS_GATEW))
#define M_GW (vcu * 8 + wave)
#define M_NGW (G * 8)
__global__ void __launch_bounds__(512, 2) mega(Args a) {
    extern __shared__ __attribute__((aligned(16))) unsigned char lds_raw[];
    LAS unsigned char* lds = (LAS unsigned char*)lds_raw;
    const int wave = __builtin_amdgcn_readfirstlane((int)(threadIdx.x >> 6));
#define TID_ (wave * 64 + lane_now())
    const int G = gridDim.x; const int bx = blockIdx.x; const int vcu = (G % 8 == 0) ? (bx % 8) * (G / 8) + bx / 8 : bx;
    volatile LAS unsigned* MISC = (volatile LAS unsigned*)(lds + LX_MISC);
    for (int u = TID_; u < 112; u += 512) ((LAS unsigned*)(lds + LX_MISC))[u] = 0u;
    __syncthreads();
    const int lo = a.ph_lo, hi = a.ph_hi;
    XcdBarrier bar; bar.bar = M_CTL + CW_BAR; bar.x = 0; bar.st = nullptr;
    if (hi - lo > 1) bar = xcd_barrier_post(M_CTL + CW_BAR, MISC + 8, TID_ == 0);
#define IN(k) (lo <= (k) && (k) < hi)
#ifndef REP_MASK
#define REP_MASK 0
#endif
#define REPS(k) for (int rep_ = 0; rep_ < 1 + ((REP_MASK >> (k)) & 1); ++rep_)
#ifndef PROBE_SEAMS
#define PROBE_SEAMS 0
#endif
#ifndef PROBE_BLK
#define PROBE_BLK 0
#endif
#ifndef PROBE_PH
#define PROBE_PH 0
#endif
#ifndef PROBE_UNIT
#define PROBE_UNIT 0
#endif
    unsigned long long probe_acc = 0ull;
    if (PROBE_PH && TID_ == 0) MISC[60] = (unsigned)__builtin_amdgcn_s_memrealtime();
    if (lane_now() == 0) { MISC[16 + 4 * wave] = 0u; MISC[17 + 4 * wave] = 0u; MISC[18 + 4 * wave] = 0xffffffffu; }
#define SEAM_DRAIN(k) ((k) == 1 ? 16 : (k) == 3 ? 17 : (k) == 4 ? 19 : (k) == 5 ? 20 : (k) == 6 ? 22 : (k) == 10 ? N_DEFER : 0)
#define SEAM(k) do { if (IN(k) && IN((k) + 1)) { if (PROBE_PH && TID_ == 0 && ((PROBE_PH >> (k)) & 1)) MISC[61] = MISC[61] + ((unsigned)__builtin_amdgcn_s_memrealtime() - MISC[60]); const unsigned long long t0_ = ((PROBE_SEAMS >> (k)) & 1) ? __builtin_amdgcn_s_memrealtime() : 0ull; \
        { DeferState dst; dst.d = __builtin_amdgcn_readfirstlane((int)MISC[16 + 4 * wave]); dst.base = __builtin_amdgcn_readfirstlane((int)MISC[17 + 4 * wave]); dst.it = __builtin_amdgcn_readfirstlane((int)MISC[18 + 4 * wave]); \
          seam_sync<SEAM_DRAIN(k)>(bar, MISC + 12, (unsigned)(k) + 1u, a, dst, M_GW, M_NGW, wave); \
          if (lane_now() == 0) { MISC[16 + 4 * wave] = (unsigned)dst.d; MISC[17 + 4 * wave] = (unsigned)dst.base; MISC[18 + 4 * wave] = (unsigned)dst.it; } } if ((PROBE_SEAMS >> (k)) & 1) probe_acc += __builtin_amdgcn_s_memrealtime() - t0_; if (PROBE_PH && TID_ == 0) MISC[60] = (unsigned)__builtin_amdgcn_s_memrealtime(); } } while (0)

    if (IN(0)) REPS(0) {
        tables_body(a, vcu * 512 + TID_, G * 512);
        convert_body(a, (float*)(lds_raw + wave * 16384), M_GW, M_NGW, lane_now(), !(IN(0) && IN(1)));
        rowprep_body(a.in[0], M_HB, M_SSP0, M_GW, M_NGW, lane_now());
    }
    SEAM(0);
    if (IN(1)) REPS(1) { pg8::DenseSched S; S.o.init(M / 256, 2048 / 256, G, bx); S.A = (const char*)M_HB; S.Bt = (const char*)(a.ws + WS_WIN); S.K = 1024;
        pg8::EpiProj E{M_SSP0, (u16*)(a.ws + WS_Y), (u16*)(a.ws + WS_XB)}; pg8::gemm_phase<pg8::EpiProj, pg8::DenseSched, false>(lds, 1024, S, E, wave); }
    SEAM(1);
    if (IN(2)) REPS(2) lru_phase<false>(a, lds, G, vcu, wave);
    SEAM(2);
    if (IN(3)) REPS(3) lru_phase<true>(a, lds, G, vcu, wave);
    SEAM(3);
    if (IN(4)) REPS(4) { pg8::DenseSched S; S.o.init(M / 256, 4, G, bx); S.A = (const char*)(a.ws + WS_G); S.Bt = (const char*)(a.ws + WS_WOUT); S.K = 1024;
        pg8::EpiRes E{M_HB, nullptr, M_SSP1, nullptr, 1.0f, 1.0f}; pg8::gemm_phase<pg8::EpiRes, pg8::DenseSched, false>(lds, 1024, S, E, wave); }
    SEAM(4);
    if (IN(5)) REPS(5) { pg8::DenseSched S; S.o.init(M / 256, 7168 / 256, G, bx); S.A = (const char*)M_HB; S.Bt = (const char*)(a.ws + WS_WGU); S.K = 1024;
        pg8::EpiGateUp E{M_SSP1, (u16*)(a.ws + WS_ACT)}; pg8::gemm_phase<pg8::EpiGateUp, pg8::DenseSched, false>(lds, 1024, S, E, wave); }
    SEAM(5);
    if (IN(6)) { pg8::DenseSched S; S.o.init(M / 256, 4, G, bx); S.A = (const char*)(a.ws + WS_ACT); S.Bt = (const char*)(a.ws + WS_WD); S.K = DFF;
        pg8::EpiRes E{M_HB, nullptr, M_SSP2, ATTN_FP8 ? (unsigned char*)(a.ws + WS_HB8) : nullptr, 1.0f, 1.0f}; pg8::gemm_phase<pg8::EpiRes, pg8::DenseSched, false>(lds, DFF, S, E, wave); }
    SEAM(6);
    if (IN(7)) REPS(7) { pg8::DenseSched S; S.o.init(M / 256, NQKV / 256, G, bx); S.A = ATTN_FP8 ? (const char*)(a.ws + WS_HB8) : (const char*)M_HB; S.Bt = (const char*)(a.ws + WS_WQKV); S.K = ATTN_FP8 ? 512 : 1024;
        pg8::EpiQKV E{M_SSP2, a.in[15], (const u16*)(a.ws + WS_ROPE), (u16*)(a.ws + WS_Q), (u16*)(a.ws + WS_K), (u16*)(a.ws + WS_V), ATTN_FP8 ? 1.0f / (S8_A * S8_W) : 1.0f}; pg8::gemm_phase<pg8::EpiQKV, pg8::DenseSched, false, ATTN_FP8 != 0>(lds, ATTN_FP8 ? 512 : 1024, S, E, wave); }
    SEAM(7);
    if (IN(8)) REPS(8) attn_phase(a, lds, G, vcu, wave);
    SEAM(8);
    if (IN(9)) { pg8::DenseSched S; S.o.init(M / 256, 4, G, bx); S.A = (const char*)(a.ws + WS_ATT); S.Bt = (const char*)(a.ws + WS_WO); S.K = ATTN_FP8 ? 512 : 1024;
        pg8::EpiRes E{M_HB, a.in[18], M_SSP3, MOE_FP8 ? (unsigned char*)(a.ws + WS_HB8) : nullptr, ATTN_FP8 ? 1.0f / (S8_O * S8_W) : 1.0f, ATTN_FP8 ? S8_O * S8_W : 1.0f}; pg8::gemm_phase<pg8::EpiRes, pg8::DenseSched, false, ATTN_FP8 != 0>(lds, ATTN_FP8 ? 512 : 1024, S, E, wave); }
    SEAM(9);
    if (IN(10)) { for (int g = vcu; g < M / 64; g += G) router_group(M_HB, (const float*)(a.ws + WS_WR), M_SSP3, M_CNT, M_LIST, M_GATEW, g, (float*)(lds_raw + LX_ROUT), wave); }
    SEAM(10);
    LAS int* tbl = (LAS int*)(lds + LX_TBL);
    if (IN(11) || IN(12)) { if (TID_ == 0) { int c8[8];
#pragma unroll
            for (int e = 0; e < 8; ++e) c8[e] = (int)__hip_atomic_load(M_CNT + e, __ATOMIC_RELAXED, __HIP_MEMORY_SCOPE_AGENT);
            int acc = 0;
#pragma unroll
            for (int e = 0; e < 8; ++e) { tbl[e] = c8[e]; tbl[8 + e] = acc; acc += (c8[e] + 255) >> 8; } tbl[16] = acc; } __syncthreads(); }
    if (IN(11)) REPS(11) { pg8::MoeSched S; S.o.init(__builtin_amdgcn_readfirstlane(tbl[16]), 7168 / 256, G, bx); S.o.init_weighted(XCD_FAST_MASK); S.A = MOE_FP8 ? (const char*)(a.ws + WS_HB8) : (const char*)M_HB; S.Bt = (const char*)(a.ws + WS_WGU2); S.K = MOE_FP8 ? 512 : 1024; S.bstride = (size_t)7168 * 1024 * (MOE_FP8 ? 1 : 2); S.list = M_LIST; S.tbl = tbl;
        pg8::EpiMoeUp E{M_SSP3, M_LIST, M_GATEW, tbl, (u16*)(a.ws + WS_ACT2)}; pg8::gemm_phase<pg8::EpiMoeUp, pg8::MoeSched, true, MOE_FP8 != 0>(lds, MOE_FP8 ? 512 : 1024, S, E, wave, (PROBE_UNIT && bx == PROBE_BLK) ? (MISC + 14) : nullptr, PROBE_UNIT - 1); if (PROBE_UNIT) { __syncthreads(); probe_acc += (unsigned long long)MISC[14] | ((unsigned long long)MISC[15] << 32); } }
    SEAM(11);
    if (IN(12) && MOE_FP8 && G == 256) REPS(12) { pg8::MoeSchedSK S; S.init(__builtin_amdgcn_readfirstlane(tbl[16]), bx, DFF / 2); S.A = (const char*)(a.ws + WS_ACT2); S.Bt = (const char*)(a.ws + WS_WD2); S.bstride = (size_t)1024 * DFF; S.tbl = tbl;
        S.part = (float*)(a.ws + WS_ACT); S.flags = M_CTL + CW_SKF;
        pg8::EpiMoeDown E{M_LIST, tbl, (u16*)(a.ws + WS_MO)}; pg8::gemm_phase<pg8::EpiMoeDown, pg8::MoeSchedSK, false, MOE_FP8 != 0>(lds, DFF / 2, S, E, wave); }
    else if (IN(12)) REPS(12) { pg8::MoeSched S; S.o.init(__builtin_amdgcn_readfirstlane(tbl[16]), 4, G, bx); S.A = (const char*)(a.ws + WS_ACT2); S.Bt = (const char*)(a.ws + WS_WD2); S.K = MOE_FP8 ? DFF / 2 : DFF; S.bstride = (size_t)1024 * DFF * (MOE_FP8 ? 1 : 2); S.list = nullptr; S.tbl = tbl;
        pg8::EpiMoeDown E{M_LIST, tbl, (u16*)(a.ws + WS_MO)}; pg8::gemm_phase<pg8::EpiMoeDown, pg8::MoeSched, false, MOE_FP8 != 0>(lds, MOE_FP8 ? DFF / 2 : DFF, S, E, wave); }
    SEAM(12);
#ifndef PROBE_P13
#define PROBE_P13 0
#endif
    const unsigned long long t13_ = PROBE_P13 ? __builtin_amdgcn_s_memrealtime() : 0ull;
    if (IN(13)) REPS(13) final_body(M_H, M_HB, (const u16*)(a.ws + WS_MO), a.in[4], M_GW, M_NGW, lane_now());
    if (PROBE_P13) { __syncthreads(); probe_acc += __builtin_amdgcn_s_memrealtime() - t13_; }
    if (PROBE_PH) __syncthreads();
    if (PROBE_PH && TID_ == 0) { if ((PROBE_PH >> 13) & 1) MISC[61] = MISC[61] + ((unsigned)__builtin_amdgcn_s_memrealtime() - MISC[60]); probe_acc += (unsigned long long)MISC[61]; }
    if ((PROBE_SEAMS != 0 || PROBE_P13 || PROBE_UNIT || PROBE_PH) && bx == PROBE_BLK && TID_ == 0) { const unsigned long long t1_ = __builtin_amdgcn_s_memrealtime() + 4ull * probe_acc; while (__builtin_amdgcn_s_memrealtime() < t1_) __builtin_amdgcn_s_sleep(8); }
#undef IN
#undef SEAM
#undef TID_
}
#ifndef MK_MODE
#define MK_MODE 1
#endif
#ifndef FASTMASK
#define FASTMASK 0x3fff
#endif
extern "C" void kernel_launch(void* const* d_in, const int* in_sizes, int n_in, void* d_out, int out_size, void* d_ws, size_t ws_size, hipStream_t stream) {
    if (n_in != 26 || out_size != M * D || ws_size < WS_END) { fprintf(stderr, "kernel_launch: unexpected shapes (n_in %d out %d ws %zu, need %zu)\n", n_in, out_size, ws_size, (size_t)WS_END); return; }
    static int grid = 0;
    if (grid == 0) {
        int dev = 0, cus = 0, per_cu = 0;
        if (hipGetDevice(&dev) != hipSuccess || hipDeviceGetAttribute(&cus, hipDeviceAttributeMultiprocessorCount, dev) != hipSuccess) { grid = -1; return; }
        if (hipFuncSetAttribute((const void*)mega, hipFuncAttributeMaxDynamicSharedMemorySize, LDS_BYTES) != hipSuccess) { fprintf(stderr, "kernel_launch: hipFuncSetAttribute failed\n"); grid = -1; return; }
        if (hipOccupancyMaxActiveBlocksPerMultiprocessor(&per_cu, (const void*)mega, 512, LDS_BYTES) != hipSuccess || per_cu < 1) { fprintf(stderr, "kernel_launch: occupancy query says %d\n", per_cu); per_cu = 1; }
        (void)hipGetLastError();
        grid = cus;
    }
    if (grid < 0) return;
    unsigned char* ws = (unsigned char*)d_ws;
    (void)hipMemsetAsync(ws + WS_CTL, 0, CTL_BYTES, stream);
    Args a{};
    for (int i = 0; i < 26; ++i) a.in[i] = (const float*)d_in[i];
    a.pos = (const int*)d_in[1]; a.out = (float*)d_out; a.ws = ws; a.ph_lo = 0; a.ph_hi = NPHASE;
#if MK_MODE == 1
    hipLaunchKernelGGL(mega, dim3(grid), dim3(512), LDS_BYTES, stream, a);
#else
    float* H = (float*)d_out; u16* HB = (u16*)(ws + WS_HB);
    float* SSP0 = (float*)(ws + WS_SSP), *SSP1 = SSP0 + 65536, *SSP2 = SSP1 + 65536, *SSP3 = SSP2 + 65536;
    const unsigned* cnt = (const unsigned*)(ws + WS_CTL) + CW_CNT; const int* list = (const int*)(ws + WS_LIST); const float* gatew = (const float*)(ws + WS_GATEW);
    for (int p = 0; p < NPHASE; ++p) {
        if ((FASTMASK >> p) & 1) { a.ph_lo = p; a.ph_hi = p + 1; hipLaunchKernelGGL(mega, dim3(grid), dim3(512), LDS_BYTES, stream, a); continue; }
        switch (p) {
        case 0: k_tables<<<256, 256, 0, stream>>>(a); k_convert<<<2048, 256, 0, stream>>>(a); k_rowprep<<<1024, 256, 0, stream>>>(a.in[0], HB, SSP0); break;
        case 1: { NE_Proj e{HB, (const u16*)(ws + WS_WIN), SSP0, (u16*)(ws + WS_Y), (u16*)(ws + WS_XB)}; k_ngemm<<<dim3(2048 / 64, M / 64), 256, 0, stream>>>(e, 1024); } break;
        case 2: k_conv1d<<<(M * D) / 256, 256, 0, stream>>>((const u16*)(ws + WS_XB), a.in[6], a.in[7], (u16*)(ws + WS_XC));
                { NE_Gates e{(const u16*)(ws + WS_XC), (const u16*)(ws + WS_WAX), a.in[9], a.in[11], (const float*)(ws + WS_SPL), (float*)d_out, (float*)(ws + WS_BX)}; k_ngemm<<<dim3(128 / 64, M / 64, 8), 256, 0, stream>>>(e, 128); } break;
        case 3: k_scan_seq<<<16, 64, 0, stream>>>((const float*)d_out, (const float*)(ws + WS_BX), (const u16*)(ws + WS_Y), (u16*)(ws + WS_G)); break;
        case 4: { NE_Res e{(const u16*)(ws + WS_G), (const u16*)(ws + WS_WOUT), 1024, a.in[0], H, HB, nullptr}; k_ngemm<<<dim3(1024 / 64, M / 64), 256, 0, stream>>>(e, 1024); } k_ssp<<<1024, 256, 0, stream>>>(H, SSP1); break;
        case 5: { NE_GateUp e{HB, (const u16*)(ws + WS_WGU), SSP1, (u16*)(ws + WS_ACT)}; k_ngemm<<<dim3(DFF / 64, M / 64), 256, 0, stream>>>(e, 1024); } break;
        case 6: { NE_Res e{(const u16*)(ws + WS_ACT), (const u16*)(ws + WS_WD), DFF, nullptr, H, HB, nullptr}; k_ngemm<<<dim3(1024 / 64, M / 64), 256, 0, stream>>>(e, DFF); } k_ssp<<<1024, 256, 0, stream>>>(H, SSP2); break;
        case 7: { NE_QKV e{HB, (const u16*)(ws + WS_WQKV), SSP2, a.in[15], (const u16*)(ws + WS_ROPE), (u16*)(ws + WS_Q), (u16*)(ws + WS_K), (u16*)(ws + WS_V)}; k_ngemm<<<dim3(NQKV / 64, M / 64), 256, 0, stream>>>(e, 1024); } break;
        case 8: k_attn_ref<<<(M * NH) / 64, 64, 0, stream>>>((const u16*)(ws + WS_Q), (const u16*)(ws + WS_K), (const u16*)(ws + WS_V), a.in[16], (u16*)(ws + WS_ATT)); break;
        case 9: { NE_Res e{(const u16*)(ws + WS_ATT), (const u16*)(ws + WS_WO), 1024, nullptr, H, HB, a.in[18]}; k_ngemm<<<dim3(1024 / 64, M / 64), 256, 0, stream>>>(e, 1024); } k_ssp<<<1024, 256, 0, stream>>>(H, SSP3); break;
        case 10: k_router<<<256, 512, 0, stream>>>(a); break;
        case 11: { NE_MoeUp e{HB, (const u16*)(ws + WS_WGU2), SSP3, cnt, list, gatew, (u16*)(ws + WS_ACT2)}; k_ngemm<<<dim3(DFF / 64, MAXSLOT / 64), 256, 0, stream>>>(e, 1024); } break;
        case 12: { NE_MoeDown e{(const u16*)(ws + WS_ACT2), (const u16*)(ws + WS_WD2), cnt, list, (u16*)(ws + WS_MO)}; k_ngemm<<<dim3(1024 / 64, MAXSLOT / 64), 256, 0, stream>>>(e, DFF); } break;
        case 13: k_final<<<1024, 256, 0, stream>>>(H, HB, (const u16*)(ws + WS_MO), a.in[4]); break;
        }
    }
#endif
}
```
